# Optimizing an MI355X kernel written in HIP

```python
import math
import jax, jax.numpy as jnp
from jax import lax
import numpy as np

D_MODEL = 1024
BATCH = 8
SEQ = 2048
DEPTH = 1

CHUNK = 64
Q_BLOCK = 128
ATTN_WIDTH = D_MODEL // 2
ATTN_HEAD_DIM = 64
ATTN_HEADS = ATTN_WIDTH // ATTN_HEAD_DIM
SSM_WIDTH = D_MODEL - ATTN_WIDTH
SSM_GROUP = 16
SSM_GROUPS = SSM_WIDTH // SSM_GROUP
SSM_STATE = 64
D_FF = 2816
CONV_WIDTH = 3
IN_COLS = 3 * ATTN_WIDTH + ATTN_HEADS + SSM_WIDTH
EPS = 1e-6
NEG_INF = -1e30

kernel_name = "hybrid_fox_s5_convffn_block"


def _rms_norm(x, g):
    xf = x.astype(jnp.float32)
    y = xf * lax.rsqrt(jnp.mean(xf * xf, axis=-1, keepdims=True) + EPS)
    return (y * g.astype(jnp.float32)).astype(x.dtype)


def _forgetting_attention(q, k, v, log_f):
    seq = q.shape[2]
    c = jnp.cumsum(log_f, axis=-1)
    scale = ATTN_HEAD_DIM ** -0.5
    outs = []
    for start in range(0, seq, Q_BLOCK):
        end = start + Q_BLOCK
        qb = q[:, :, start:end]
        kb = k[:, :, :end]
        vb = v[:, :, :end]
        s = jnp.einsum('bhqd,bhkd->bhqk', qb, kb) * scale
        s = s + c[:, :, start:end, None] - c[:, :, None, :end]
        qpos = jnp.arange(start, end)[:, None]
        kpos = jnp.arange(end)[None, :]
        s = jnp.where(kpos <= qpos, s, NEG_INF)
        p = jax.nn.softmax(s, axis=-1)
        outs.append(jnp.einsum('bhqk,bhkd->bhqd', p, vb))
    return jnp.concatenate(outs, axis=2)


def _ssm_combine(e1, e2):
    a1r, a1i, b1r, b1i = e1
    a2r, a2i, b2r, b2i = e2
    ar = a2r * a1r - a2i * a1i
    ai = a2r * a1i + a2i * a1r
    br = a2r * b1r - a2i * b1i + b2r
    bi = a2r * b1i + a2i * b1r + b2i
    return (ar, ai, br, bi)


def _s5_ssm(u, lambda_re, lambda_im, log_step, b_re, b_im, c_re, c_im, d_skip):
    seq = u.shape[1]
    lr = lambda_re.astype(jnp.float32)
    li = lambda_im.astype(jnp.float32)
    step = jnp.exp(log_step.astype(jnp.float32))[:, None]
    er = jnp.exp(lr * step)
    ab_re = er * jnp.cos(li * step)
    ab_im = er * jnp.sin(li * step)
    num_re = ab_re - 1.0
    num_im = ab_im
    den = lr * lr + li * li
    f_re = (num_re * lr + num_im * li) / den
    f_im = (num_im * lr - num_re * li) / den
    br = b_re.astype(jnp.float32)
    bi = b_im.astype(jnp.float32)
    bb_re = f_re[:, :, None] * br - f_im[:, :, None] * bi
    bb_im = f_re[:, :, None] * bi + f_im[:, :, None] * br
    bu_re = jnp.einsum('bsgh,gph->bsgp', u, bb_re)
    bu_im = jnp.einsum('bsgh,gph->bsgp', u, bb_im)
    a_re = jnp.broadcast_to(ab_re[None, None], (1, seq) + ab_re.shape)
    a_im = jnp.broadcast_to(ab_im[None, None], (1, seq) + ab_im.shape)
    _, _, x_re, x_im = lax.associative_scan(_ssm_combine, (a_re, a_im, bu_re, bu_im), axis=1)
    y = (jnp.einsum('bsgp,ghp->bsgh', x_re, c_re.astype(jnp.float32))
         - jnp.einsum('bsgp,ghp->bsgh', x_im, c_im.astype(jnp.float32)))
    return y + d_skip.astype(jnp.float32) * u


def _causal_dwconv(h, w, b):
    seq = h.shape[1]
    hp = jnp.pad(h, ((0, 0), (CONV_WIDTH - 1, 0), (0, 0)))
    y = b
    for j in range(CONV_WIDTH):
        y = y + hp[:, j:j + seq] * w[j]
    return y


def setup_inputs(seed: int = 0) -> dict:
    key = jax.random.key(seed)
    ks = jax.random.split(key, 24)
    f32 = jnp.float32
    n = lambda k, shape, s: jax.random.normal(k, shape, f32) * s
    x = n(ks[0], (BATCH, SEQ, D_MODEL), 1.0)
    g_mix = 1.0 + n(ks[1], (D_MODEL,), 0.02)
    w_in = n(ks[2], (D_MODEL, IN_COLS), D_MODEL ** -0.5)
    b_f = 2.0 + n(ks[3], (ATTN_HEADS,), 0.1)
    g_q = 1.0 + n(ks[4], (ATTN_HEAD_DIM,), 0.02)
    g_k = 1.0 + n(ks[5], (ATTN_HEAD_DIM,), 0.02)
    lambda_re = -0.5 + n(ks[6], (SSM_GROUPS, SSM_STATE), 0.01)
    lambda_im = (math.pi * jnp.arange(SSM_STATE, dtype=f32))[None, :] + n(ks[7], (SSM_GROUPS, SSM_STATE), 0.01)
    log_step = jax.random.uniform(ks[8], (SSM_GROUPS,), f32, math.log(1e-3), math.log(1e-1))
    b_re = n(ks[9], (SSM_GROUPS, SSM_STATE, SSM_GROUP), (2.0 * SSM_GROUP) ** -0.5)
    b_im = n(ks[10], (SSM_GROUPS, SSM_STATE, SSM_GROUP), (2.0 * SSM_GROUP) ** -0.5)
    c_re = n(ks[11], (SSM_GROUPS, SSM_GROUP, SSM_STATE), (2.0 * SSM_STATE) ** -0.5)
    c_im = n(ks[12], (SSM_GROUPS, SSM_GROUP, SSM_STATE), (2.0 * SSM_STATE) ** -0.5)
    d_skip = n(ks[13], (SSM_GROUPS, SSM_GROUP), 1.0)
    w_glu = n(ks[14], (SSM_WIDTH, SSM_WIDTH), SSM_WIDTH ** -0.5)
    b_glu = n(ks[15], (SSM_WIDTH,), 0.02)
    g_attn_out = 1.0 + n(ks[16], (ATTN_WIDTH,), 0.02)
    g_ssm_out = 1.0 + n(ks[17], (SSM_WIDTH,), 0.02)
    w_out = n(ks[18], (D_MODEL, D_MODEL), D_MODEL ** -0.5)
    g_ffn = 1.0 + n(ks[19], (D_MODEL,), 0.02)
    w_up = n(ks[20], (D_MODEL, 2 * D_FF), D_MODEL ** -0.5)
    conv_w = n(ks[21], (CONV_WIDTH, 2 * D_FF), CONV_WIDTH ** -0.5)
    conv_b = n(ks[22], (2 * D_FF,), 0.02)
    w_down = n(ks[23], (D_FF, D_MODEL), D_FF ** -0.5)
    return {"x": x, "g_mix": g_mix, "w_in": w_in, "b_f": b_f, "g_q": g_q, "g_k": g_k,
            "lambda_re": lambda_re, "lambda_im": lambda_im, "log_step": log_step,
            "b_re": b_re, "b_im": b_im, "c_re": c_re, "c_im": c_im, "d_skip": d_skip,
            "w_glu": w_glu, "b_glu": b_glu, "g_attn_out": g_attn_out, "g_ssm_out": g_ssm_out,
            "w_out": w_out, "g_ffn": g_ffn, "w_up": w_up, "conv_w": conv_w, "conv_b": conv_b,
            "w_down": w_down}


def reference(x, g_mix, w_in, b_f, g_q, g_k, lambda_re, lambda_im, log_step, b_re, b_im,
              c_re, c_im, d_skip, w_glu, b_glu, g_attn_out, g_ssm_out, w_out, g_ffn,
              w_up, conv_w, conv_b, w_down):
    bsz, seq, _ = x.shape
    f32 = jnp.float32
    for _layer in range(DEPTH):
        h = _rms_norm(x, g_mix)
        z = h @ w_in
        o = 0
        q = z[..., o:o + ATTN_WIDTH]; o += ATTN_WIDTH
        k = z[..., o:o + ATTN_WIDTH]; o += ATTN_WIDTH
        v = z[..., o:o + ATTN_WIDTH]; o += ATTN_WIDTH
        f_logit = z[..., o:o + ATTN_HEADS]; o += ATTN_HEADS
        u = z[..., o:o + SSM_WIDTH]

        heads = lambda t: t.reshape(bsz, seq, ATTN_HEADS, ATTN_HEAD_DIM)
        qh = _rms_norm(heads(q), g_q).astype(f32).transpose(0, 2, 1, 3)
        kh = _rms_norm(heads(k), g_k).astype(f32).transpose(0, 2, 1, 3)
        vh = heads(v).astype(f32).transpose(0, 2, 1, 3)
        log_f = jax.nn.log_sigmoid((f_logit + b_f).astype(f32)).transpose(0, 2, 1)
        att = _forgetting_attention(qh, kh, vh, log_f)
        att = att.transpose(0, 2, 1, 3).reshape(bsz, seq, ATTN_WIDTH).astype(x.dtype)

        ug = u.astype(f32).reshape(bsz, seq, SSM_GROUPS, SSM_GROUP)
        y = _s5_ssm(ug, lambda_re, lambda_im, log_step, b_re, b_im, c_re, c_im, d_skip)
        y = jax.nn.gelu(y.reshape(bsz, seq, SSM_WIDTH))
        y = y * jax.nn.sigmoid(y @ w_glu.astype(f32) + b_glu.astype(f32))
        ssm = y.astype(x.dtype)

        mixed = jnp.concatenate([_rms_norm(att, g_attn_out), _rms_norm(ssm, g_ssm_out)], axis=-1)
        x = x + mixed @ w_out

        h2 = _rms_norm(x, g_ffn)
        hh = _causal_dwconv(h2 @ w_up, conv_w, conv_b)
        gate = hh[..., :D_FF]
        val = hh[..., D_FF:]
        x = x + (jax.nn.silu(gate) * val) @ w_down
    return x
```

```cpp
#include <hip/hip_runtime.h>
#include <hip/hip_cooperative_groups.h>
#include <cstdio>
#include <cstdint>
namespace cg = cooperative_groups;
namespace pg8 {
#define PG8_LAS __attribute__((address_space(3)))
typedef unsigned short bf16_t;
typedef short bf16x8 __attribute__((ext_vector_type(8)));
typedef float f32x4 __attribute__((ext_vector_type(4)));
typedef unsigned u32x4 __attribute__((ext_vector_type(4)));
constexpr int BM = 256, BK = 64, HALF = 128, HTB = HALF * BK * 2  , STAGE_BYTES = 8 * HTB, NXCD = 8, WGM = 8;

__host__ __device__ __forceinline__ int lds_byte(int r, int c) { const int st = (r >> 4) * 2 + (c >> 5), rr = r & 15, cc = c & 31, ob = rr * 64 + cc * 2; return st * 1024 + (ob ^ (((ob >> 9) & 1) << 5)); }
__host__ __device__ __forceinline__ void stage_rc(int b, int& R, int& C) { const int st = b / 1024, sb = b % 1024, swz = sb ^ (((sb >> 9) & 1) << 5); R = (st >> 1) * 16 + swz / 64; C = (st & 1) * 32 + (swz % 64) / 2; }
__host__ __device__ __forceinline__ int perm32(int rho) { const int n = rho >> 4, i = rho & 15; return 8 * (i >> 2) + 4 * n + (i & 3); }

struct Unit { int pm, pn; };
struct Gemm { const bf16_t* A; const bf16_t* Bt; int M, N, K; };

struct StaticOrder {
    int nM, nN, nwg, G, c;
    __host__ __device__ void init(int M, int N, int G_, int c_) { nM = M / BM; nN = N / BM; nwg = nM * nN; G = G_; c = c_; }
    __host__ __device__ bool next(int i, Unit& u) const {
        const long L = (long)i * G + c; if (L >= nwg) return false;
        int wgid = (int)L; { const int q = nwg / NXCD, r = nwg % NXCD, xcd = wgid % NXCD, off = wgid / NXCD; wgid = (xcd < r ? xcd * (q + 1) : r * (q + 1) + (xcd - r) * q) + off; }
        const int nig = WGM * nN, gid = wgid / nig, fm = gid * WGM, gsz = (nM - fm) < WGM ? (nM - fm) : WGM;
        u.pm = fm + ((wgid % nig) % gsz); u.pn = (wgid % nig) / gsz; return true;
    }
    __device__ __forceinline__ void a_ready(const Unit&) const {}
    __device__ __forceinline__ void done(const Unit&) const {}
};

__device__ __forceinline__ unsigned cvt_pk_bf16(float lo, float hi) { unsigned r; asm volatile("v_cvt_pk_bf16_f32 %0, %1, %2" : "=v"(r) : "v"(lo), "v"(hi)); return r; }
typedef float f32x2 __attribute__((ext_vector_type(2)));
__device__ __forceinline__ f32x2 gelu_pk(f32x2 v) {
    const f32x2 av = __builtin_elementwise_abs(v), d = av * 0.2316418882f + 1.0f;
    f32x2 t; t.x = __builtin_amdgcn_rcpf(d.x); t.y = __builtin_amdgcn_rcpf(d.y);
    f32x2 q = t * 0.5307027145f + (-0.7265760135f); q = q * t + 0.7107068705f; q = q * t + (-0.142248368f); q = q * t + 0.127414796f; q = q * t;
    const f32x2 s = (v * v) * (-0.72134752044f);
    f32x2 e; e.x = __builtin_amdgcn_exp2f(s.x); e.y = __builtin_amdgcn_exp2f(s.y);
    const f32x2 m = v * (q * e), r = v - m;
    f32x2 o; o.x = v.x < 0.f ? m.x : r.x; o.y = v.y < 0.f ? m.y : r.y; return o;
}

template <int ACT  > struct EpiBf16 {
    static constexpr bool PERM = true, AFTER_DRAIN = false; static_assert(ACT == 0 || ACT == 1, "EpiBf16: ACT is 0 (none) or 1 (gelu_pk)");
    bf16_t* O; int ldc; const float* bias; int split_cols; size_t split_stride; float scale0;
    __device__ __forceinline__ void operator()(const f32x4 (&acc)[2][2][4][2], const Unit& u, int wr, int wc, int fr, int fq) const {
        const int row0 = u.pm * BM + wr * 64 + fr; int colt = u.pn * BM; bf16_t* base = O;
        float sc = 1.f; if (split_cols) { const int t = colt / split_cols; base += (size_t)t * split_stride; colt -= t * split_cols; if (t == 0) sc = scale0; }
        const int col0 = colt + wc * 32 + 8 * fq, bcol0 = u.pn * BM + wc * 32 + 8 * fq;
        f32x4 bv[2][2];
#pragma unroll
        for (int bj = 0; bj < 2; ++bj)
#pragma unroll
            for (int n = 0; n < 2; ++n) bv[bj][n] = bias ? *(const f32x4*)(bias + bcol0 + bj * HALF + 4 * n) : (f32x4){0.f, 0.f, 0.f, 0.f};
#pragma unroll
        for (int ai = 0; ai < 2; ++ai)
#pragma unroll
            for (int m = 0; m < 4; ++m) { bf16_t* rowp = base + (size_t)(row0 + ai * HALF + m * 16) * ldc + col0;
#pragma unroll
                for (int bj = 0; bj < 2; ++bj) { f32x4 v0 = acc[ai][bj][m][0] + bv[bj][0], v1 = acc[ai][bj][m][1] + bv[bj][1];
                    if (ACT == 1) { f32x2 a = gelu_pk((f32x2){v0[0], v0[1]}), b = gelu_pk((f32x2){v0[2], v0[3]}), c = gelu_pk((f32x2){v1[0], v1[1]}), d = gelu_pk((f32x2){v1[2], v1[3]});
                        v0 = (f32x4){a.x, a.y, b.x, b.y}; v1 = (f32x4){c.x, c.y, d.x, d.y}; }
                    v0 = v0 * sc; v1 = v1 * sc; u32x4 w; w.x = cvt_pk_bf16(v0[0], v0[1]); w.y = cvt_pk_bf16(v0[2], v0[3]); w.z = cvt_pk_bf16(v1[0], v1[1]); w.w = cvt_pk_bf16(v1[2], v1[3]);
                    *(u32x4*)(rowp + bj * HALF) = w; } }
    }
};

struct PanelStats {
    unsigned* xbuf;
    unsigned* cnt;
    unsigned* tmo;
    int ntn; float eps;
    unsigned code;
    __device__ __forceinline__ bool run(const f32x4 (&v)[2][2][4][2], const Unit& u, int wr, int wc, int fr, int fq, PG8_LAS unsigned char* lds, int wid, int lane) const {
        typedef float f32x2v __attribute__((ext_vector_type(2)));
        PG8_LAS f32x2v* P = (PG8_LAS f32x2v*)lds;
        PG8_LAS f32x2v* S = (PG8_LAS f32x2v*)(lds + 8192);
        PG8_LAS unsigned* flag = (PG8_LAS unsigned*)(lds + 8192 + 2048);
#pragma unroll
        for (int ai = 0; ai < 2; ++ai)
#pragma unroll
            for (int m = 0; m < 4; ++m) {
                float s = 0.f;
#pragma unroll
                for (int bj = 0; bj < 2; ++bj)
#pragma unroll
                    for (int n = 0; n < 2; ++n) { const f32x4 x = v[ai][bj][m][n]; s += (x[0] + x[1]) + (x[2] + x[3]); }
                s += __shfl_xor(s, 16); s += __shfl_xor(s, 32);
                const float mw = s * (1.0f / 64.0f); float q = 0.f;
#pragma unroll
                for (int bj = 0; bj < 2; ++bj)
#pragma unroll
                    for (int n = 0; n < 2; ++n) { const f32x4 d = v[ai][bj][m][n] - mw; q += (d[0] * d[0] + d[1] * d[1]) + (d[2] * d[2] + d[3] * d[3]); }
                q += __shfl_xor(q, 16); q += __shfl_xor(q, 32);
                if (fq == 0) P[(ai * HALF + wr * 64 + m * 16 + fr) * 4 + wc] = (f32x2v){mw, q};
            }
        asm volatile("s_waitcnt lgkmcnt(0)" ::: "memory"); __builtin_amdgcn_s_barrier(); asm volatile("" ::: "memory");
#if defined(BROKEN_EXCHANGE_NO_WAIT)
#warning BROKEN CONTROL BUILD: the row-statistics exchange does not wait; results are wrong by design
        if (blockIdx.x >= 64) { const long long t0_ = clock64(); while (clock64() - t0_ < 60000) __builtin_amdgcn_s_sleep(8); }
#endif
        const int row = wid * 32 + (lane & 31);
        if (lane < 32) {
            const f32x2v a = P[row * 4 + 0], b = P[row * 4 + 1], c = P[row * 4 + 2], d = P[row * 4 + 3];
            const float mt = (a.x + b.x + c.x + d.x) * 0.25f;
            const float da = a.x - mt, db = b.x - mt, dc = c.x - mt, dd = d.x - mt;
            const float m2 = (a.y + b.y) + (c.y + d.y) + 64.0f * ((da * da + db * db) + (dc * dc + dd * dd));
            unsigned long long* slot = (unsigned long long*)xbuf + ((size_t)(u.pm * BM + row) * 4 + u.pn);
            __hip_atomic_store(slot, ((unsigned long long)__float_as_uint(m2) << 32) | __float_as_uint(mt), __ATOMIC_RELAXED, __HIP_MEMORY_SCOPE_AGENT);
        }
        asm volatile("s_waitcnt vmcnt(0)" ::: "memory");
        if (lane == 0) __hip_atomic_fetch_add(cnt + 64 * u.pm, 1u, __ATOMIC_RELAXED, __HIP_MEMORY_SCOPE_AGENT);
        if (wid == 0) {
            bool dead = false; const unsigned long long t0 = __builtin_amdgcn_s_memrealtime(); const unsigned want = 8u * (unsigned)ntn;
            for (;;) {
#if defined(BROKEN_EXCHANGE_NO_WAIT)
                break;
#endif
                if ((unsigned)__builtin_amdgcn_readfirstlane(__hip_atomic_load(cnt + 64 * u.pm, __ATOMIC_RELAXED, __HIP_MEMORY_SCOPE_AGENT)) >= want) break;
                if (__builtin_amdgcn_s_memrealtime() - t0 > 2000000ull) {
                    if (lane == 0) { unsigned expect = 0u; __hip_atomic_compare_exchange_strong(tmo + 1, &expect, code | (unsigned)(u.pm & 0xff), __ATOMIC_RELAXED, __ATOMIC_RELAXED, __HIP_MEMORY_SCOPE_AGENT);
                                     __hip_atomic_store(tmo, 1u, __ATOMIC_RELAXED, __HIP_MEMORY_SCOPE_AGENT); }
                    dead = true; break; }
                __builtin_amdgcn_s_sleep(2);
            }
            __builtin_amdgcn_fence(__ATOMIC_ACQUIRE, "agent");
            if (lane == 0) flag[0] = dead ? 1u : 0u;
        }
        asm volatile("s_waitcnt vmcnt(0) lgkmcnt(0)" ::: "memory"); __builtin_amdgcn_s_barrier(); asm volatile("" ::: "memory");
        const bool bad = flag[0] != 0u;
        if (lane < 32) {
            const unsigned long long* slot = (const unsigned long long*)xbuf + (size_t)(u.pm * BM + row) * 4; float mt[4], m2[4]; float ms = 0.f;
#pragma unroll
            for (int t = 0; t < 4; ++t) { if (t < ntn) { const unsigned long long w = __hip_atomic_load(slot + t, __ATOMIC_RELAXED, __HIP_MEMORY_SCOPE_AGENT); mt[t] = __uint_as_float((unsigned)w); m2[t] = __uint_as_float((unsigned)(w >> 32)); } else { mt[t] = 0.f; m2[t] = 0.f; } ms += mt[t]; }
            const float mean = ms / (float)ntn; float q = 0.f;
#pragma unroll
            for (int t = 0; t < 4; ++t) if (t < ntn) { const float dm = mt[t] - mean; q += m2[t] + 256.0f * dm * dm; }
            S[row] = (f32x2v){mean, 1.0f / sqrtf(q / (256.0f * (float)ntn) + eps)};
        }
        asm volatile("s_waitcnt lgkmcnt(0)" ::: "memory"); __builtin_amdgcn_s_barrier(); asm volatile("" ::: "memory");
        return bad;
    }
};
struct EpiLnRes {
    static constexpr bool PERM = false, AFTER_DRAIN = true;
    const float* base; float* out; int ldc; const float* bias; PanelStats st; unsigned poison;
    __device__ __forceinline__ void fused(f32x4 (&acc)[2][2][4][2], const Unit& u, int wr, int wc, int fr, int fq, PG8_LAS unsigned char* lds, int wid, int lane) const {
        typedef float f32x2v __attribute__((ext_vector_type(2)));
        const PG8_LAS f32x2v* S = (const PG8_LAS f32x2v*)(lds + 8192);
        const int col0 = u.pn * BM + wc * 32 + 4 * fq;
#pragma unroll
        for (int bj = 0; bj < 2; ++bj)
#pragma unroll
            for (int n = 0; n < 2; ++n) { const f32x4 bv = bias ? *(const f32x4*)(bias + col0 + bj * HALF + n * 16) : (f32x4){0.f, 0.f, 0.f, 0.f};
#pragma unroll
                for (int ai = 0; ai < 2; ++ai)
#pragma unroll
                    for (int m = 0; m < 4; ++m) acc[ai][bj][m][n] += bv; }
        f32x4 pre[4][2][2];
#pragma unroll
        for (int m = 0; m < 4; ++m) { const size_t off = (size_t)(u.pm * BM + wr * 64 + m * 16 + fr) * ldc + col0;
#pragma unroll
            for (int bj = 0; bj < 2; ++bj)
#pragma unroll
                for (int n = 0; n < 2; ++n) pre[m][bj][n] = *(const f32x4*)(base + off + bj * HALF + n * 16); }
        const bool bad = st.run(acc, u, wr, wc, fr, fq, lds, wid, lane) || poison != 0u;
        const float qnan = __builtin_nanf("");
#pragma unroll
        for (int ai = 0; ai < 2; ++ai)
#pragma unroll
            for (int m = 0; m < 4; ++m) { const int r = ai * HALF + wr * 64 + m * 16 + fr; const f32x2v sr = S[r]; const size_t off = (size_t)(u.pm * BM + r) * ldc + col0;
#pragma unroll
                for (int bj = 0; bj < 2; ++bj)
#pragma unroll
                    for (int n = 0; n < 2; ++n) { const f32x4 bs = ai == 0 ? pre[m][bj][n] : *(const f32x4*)(base + off + bj * HALF + n * 16); f32x4 o = bs + (acc[ai][bj][m][n] - sr.x) * sr.y;
                        if (bad) o = (f32x4){qnan, qnan, qnan, qnan}; *(f32x4*)(out + off + bj * HALF + n * 16) = o; }
                if (m & 1) asm volatile("" ::: "memory"); }
    }
};
struct EpiLnResLn {
    static constexpr bool PERM = false, AFTER_DRAIN = true;
    const float* base; float* out; bf16_t* xn; int ldc; const float* bias; PanelStats st1, st2; unsigned poison;
    __device__ __forceinline__ void fused(f32x4 (&acc)[2][2][4][2], const Unit& u, int wr, int wc, int fr, int fq, PG8_LAS unsigned char* lds, int wid, int lane) const {
        typedef float f32x2v __attribute__((ext_vector_type(2))); typedef unsigned u32x2v __attribute__((ext_vector_type(2)));
        const PG8_LAS f32x2v* S = (const PG8_LAS f32x2v*)(lds + 8192);
        const int col0 = u.pn * BM + wc * 32 + 4 * fq;
#pragma unroll
        for (int bj = 0; bj < 2; ++bj)
#pragma unroll
            for (int n = 0; n < 2; ++n) { const f32x4 bv = bias ? *(const f32x4*)(bias + col0 + bj * HALF + n * 16) : (f32x4){0.f, 0.f, 0.f, 0.f};
#pragma unroll
                for (int ai = 0; ai < 2; ++ai)
#pragma unroll
                    for (int m = 0; m < 4; ++m) acc[ai][bj][m][n] += bv; }
        bool bad = st1.run(acc, u, wr, wc, fr, fq, lds, wid, lane) || poison != 0u;
        const float qnan = __builtin_nanf("");
#pragma unroll
        for (int ai = 0; ai < 2; ++ai)
#pragma unroll
            for (int m = 0; m < 4; ++m) { const int r = ai * HALF + wr * 64 + m * 16 + fr; const f32x2v sr = S[r]; const size_t off = (size_t)(u.pm * BM + r) * ldc + col0;
#pragma unroll
                for (int bj = 0; bj < 2; ++bj)
#pragma unroll
                    for (int n = 0; n < 2; ++n) { const f32x4 bs = *(const f32x4*)(base + off + bj * HALF + n * 16); acc[ai][bj][m][n] = bs + (acc[ai][bj][m][n] - sr.x) * sr.y; }
                asm volatile("" : "+v"(acc[ai][0][m][0]), "+v"(acc[ai][0][m][1]), "+v"(acc[ai][1][m][0]), "+v"(acc[ai][1][m][1]));
                if (m & 1) asm volatile("" ::: "memory"); }
        const bool bad1 = bad;
        bad = st2.run(acc, u, wr, wc, fr, fq, lds, wid, lane) || bad;
#pragma unroll
        for (int ai = 0; ai < 2; ++ai)
#pragma unroll
            for (int m = 0; m < 4; ++m) { const int r = ai * HALF + wr * 64 + m * 16 + fr; const f32x2v sr = S[r]; const size_t off = (size_t)(u.pm * BM + r) * ldc + col0;
#pragma unroll
                for (int bj = 0; bj < 2; ++bj)
#pragma unroll
                    for (int n = 0; n < 2; ++n) { const f32x4 x1 = acc[ai][bj][m][n]; *(f32x4*)(out + off + bj * HALF + n * 16) = bad1 ? (f32x4){qnan, qnan, qnan, qnan} : x1;
                        const f32x4 o = (x1 - sr.x) * sr.y; u32x2v w; w.x = cvt_pk_bf16(o[0], o[1]); w.y = cvt_pk_bf16(o[2], o[3]);
                        if (bad) { w.x = 0x7fc07fc0u; w.y = 0x7fc07fc0u; } *(u32x2v*)(xn + off + bj * HALF + n * 16) = w; }
                asm volatile("" ::: "memory"); }
    }
};

template <class Epi, class Sched, bool ALIGN_EPI = false, bool SP2 = false>
__device__ __forceinline__ void gemm_phase(PG8_LAS unsigned char* lds, const Gemm g, const Sched& S, const Epi& E) {
    const int tid = threadIdx.x, wid = __builtin_amdgcn_readfirstlane(tid >> 6), lane = tid & 63, wr = wid >> 2, wc = wid & 3, fr = lane & 15, fq = lane >> 4;
    const int K = g.K, nt = K / BK;
    unsigned voffA[2], voffB[2];
#pragma unroll
    for (int i = 0; i < 2; ++i) { int R, C; stage_rc(tid * 16 + i * 8192, R, C); const int Rb = Epi::PERM ? ((R & ~31) + perm32(R & 31)) : R;
        voffA[i] = (unsigned)(R * K + C) * 2u; voffB[i] = (unsigned)(Rb * K + C) * 2u; }
    const size_t kstep = (size_t)(BK * 2);
    const size_t hstep = (size_t)HALF * K * 2;
    const size_t tstep = 2 * hstep;
    const unsigned ldsw = (unsigned)wid * 1024u;
    const int aoff = lds_byte(wr * 64 + fr, fq * 8), boff = lds_byte(wc * 32 + fr, fq * 8);
#define PG8_SA(b, h) (((b) * 2 + (h)) * HTB)
#define PG8_SB(b, h) ((4 + (b) * 2 + (h)) * HTB)
#define PG8_STAGE(bufoff, gbase, voff) do { _Pragma("unroll") for (int _i = 0; _i < 2; ++_i) \
        __builtin_amdgcn_global_load_lds((const unsigned*)((const char*)(gbase) + (voff)[_i]), (PG8_LAS unsigned*)(lds + (bufoff) + ldsw + _i * 8192), 16, 0, 0); } while (0)
#define PG8_LDA(dst, b, h) do { _Pragma("unroll") for (int m = 0; m < 4; ++m) _Pragma("unroll") for (int k = 0; k < 2; ++k) dst[m][k] = *(const PG8_LAS bf16x8*)(lds + PG8_SA(b, h) + aoff + m * 2048 + k * 1024); } while (0)
#define PG8_LDB(dst, b, h) do { _Pragma("unroll") for (int n = 0; n < 2; ++n) _Pragma("unroll") for (int k = 0; k < 2; ++k) dst[n][k] = *(const PG8_LAS bf16x8*)(lds + PG8_SB(b, h) + boff + n * 2048 + k * 1024); } while (0)
#define PG8_MMA(ai, bj, At, Bt) do { __builtin_amdgcn_s_setprio(1); _Pragma("unroll") for (int m = 0; m < 4; ++m) _Pragma("unroll") for (int n = 0; n < 2; ++n) _Pragma("unroll") for (int k = 0; k < 2; ++k) \
        acc[ai][bj][m][n] = __builtin_amdgcn_mfma_f32_16x16x32_bf16(Bt[n][k], At[m][k], acc[ai][bj][m][n], 0, 0, 0); __builtin_amdgcn_s_setprio(0); } while (0)
#define PG8_WAIT_V(n) asm volatile("s_waitcnt vmcnt(" #n ")" ::: "memory")
#define PG8_WAIT_L(n) asm volatile("s_waitcnt lgkmcnt(" #n ")" ::: "memory")
#define PG8_BAR __builtin_amdgcn_s_barrier()
#define PG8_SCHED __builtin_amdgcn_sched_barrier(0)
    Unit cur, nxt; int ui = 0;
    if (!S.next(0, cur)) return;
    f32x4 acc[2][2][4][2];
#pragma unroll
    for (int a = 0; a < 2; ++a)
#pragma unroll
        for (int b = 0; b < 2; ++b)
#pragma unroll
            for (int m = 0; m < 4; ++m)
#pragma unroll
                for (int n = 0; n < 2; ++n) acc[a][b][m][n] = (f32x4){0.f, 0.f, 0.f, 0.f};
    bf16x8 At[4][2], B0[2][2], B1[2][2];
    const char* cA = (const char*)g.A + (size_t)cur.pm * tstep; const char* cB = (const char*)g.Bt + (size_t)cur.pn * tstep;
    S.a_ready(cur);
    if constexpr (SP2) {
        PG8_STAGE(PG8_SB(0, 0), cB, voffB); PG8_STAGE(PG8_SB(0, 1), cB + hstep, voffB); PG8_STAGE(PG8_SA(0, 0), cA, voffA); PG8_STAGE(PG8_SA(0, 1), cA + hstep, voffA);
        if (wr == 1) PG8_BAR;
        PG8_WAIT_V(2); PG8_BAR;
        PG8_STAGE(PG8_SB(1, 0), cB + kstep, voffB); PG8_STAGE(PG8_SA(1, 0), cA + kstep, voffA); PG8_STAGE(PG8_SB(1, 1), cB + hstep + kstep, voffB);
        PG8_WAIT_V(6); PG8_BAR;
    } else {
        PG8_STAGE(PG8_SB(0, 0), cB, voffB); PG8_STAGE(PG8_SA(0, 0), cA, voffA); PG8_STAGE(PG8_SB(0, 1), cB + hstep, voffB); PG8_STAGE(PG8_SA(0, 1), cA + hstep, voffA);
        if (wr == 1) PG8_BAR;
        PG8_WAIT_V(4); PG8_BAR;
        PG8_STAGE(PG8_SB(1, 0), cB + kstep, voffB); PG8_STAGE(PG8_SA(1, 0), cA + kstep, voffA); PG8_STAGE(PG8_SB(1, 1), cB + hstep + kstep, voffB);
        PG8_WAIT_V(6); PG8_BAR;
    }
    for (;;) {
        const bool has_next = S.next(ui + 1, nxt);
        const char* nA = has_next ? (const char*)g.A + (size_t)nxt.pm * tstep : cA; const char* nB = has_next ? (const char*)g.Bt + (size_t)nxt.pn * tstep : cB;
        for (int t = 0; t < nt; t += 2) {
            const bool last = (t == nt - 2);
            const char* a1 = cA + (size_t)(t + 1) * kstep;
            const char* a2 = last ? nA : cA + (size_t)(t + 2) * kstep; const char* b2 = last ? nB : cB + (size_t)(t + 2) * kstep;
            const char* a3 = a2 + kstep; const char* b3 = b2 + kstep;
            if (last && has_next) S.a_ready(nxt);
            if constexpr (SP2) {
            PG8_LDB(B0, 0, 0); PG8_LDB(B1, 0, 1); PG8_SCHED; PG8_LDA(At, 0, 0); PG8_STAGE(PG8_SA(1, 1), a1 + hstep, voffA);
            PG8_WAIT_V(8); PG8_WAIT_L(0); PG8_BAR; PG8_MMA(0, 0, At, B0); PG8_MMA(0, 1, At, B1); PG8_BAR; PG8_SCHED;
            PG8_LDA(At, 0, 1); PG8_STAGE(PG8_SB(0, 0), b2, voffB); PG8_STAGE(PG8_SB(0, 1), b2 + hstep, voffB); PG8_STAGE(PG8_SA(0, 0), a2, voffA);
            PG8_WAIT_V(8); PG8_WAIT_L(0); PG8_BAR; PG8_MMA(1, 0, At, B0); PG8_MMA(1, 1, At, B1); PG8_BAR; PG8_SCHED;
            PG8_LDB(B0, 1, 0); PG8_LDB(B1, 1, 1); PG8_SCHED; PG8_LDA(At, 1, 0); PG8_STAGE(PG8_SA(0, 1), a2 + hstep, voffA);
            PG8_WAIT_V(8); PG8_WAIT_L(0); PG8_BAR; PG8_MMA(0, 0, At, B0); PG8_MMA(0, 1, At, B1); PG8_BAR; PG8_SCHED;
            PG8_LDA(At, 1, 1); PG8_STAGE(PG8_SB(1, 0), b3, voffB); PG8_STAGE(PG8_SB(1, 1), b3 + hstep, voffB); PG8_STAGE(PG8_SA(1, 0), a3, voffA);
            PG8_WAIT_V(8); PG8_WAIT_L(0); PG8_BAR; PG8_MMA(1, 0, At, B0); PG8_MMA(1, 1, At, B1); PG8_BAR; PG8_SCHED;
            } else {
            PG8_LDB(B0, 0, 0); PG8_SCHED; PG8_LDA(At, 0, 0); PG8_STAGE(PG8_SA(1, 1), a1 + hstep, voffA);
            PG8_WAIT_L(8); PG8_BAR; PG8_WAIT_L(0); PG8_MMA(0, 0, At, B0); PG8_BAR; PG8_SCHED;
            PG8_LDB(B1, 0, 1); PG8_STAGE(PG8_SB(0, 0), b2, voffB);
            PG8_BAR; PG8_WAIT_L(0); PG8_MMA(0, 1, At, B1); PG8_BAR;
            PG8_LDA(At, 0, 1); PG8_STAGE(PG8_SA(0, 0), a2, voffA);
            PG8_BAR; PG8_WAIT_L(0); PG8_MMA(1, 0, At, B0); PG8_BAR; PG8_SCHED;
            PG8_STAGE(PG8_SB(0, 1), b2 + hstep, voffB);
            PG8_WAIT_V(6); PG8_BAR; PG8_MMA(1, 1, At, B1); PG8_BAR;
            PG8_LDB(B0, 1, 0); PG8_SCHED; PG8_LDA(At, 1, 0); PG8_STAGE(PG8_SA(0, 1), a2 + hstep, voffA);
            PG8_WAIT_L(8); PG8_BAR; PG8_WAIT_L(0); PG8_MMA(0, 0, At, B0); PG8_BAR; PG8_SCHED;
            PG8_LDB(B1, 1, 1); PG8_STAGE(PG8_SB(1, 0), b3, voffB);
            PG8_BAR; PG8_WAIT_L(0); PG8_MMA(0, 1, At, B1); PG8_BAR;
            PG8_LDA(At, 1, 1); PG8_STAGE(PG8_SA(1, 0), a3, voffA);
            PG8_BAR; PG8_WAIT_L(0); PG8_MMA(1, 0, At, B0); PG8_BAR; PG8_SCHED;
            PG8_STAGE(PG8_SB(1, 1), b3 + hstep, voffB);
            PG8_WAIT_V(6); PG8_BAR; PG8_MMA(1, 1, At, B1); PG8_BAR;
            }
        }
        if constexpr (ALIGN_EPI) { if (wr == 0) PG8_BAR; }
        if constexpr (!Epi::AFTER_DRAIN) { E(acc, cur, wr, wc, fr, fq); S.done(cur); }
        if (!has_next) break;
#pragma unroll
        for (int a = 0; a < 2; ++a)
#pragma unroll
            for (int b = 0; b < 2; ++b)
#pragma unroll
                for (int m = 0; m < 4; ++m)
#pragma unroll
                    for (int n = 0; n < 2; ++n) acc[a][b][m][n] = (f32x4){0.f, 0.f, 0.f, 0.f};
        cur = nxt; cA = nA; cB = nB; ++ui;
        if constexpr (ALIGN_EPI) { if (wr == 1) PG8_BAR; }
    }
    PG8_WAIT_V(0);
    if constexpr (!ALIGN_EPI) { if (wr == 0) PG8_BAR; }
    PG8_BAR;
    if constexpr (Epi::AFTER_DRAIN) { E.fused(acc, cur, wr, wc, fr, fq, lds, wid, lane); S.done(cur); }
#undef PG8_SA
#undef PG8_SB
#undef PG8_STAGE
#undef PG8_LDA
#undef PG8_LDB
#undef PG8_MMA
#undef PG8_WAIT_V
#undef PG8_WAIT_L
#undef PG8_BAR
#undef PG8_SCHED
}
}

#define LAS __attribute__((address_space(3)))
typedef unsigned short bf16;
typedef unsigned v4u __attribute__((ext_vector_type(4)));
typedef unsigned v2u __attribute__((ext_vector_type(2)));
typedef float f32x4 __attribute__((ext_vector_type(4)));
constexpr int NWAVES = 8, NTHR = 512;
constexpr int BATCH = 8, SEQ = 2048, M = BATCH * SEQ, D = 1024, AW = 512, NH = 8, HD = 64, SW = 512, NG = 32, GS = 16, NP = 64, DFF = 2816, NUP = 2 * DFF, INC = 2056;
constexpr float EPS = 1e-6f;
constexpr size_t MiB = 1u << 20;
constexpr size_t WS_WIN = 1 * MiB, WS_WGLU = 5 * MiB, WS_WOUT = 6 * MiB, WS_WUP = 8 * MiB, WS_WDN = 19 * MiB;
constexpr size_t WS_TAB = 25 * MiB;
constexpr size_t TB_LOGF = 0, TB_CUM = 512 * 1024, TB_LB = 1024 * 1024, TB_BB = TB_LB + 16384, TB_END = TB_BB + 262144;
constexpr size_t WS_XB = 32 * MiB;
constexpr size_t WS_Q = 64 * MiB, WS_K = 80 * MiB, WS_V = 96 * MiB, WS_U = 112 * MiB, WS_YG = 128 * MiB, WS_MIX = 144 * MiB;
constexpr size_t WS_UPH = 64 * MiB, WS_ACT = 152 * MiB, WS_END = 240 * MiB;
constexpr int LDS_BYTES = 147456, RING_BYTES = 131072;

__device__ __forceinline__ float bf2f(unsigned v) { return __uint_as_float(v << 16); }
__device__ __forceinline__ unsigned f2bf(float f) { unsigned u = __float_as_uint(f); return (u + 0x7fffu + ((u >> 16) & 1u)) >> 16; }
__device__ __forceinline__ unsigned pk2(float lo, float hi) { return f2bf(lo) | (f2bf(hi) << 16); }
__device__ __forceinline__ float wave_sum(float v) {
#pragma unroll
    for (int o = 1; o < 64; o <<= 1) v += __shfl_xor(v, o);
    return v;
}
__device__ __forceinline__ void unpack8(const v4u w, float* f) {
    f[0] = bf2f(w.x & 0xffffu); f[1] = bf2f(w.x >> 16); f[2] = bf2f(w.y & 0xffffu); f[3] = bf2f(w.y >> 16);
    f[4] = bf2f(w.z & 0xffffu); f[5] = bf2f(w.z >> 16); f[6] = bf2f(w.w & 0xffffu); f[7] = bf2f(w.w >> 16);
}
__device__ __forceinline__ v4u pack8(const float* f) { v4u w; w.x = pk2(f[0], f[1]); w.y = pk2(f[2], f[3]); w.z = pk2(f[4], f[5]); w.w = pk2(f[6], f[7]); return w; }

namespace pg8 {
struct EpiPlain {
    static constexpr bool PERM = true, AFTER_DRAIN = false;
    bf16_t* O; int ldc; int split_cols; size_t split_stride;
    __device__ __forceinline__ void operator()(const f32x4 (&acc)[2][2][4][2], const Unit& u, int wr, int wc, int fr, int fq) const {
        const int row0 = u.pm * BM + wr * 64 + fr; int colt = u.pn * BM; bf16_t* base = O;
        if (split_cols) { const int t = colt / split_cols; base += (size_t)t * split_stride; colt -= t * split_cols; }
        const int col0 = colt + wc * 32 + 8 * fq;
#pragma unroll
        for (int ai = 0; ai < 2; ++ai)
#pragma unroll
            for (int m = 0; m < 4; ++m) { bf16_t* rowp = base + (size_t)(row0 + ai * HALF + m * 16) * ldc + col0;
#pragma unroll
                for (int bj = 0; bj < 2; ++bj) { const f32x4 v0 = acc[ai][bj][m][0], v1 = acc[ai][bj][m][1];
                    u32x4 w; w.x = cvt_pk_bf16(v0[0], v0[1]); w.y = cvt_pk_bf16(v0[2], v0[3]); w.z = cvt_pk_bf16(v1[0], v1[1]); w.w = cvt_pk_bf16(v1[2], v1[3]);
                    *(u32x4*)(rowp + bj * HALF) = w; } }
    }
};
struct EpiGlu {
    static constexpr bool PERM = true, AFTER_DRAIN = false;
    const bf16_t* YG; const float* bias; bf16_t* O; int ldo; int ocol0;
    __device__ __forceinline__ void operator()(const f32x4 (&acc)[2][2][4][2], const Unit& u, int wr, int wc, int fr, int fq) const {
        const int row0 = u.pm * BM + wr * 64 + fr; const int col0 = u.pn * BM + wc * 32 + 8 * fq;
#pragma unroll
        for (int ai = 0; ai < 2; ++ai)
#pragma unroll
            for (int m = 0; m < 4; ++m) { const int row = row0 + ai * HALF + m * 16;
#pragma unroll
                for (int bj = 0; bj < 2; ++bj) { const int col = col0 + bj * HALF;
                    const f32x4 b0 = *(const f32x4*)(bias + col), b1 = *(const f32x4*)(bias + col + 4);
                    const f32x4 v0 = acc[ai][bj][m][0] + b0, v1 = acc[ai][bj][m][1] + b1;
                    const u32x4 yw = *(const u32x4*)(YG + (size_t)row * 512 + col);
                    float y[8]; y[0] = __uint_as_float(yw.x << 16); y[1] = __uint_as_float(yw.x & 0xffff0000u); y[2] = __uint_as_float(yw.y << 16); y[3] = __uint_as_float(yw.y & 0xffff0000u);
                    y[4] = __uint_as_float(yw.z << 16); y[5] = __uint_as_float(yw.z & 0xffff0000u); y[6] = __uint_as_float(yw.w << 16); y[7] = __uint_as_float(yw.w & 0xffff0000u);
                    float o[8];
#pragma unroll
                    for (int i = 0; i < 4; ++i) { o[i] = y[i] / (1.f + __expf(-v0[i])); o[4 + i] = y[4 + i] / (1.f + __expf(-v1[i])); }
                    u32x4 w; w.x = cvt_pk_bf16(o[0], o[1]); w.y = cvt_pk_bf16(o[2], o[3]); w.z = cvt_pk_bf16(o[4], o[5]); w.w = cvt_pk_bf16(o[6], o[7]);
                    *(u32x4*)(O + (size_t)row * ldo + ocol0 + col) = w; } }
    }
};
struct EpiRes {
    static constexpr bool PERM = true, AFTER_DRAIN = false;
    const float* base; float* out; int ldc;
    __device__ __forceinline__ void operator()(const f32x4 (&acc)[2][2][4][2], const Unit& u, int wr, int wc, int fr, int fq) const {
        const int row0 = u.pm * BM + wr * 64 + fr; const int col0 = u.pn * BM + wc * 32 + 8 * fq;
#pragma unroll
        for (int ai = 0; ai < 2; ++ai)
#pragma unroll
            for (int m = 0; m < 4; ++m) { const size_t off = (size_t)(row0 + ai * HALF + m * 16) * ldc + col0;
#pragma unroll
                for (int bj = 0; bj < 2; ++bj) {
                    const f32x4 x0 = *(const f32x4*)(base + off + bj * HALF), x1 = *(const f32x4*)(base + off + bj * HALF + 4);
                    *(f32x4*)(out + off + bj * HALF) = x0 + acc[ai][bj][m][0]; *(f32x4*)(out + off + bj * HALF + 4) = x1 + acc[ai][bj][m][1]; } }
    }
};
}

struct Args { const float* in[24]; float* out; unsigned char* ws; int ph_lo, ph_hi; };

__device__ __forceinline__ void transpose_item(const float* W, int K, int ldn, bf16* WT, int k0, int src_n0, int dst_n0, const float* g0, const float* g1, int gsplit, LAS float* scr, int lane) {
#pragma unroll 8
    for (int i = 0; i < 32; ++i) { const int kk = 2 * i + (lane >> 5); const int k = k0 + kk;
        float s = 1.f; if (g0) s = (k < gsplit) ? g0[k] : g1[k - gsplit];
        scr[kk * 33 + (lane & 31)] = W[(size_t)k * ldn + src_n0 + (lane & 31)] * s; }
    asm volatile("s_waitcnt lgkmcnt(0)" ::: "memory");
    const int c = lane & 7;
#pragma unroll
    for (int j = 0; j < 4; ++j) { const int n = (lane >> 3) + 8 * j; const LAS float* s = scr + (8 * c) * 33 + n;
        v4u o; o.x = pk2(s[0 * 33], s[1 * 33]); o.y = pk2(s[2 * 33], s[3 * 33]); o.z = pk2(s[4 * 33], s[5 * 33]); o.w = pk2(s[6 * 33], s[7 * 33]);
        *(v4u*)(WT + (size_t)(dst_n0 + n) * K + k0 + 8 * c) = o; }
    asm volatile("s_waitcnt lgkmcnt(0)" ::: "memory");
}
__device__ __forceinline__ float log_sigmoid(float z) { return fminf(z, 0.f) - log1pf(expf(-fabsf(z))); }

__device__ __forceinline__ void p0_prologue(const Args& a, LAS unsigned char* lds, int gw, int NGW, int wave, int lane) {
    unsigned char* ws = a.ws;
    LAS float* scr = (LAS float*)(lds + wave * 16384);
    constexpr int I_IN = 16 * 64, I_GLU = 8 * 16, I_OUT = 16 * 32, I_UP = 16 * 176, I_DN = 44 * 32, NITEMS = I_IN + I_GLU + I_OUT + I_UP + I_DN;
    for (int it = gw; it < NITEMS; it += NGW) {
        int r = it;
        if (r < I_IN) { const int kb = r / 64, nb = r % 64, dn = 32 * nb; transpose_item(a.in[2], D, INC, (bf16*)(ws + WS_WIN), 64 * kb, dn < 1536 ? dn : dn + 8, dn, a.in[1], a.in[1], D, scr, lane); continue; } r -= I_IN;
        if (r < I_GLU) { const int kb = r / 16, nb = r % 16; transpose_item(a.in[14], SW, SW, (bf16*)(ws + WS_WGLU), 64 * kb, 32 * nb, 32 * nb, nullptr, nullptr, 0, scr, lane); continue; } r -= I_GLU;
        if (r < I_OUT) { const int kb = r / 32, nb = r % 32; transpose_item(a.in[18], D, D, (bf16*)(ws + WS_WOUT), 64 * kb, 32 * nb, 32 * nb, a.in[16], a.in[17], AW, scr, lane); continue; } r -= I_OUT;
        if (r < I_UP) { const int kb = r / 176, nb = r % 176; transpose_item(a.in[20], D, NUP, (bf16*)(ws + WS_WUP), 64 * kb, 32 * nb, 32 * nb, a.in[19], a.in[19], D, scr, lane); continue; } r -= I_UP;
        { const int kb = r / 32, nb = r % 32; transpose_item(a.in[23], DFF, D, (bf16*)(ws + WS_WDN), 64 * kb, 32 * nb, 32 * nb, nullptr, nullptr, 0, scr, lane); }
    }
    {
        const float* x = a.in[0]; const float* gm = a.in[1]; const float* win = a.in[2]; const float* bfv = a.in[3];
        float* logf = (float*)(ws + WS_TAB + TB_LOGF); bf16* XB = (bf16*)(ws + WS_XB);
        float wf[4][4][8];
#pragma unroll
        for (int j = 0; j < 4; ++j)
#pragma unroll
            for (int i = 0; i < 4; ++i) { const int k = 4 * lane + 256 * j + i; const float g = gm[k];
                const f32x4 w0 = *(const f32x4*)(win + (size_t)k * INC + 1536), w1 = *(const f32x4*)(win + (size_t)k * INC + 1540);
                wf[j][i][0] = w0[0] * g; wf[j][i][1] = w0[1] * g; wf[j][i][2] = w0[2] * g; wf[j][i][3] = w0[3] * g;
                wf[j][i][4] = w1[0] * g; wf[j][i][5] = w1[1] * g; wf[j][i][6] = w1[2] * g; wf[j][i][7] = w1[3] * g; }
        for (int m = gw; m < M; m += NGW) {
            const f32x4* xr = (const f32x4*)(x + (size_t)m * D) + lane;
            f32x4 v[4]; float s = 0.f;
#pragma unroll
            for (int j = 0; j < 4; ++j) { v[j] = xr[64 * j]; s += (v[j][0] * v[j][0] + v[j][1] * v[j][1]) + (v[j][2] * v[j][2] + v[j][3] * v[j][3]); }
            const float rstd = 1.f / sqrtf(wave_sum(s) * (1.f / D) + EPS);
            float dt[8];
#pragma unroll
            for (int h = 0; h < 8; ++h) { float t = 0.f;
#pragma unroll
                for (int j = 0; j < 4; ++j)
#pragma unroll
                    for (int i = 0; i < 4; ++i) t += v[j][i] * wf[j][i][h];
                dt[h] = wave_sum(t); }
            float mine = dt[0];
#pragma unroll
            for (int h = 1; h < 8; ++h) mine = (lane == h) ? dt[h] : mine;
            if (lane < 8) logf[(size_t)m * 8 + lane] = log_sigmoid(mine * rstd + bfv[lane]);
            unsigned long long* o8 = (unsigned long long*)(XB + (size_t)m * D) + lane;
#pragma unroll
            for (int j = 0; j < 4; ++j) o8[64 * j] = (unsigned long long)pk2(v[j][0] * rstd, v[j][1] * rstd) | ((unsigned long long)pk2(v[j][2] * rstd, v[j][3] * rstd) << 32);
        }
    }
    {
        const float* lre = a.in[6]; const float* lim = a.in[7]; const float* lst = a.in[8]; const float* bre = a.in[9]; const float* bim = a.in[10];
        float* LB = (float*)(ws + WS_TAB + TB_LB); float* BB = (float*)(ws + WS_TAB + TB_BB);
        const int gt = gw * 64 + lane;
        for (int i = gt; i < NG * NP; i += NGW * 64) {
            const int g = i / NP; const float lr = lre[i], li = lim[i], step = expf(lst[g]);
            const float er = expf(lr * step), ar = er * cosf(li * step), ai = er * sinf(li * step);
            const float nr = ar - 1.f, ni = ai, den = lr * lr + li * li;
            const float fr = (nr * lr + ni * li) / den, fi = (ni * lr - nr * li) / den;
            LB[2 * i] = ar; LB[2 * i + 1] = ai;
#pragma unroll
            for (int h = 0; h < GS; ++h) { const float br = bre[(size_t)i * GS + h], bi = bim[(size_t)i * GS + h];
                BB[((size_t)i * GS + h) * 2] = fr * br - fi * bi; BB[((size_t)i * GS + h) * 2 + 1] = fr * bi + fi * br; }
        }
    }
}

__device__ __forceinline__ void p1b_qknorm_cumsum(const Args& a, int gw, int NGW, int wave, int lane) {
    unsigned char* ws = a.ws;
    const float* gq = a.in[4]; const float* gk = a.in[5];
    for (int it = gw; it < 2 * M; it += NGW) {
        const int which = it / M, m = it % M;
        bf16* row = (bf16*)(ws + (which ? WS_K : WS_Q)) + (size_t)m * AW; const float* g = which ? gk : gq;
        v4u w = *(const v4u*)(row + 8 * lane); float f[8]; unpack8(w, f);
        float s = 0.f;
#pragma unroll
        for (int i = 0; i < 8; ++i) s += f[i] * f[i];
        s += __shfl_xor(s, 1); s += __shfl_xor(s, 2); s += __shfl_xor(s, 4);
        const float rstd = 1.f / sqrtf(s * (1.f / HD) + EPS);
        const int d0 = (8 * lane) & 63;
#pragma unroll
        for (int i = 0; i < 8; ++i) f[i] = f[i] * rstd * g[d0 + i];
        *(v4u*)(row + 8 * lane) = pack8(f);
    }
    const float* logf = (const float*)(ws + WS_TAB + TB_LOGF); float* cum = (float*)(ws + WS_TAB + TB_CUM);
    for (int bh = gw; bh < BATCH * NH; bh += NGW) {
        const int b = bh / NH, h = bh % NH; float loc[32]; float t = 0.f;
#pragma unroll
        for (int i = 0; i < 32; ++i) { t += logf[((size_t)b * SEQ + 32 * lane + i) * 8 + h]; loc[i] = t; }
        float incl = t;
#pragma unroll
        for (int o = 1; o < 64; o <<= 1) { const float n = __shfl_up(incl, o); if (lane >= o) incl += n; }
        const float excl = incl - t;
#pragma unroll
        for (int i = 0; i < 32; ++i) cum[(size_t)bh * SEQ + 32 * lane + i] = loc[i] + excl;
    }
}

__device__ __forceinline__ void p2_attn_naive(const Args& a, int vcu, int wave, int lane) {
    unsigned char* ws = a.ws;
    const bf16* Q = (const bf16*)(ws + WS_Q); const bf16* K = (const bf16*)(ws + WS_K); const bf16* V = (const bf16*)(ws + WS_V); bf16* MIX = (bf16*)(ws + WS_MIX);
    const float* cum = (const float*)(ws + WS_TAB + TB_CUM);
    const int bh = vcu >> 2, b = bh / NH, h = bh % NH, tb = wave * 4 + (vcu & 3), t = tb * 64 + lane;
    const size_t rowq = (size_t)b * SEQ + t;
    float q[64];
#pragma unroll
    for (int c = 0; c < 8; ++c) { const v4u w = *(const v4u*)(Q + rowq * AW + h * HD + 8 * c); unpack8(w, q + 8 * c); }
    const float cq = cum[(size_t)bh * SEQ + t];
    float mx = -1e30f, l = 0.f, o[64];
#pragma unroll
    for (int d = 0; d < 64; ++d) o[d] = 0.f;
    const int smax = tb * 64 + 63;
    for (int s = 0; s <= smax; ++s) {
        const bf16* kr = K + ((size_t)b * SEQ + s) * AW + h * HD; const bf16* vr = V + ((size_t)b * SEQ + s) * AW + h * HD;
        float dot = 0.f;
#pragma unroll
        for (int c = 0; c < 8; ++c) { const v4u w = *(const v4u*)(kr + 8 * c); float f[8]; unpack8(w, f);
#pragma unroll
            for (int i = 0; i < 8; ++i) dot += q[8 * c + i] * f[i]; }
        float lg = dot * 0.125f + cq - cum[(size_t)bh * SEQ + s];
        if (s > t) lg = -1e30f;
        const float mn = fmaxf(mx, lg), sc = __expf(mx - mn), p = (s > t) ? 0.f : __expf(lg - mn);
        l = l * sc + p; mx = mn;
#pragma unroll
        for (int c = 0; c < 8; ++c) { const v4u w = *(const v4u*)(vr + 8 * c); float f[8]; unpack8(w, f);
#pragma unroll
            for (int i = 0; i < 8; ++i) o[8 * c + i] = o[8 * c + i] * sc + p * f[i]; }
    }
    const float il = 1.f / l;
#pragma unroll
    for (int c = 0; c < 8; ++c) { float f[8];
#pragma unroll
        for (int i = 0; i < 8; ++i) f[i] = o[8 * c + i] * il;
        *(v4u*)(MIX + rowq * D + h * HD + 8 * c) = pack8(f); }
}

__device__ __forceinline__ float gelu_tanh(float x) { const float u = 0.7978845608028654f * (x + 0.044715f * x * x * x); return 0.5f * x * (1.f + tanhf(u)); }
__device__ __forceinline__ void p2_ssm_naive(const Args& a, LAS unsigned char* lds, int unit, int tid, int wave, int lane) {
    unsigned char* ws = a.ws;
    const int b = unit / NG, g = unit % NG;
    const bf16* U = (const bf16*)(ws + WS_U); bf16* YG = (bf16*)(ws + WS_YG);
    const float* LB = (const float*)(ws + WS_TAB + TB_LB); const float* BB = (const float*)(ws + WS_TAB + TB_BB);
    const float* cre = a.in[11]; const float* cim = a.in[12]; const float* dsk = a.in[13];
    LAS float* uS = (LAS float*)lds;
    LAS float* xS = (LAS float*)(lds + 4096);
    LAS float* cS = (LAS float*)(lds + 4096 + 32768);
    for (int i = tid; i < GS * NP; i += NTHR) { cS[2 * i] = cre[(size_t)g * GS * NP + i]; cS[2 * i + 1] = -cim[(size_t)g * GS * NP + i]; }
    float xr = 0.f, xi = 0.f, lr = 0.f, li = 0.f, br[GS], bi[GS];
    if (wave == 0) { lr = LB[2 * (g * NP + lane)]; li = LB[2 * (g * NP + lane) + 1];
#pragma unroll
        for (int h = 0; h < GS; ++h) { br[h] = BB[((size_t)(g * NP + lane) * GS + h) * 2]; bi[h] = BB[((size_t)(g * NP + lane) * GS + h) * 2 + 1]; } }
    for (int t0 = 0; t0 < SEQ; t0 += 64) {
        __syncthreads();
        for (int i = tid; i < 64 * GS; i += NTHR) { const int s = i / GS, h = i % GS; uS[i] = bf2f(U[((size_t)b * SEQ + t0 + s) * SW + g * GS + h]); }
        __syncthreads();
        if (wave == 0) {
            for (int s = 0; s < 64; ++s) { float ur = 0.f, ui = 0.f;
#pragma unroll
                for (int h = 0; h < GS; ++h) { const float uv = uS[s * GS + h]; ur += br[h] * uv; ui += bi[h] * uv; }
                const float nr = lr * xr - li * xi + ur, ni = lr * xi + li * xr + ui; xr = nr; xi = ni;
                xS[(s * NP + lane) * 2] = xr; xS[(s * NP + lane) * 2 + 1] = xi; }
        }
        __syncthreads();
        for (int i = tid; i < 64 * GS; i += NTHR) { const int s = i / GS, h = i % GS; float y = 0.f;
            for (int p = 0; p < NP; ++p) y += cS[(h * NP + p) * 2] * xS[(s * NP + p) * 2] + cS[(h * NP + p) * 2 + 1] * xS[(s * NP + p) * 2 + 1];
            y += dsk[g * GS + h] * uS[i];
            YG[((size_t)b * SEQ + t0 + s) * SW + g * GS + h] = (bf16)f2bf(gelu_tanh(y)); }
    }
    __syncthreads();
}

__device__ __forceinline__ void p3b_mixnorm(const Args& a, int gw, int NGW, int lane) {
    bf16* MIX = (bf16*)(a.ws + WS_MIX);
    for (int m = gw; m < M; m += NGW) {
        bf16* row = MIX + (size_t)m * D + 16 * lane; v4u w0 = *(const v4u*)row, w1 = *(const v4u*)(row + 8); float f[16]; unpack8(w0, f); unpack8(w1, f + 8);
        float s = 0.f;
#pragma unroll
        for (int i = 0; i < 16; ++i) s += f[i] * f[i];
        s += __shfl_xor(s, 1); s += __shfl_xor(s, 2); s += __shfl_xor(s, 4); s += __shfl_xor(s, 8); s += __shfl_xor(s, 16);
        const float rstd = 1.f / sqrtf(s * (1.f / 512.f) + EPS);
#pragma unroll
        for (int i = 0; i < 16; ++i) f[i] *= rstd;
        *(v4u*)row = pack8(f); *(v4u*)(row + 8) = pack8(f + 8);
    }
}
__device__ __forceinline__ void p4b_x1norm(const Args& a, int gw, int NGW, int lane) {
    bf16* XB = (bf16*)(a.ws + WS_XB);
    for (int m = gw; m < M; m += NGW) {
        const f32x4* xr = (const f32x4*)(a.out + (size_t)m * D) + lane; f32x4 v[4]; float s = 0.f;
#pragma unroll
        for (int j = 0; j < 4; ++j) { v[j] = xr[64 * j]; s += (v[j][0] * v[j][0] + v[j][1] * v[j][1]) + (v[j][2] * v[j][2] + v[j][3] * v[j][3]); }
        const float rstd = 1.f / sqrtf(wave_sum(s) * (1.f / D) + EPS);
        unsigned long long* o8 = (unsigned long long*)(XB + (size_t)m * D) + lane;
#pragma unroll
        for (int j = 0; j < 4; ++j) o8[64 * j] = (unsigned long long)pk2(v[j][0] * rstd, v[j][1] * rstd) | ((unsigned long long)pk2(v[j][2] * rstd, v[j][3] * rstd) << 32);
    }
}
__device__ __forceinline__ void p5b_convgate(const Args& a, int r0, int gtid, int NT) {
    const bf16* UPH = (const bf16*)(a.ws + WS_UPH); bf16* ACT = (bf16*)(a.ws + WS_ACT);
    const float* cw = a.in[21]; const float* cb = a.in[22];
    constexpr int C8 = DFF / 8;
    for (int it = gtid; it < 8192 * C8; it += NT) {
        const int tl = it / C8, c = (it % C8) * 8, pos = (r0 + tl) % SEQ;
        float hg[8], hv[8];
#pragma unroll
        for (int i = 0; i < 8; ++i) { hg[i] = cb[c + i]; hv[i] = cb[DFF + c + i]; }
#pragma unroll
        for (int j = 0; j < 3; ++j) { const int dt = 2 - j; if (pos >= dt) {
                const bf16* r = UPH + (size_t)(tl - dt) * NUP; float fg[8], fv[8]; unpack8(*(const v4u*)(r + c), fg); unpack8(*(const v4u*)(r + DFF + c), fv);
#pragma unroll
                for (int i = 0; i < 8; ++i) { hg[i] += cw[(size_t)j * NUP + c + i] * fg[i]; hv[i] += cw[(size_t)j * NUP + DFF + c + i] * fv[i]; } } }
        float o[8];
#pragma unroll
        for (int i = 0; i < 8; ++i) o[i] = hg[i] / (1.f + __expf(-hg[i])) * hv[i];
        *(v4u*)(ACT + (size_t)(r0 + tl) * DFF + c) = pack8(o);
    }
}

__global__ void __launch_bounds__(NTHR, 2) fwd_kernel(Args args) {
    extern __shared__ __attribute__((aligned(16))) unsigned char lds_raw[];
    LAS unsigned char* lds = (LAS unsigned char*)lds_raw;
    cg::grid_group grid = cg::this_grid();
    const int tid = threadIdx.x, lane = tid & 63, wave = __builtin_amdgcn_readfirstlane(tid >> 6);
    const int G = gridDim.x, bx = blockIdx.x, vcu = (G % 8 == 0) ? (bx % 8) * (G / 8) + bx / 8 : bx;
    const int gw = vcu * NWAVES + wave, NGW = G * NWAVES, gtid = vcu * NTHR + tid, NT = G * NTHR;
    unsigned char* ws = args.ws;
    const int lo = args.ph_lo, hi = args.ph_hi;
#define IN(k) (lo <= (k) && (k) < hi)
#define SYNC(k) do { if (IN(k) && IN((k) + 1)) grid.sync(); } while (0)
    if (IN(0)) { p0_prologue(args, lds, gw, NGW, wave, lane); } SYNC(0);
    if (IN(1)) {
        pg8::Gemm g{(const pg8::bf16_t*)(ws + WS_XB), (const pg8::bf16_t*)(ws + WS_WIN), M, 2048, D}; pg8::StaticOrder S; S.init(M, 2048, G, bx);
        pg8::EpiPlain E{(pg8::bf16_t*)(ws + WS_Q), AW, 512, (size_t)M * AW};
        pg8::gemm_phase<pg8::EpiPlain, pg8::StaticOrder, true, true>(lds, g, S, E);
    } SYNC(1);
    if (IN(2)) { p1b_qknorm_cumsum(args, gw, NGW, wave, lane); } SYNC(2);
    if (IN(3)) {
        if (G == 256) p2_attn_naive(args, vcu, wave, lane);
        for (int u = bx; u < BATCH * NG; u += G) p2_ssm_naive(args, lds, u, tid, wave, lane);
    } SYNC(3);
    if (IN(4)) {
        pg8::Gemm g{(const pg8::bf16_t*)(ws + WS_YG), (const pg8::bf16_t*)(ws + WS_WGLU), M, SW, SW}; pg8::StaticOrder S; S.init(M, SW, G, bx);
        pg8::EpiGlu E{(const pg8::bf16_t*)(ws + WS_YG), args.in[15], (pg8::bf16_t*)(ws + WS_MIX), D, AW};
        pg8::gemm_phase<pg8::EpiGlu, pg8::StaticOrder, true, true>(lds, g, S, E);
    } SYNC(4);
    if (IN(5)) { p3b_mixnorm(args, gw, NGW, lane); } SYNC(5);
    if (IN(6)) {
        pg8::Gemm g{(const pg8::bf16_t*)(ws + WS_MIX), (const pg8::bf16_t*)(ws + WS_WOUT), M, D, D}; pg8::StaticOrder S; S.init(M, D, G, bx);
        pg8::EpiRes E{args.in[0], args.out, D};
        pg8::gemm_phase<pg8::EpiRes, pg8::StaticOrder, true, true>(lds, g, S, E);
    } SYNC(6);
    if (IN(7)) { p4b_x1norm(args, gw, NGW, lane); } SYNC(7);
#pragma unroll 1
    for (int half = 0; half < 2; ++half) {
        if (IN(8 + 2 * half)) {
            pg8::Gemm g{(const pg8::bf16_t*)(ws + WS_XB) + (size_t)half * 8192 * D, (const pg8::bf16_t*)(ws + WS_WUP), 8192, NUP, D}; pg8::StaticOrder S; S.init(8192, NUP, G, bx);
            pg8::EpiPlain E{(pg8::bf16_t*)(ws + WS_UPH), NUP, 0, 0};
            pg8::gemm_phase<pg8::EpiPlain, pg8::StaticOrder, true, true>(lds, g, S, E);
        } SYNC(8 + 2 * half);
        if (IN(9 + 2 * half)) { p5b_convgate(args, half * 8192, gtid, NT); } SYNC(9 + 2 * half);
    }
    if (IN(12)) {
        pg8::Gemm g{(const pg8::bf16_t*)(ws + WS_ACT), (const pg8::bf16_t*)(ws + WS_WDN), M, D, DFF}; pg8::StaticOrder S; S.init(M, D, G, bx);
        pg8::EpiRes E{args.out, args.out, D};
        pg8::gemm_phase<pg8::EpiRes, pg8::StaticOrder, true, true>(lds, g, S, E);
    }
#undef IN
#undef SYNC
}

constexpr int N_PHASES = 13;
#ifndef MK_MULTI
#define MK_MULTI 0
#endif
extern "C" void kernel_launch(void* const* d_in, const int* in_sizes, int n_in, void* d_out, int out_size, void* d_ws, size_t ws_size, hipStream_t stream) {
    static int grid = 0;
    if (grid == 0) {
        if (n_in != 24 || out_size != M * D || ws_size < WS_END) { fprintf(stderr, "kernel_launch: unexpected sizes n_in %d out %d ws %zu\n", n_in, out_size, ws_size); grid = -1; return; }
        int dev = 0, cus = 0, per_cu = 0;
        hipGetDevice(&dev); hipDeviceGetAttribute(&cus, hipDeviceAttributeMultiprocessorCount, dev);
        hipFuncSetAttribute((const void*)fwd_kernel, hipFuncAttributeMaxDynamicSharedMemorySize, LDS_BYTES);
        hipOccupancyMaxActiveBlocksPerMultiprocessor(&per_cu, (const void*)fwd_kernel, NTHR, LDS_BYTES);
        (void)hipGetLastError();
        if (per_cu < 1) { fprintf(stderr, "kernel_launch: occupancy query says %d blocks per CU\n", per_cu); per_cu = 1; }
        grid = cus * 1;
        fprintf(stderr, "kernel_launch: cus %d per_cu %d grid %d\n", cus, per_cu, grid);
    }
    if (grid < 0) return;
    Args a{};
    for (int i = 0; i < 24; ++i) a.in[i] = (const float*)d_in[i];
    a.out = (float*)d_out; a.ws = (unsigned char*)d_ws;
#if MK_MULTI
    for (int p = 0; p < N_PHASES; ++p) { a.ph_lo = p; a.ph_hi = p + 1; hipLaunchKernelGGL(fwd_kernel, dim3(grid), dim3(NTHR), LDS_BYTES, stream, a); }
#else
    a.ph_lo = 0; a.ph_hi = N_PHASES;
    void* kargs[] = {&a};
    hipError_t e = hipLaunchCooperativeKernel((const void*)fwd_kernel, dim3(grid), dim3(NTHR), kargs, LDS_BYTES, stream);
    if (e != hipSuccess) fprintf(stderr, "cooperative launch failed: %s (grid %d)\n", hipGetErrorString(e), grid);
#endif
}
```

```cpp
#include <hip/hip_runtime.h>
#include <hip/hip_cooperative_groups.h>
#include <cstdio>
#include <cstdint>
namespace cg = cooperative_groups;
namespace pg8 {
#define PG8_LAS __attribute__((address_space(3)))
typedef unsigned short bf16_t;
typedef short bf16x8 __attribute__((ext_vector_type(8)));
typedef float f32x4 __attribute__((ext_vector_type(4)));
typedef unsigned u32x4 __attribute__((ext_vector_type(4)));
constexpr int BM = 256, BK = 64, HALF = 128, HTB = HALF * BK * 2  , STAGE_BYTES = 8 * HTB, NXCD = 8, WGM = 8;

__host__ __device__ __forceinline__ int lds_byte(int r, int c) { const int st = (r >> 4) * 2 + (c >> 5), rr = r & 15, cc = c & 31, ob = rr * 64 + cc * 2; return st * 1024 + (ob ^ (((ob >> 9) & 1) << 5)); }
__host__ __device__ __forceinline__ void stage_rc(int b, int& R, int& C) { const int st = b / 1024, sb = b % 1024, swz = sb ^ (((sb >> 9) & 1) << 5); R = (st >> 1) * 16 + swz / 64; C = (st & 1) * 32 + (swz % 64) / 2; }
__host__ __device__ __forceinline__ int perm32(int rho) { const int n = rho >> 4, i = rho & 15; return 8 * (i >> 2) + 4 * n + (i & 3); }

struct Unit { int pm, pn; };
struct Gemm { const bf16_t* A; const bf16_t* Bt; int M, N, K; };

struct StaticOrder {
    int nM, nN, nwg, G, c;
    __host__ __device__ void init(int M, int N, int G_, int c_) { nM = M / BM; nN = N / BM; nwg = nM * nN; G = G_; c = c_; }
    __host__ __device__ bool next(int i, Unit& u) const {
        const long L = (long)i * G + c; if (L >= nwg) return false;
        int wgid = (int)L; { const int q = nwg / NXCD, r = nwg % NXCD, xcd = wgid % NXCD, off = wgid / NXCD; wgid = (xcd < r ? xcd * (q + 1) : r * (q + 1) + (xcd - r) * q) + off; }
        const int nig = WGM * nN, gid = wgid / nig, fm = gid * WGM, gsz = (nM - fm) < WGM ? (nM - fm) : WGM;
        u.pm = fm + ((wgid % nig) % gsz); u.pn = (wgid % nig) / gsz; return true;
    }
    __device__ __forceinline__ void a_ready(const Unit&) const {}
    __device__ __forceinline__ void done(const Unit&) const {}
};

__device__ __forceinline__ unsigned cvt_pk_bf16(float lo, float hi) { unsigned r; asm volatile("v_cvt_pk_bf16_f32 %0, %1, %2" : "=v"(r) : "v"(lo), "v"(hi)); return r; }
typedef float f32x2 __attribute__((ext_vector_type(2)));
__device__ __forceinline__ f32x2 gelu_pk(f32x2 v) {
    const f32x2 av = __builtin_elementwise_abs(v), d = av * 0.2316418882f + 1.0f;
    f32x2 t; t.x = __builtin_amdgcn_rcpf(d.x); t.y = __builtin_amdgcn_rcpf(d.y);
    f32x2 q = t * 0.5307027145f + (-0.7265760135f); q = q * t + 0.7107068705f; q = q * t + (-0.142248368f); q = q * t + 0.127414796f; q = q * t;
    const f32x2 s = (v * v) * (-0.72134752044f);
    f32x2 e; e.x = __builtin_amdgcn_exp2f(s.x); e.y = __builtin_amdgcn_exp2f(s.y);
    const f32x2 m = v * (q * e), r = v - m;
    f32x2 o; o.x = v.x < 0.f ? m.x : r.x; o.y = v.y < 0.f ? m.y : r.y; return o;
}

template <int ACT  > struct EpiBf16 {
    static constexpr bool PERM = true, AFTER_DRAIN = false; static_assert(ACT == 0 || ACT == 1, "EpiBf16: ACT is 0 (none) or 1 (gelu_pk)");
    bf16_t* O; int ldc; const float* bias; int split_cols; size_t split_stride; float scale0;
    __device__ __forceinline__ void operator()(const f32x4 (&acc)[2][2][4][2], const Unit& u, int wr, int wc, int fr, int fq) const {
        const int row0 = u.pm * BM + wr * 64 + fr; int colt = u.pn * BM; bf16_t* base = O;
        float sc = 1.f; if (split_cols) { const int t = colt / split_cols; base += (size_t)t * split_stride; colt -= t * split_cols; if (t == 0) sc = scale0; }
        const int col0 = colt + wc * 32 + 8 * fq, bcol0 = u.pn * BM + wc * 32 + 8 * fq;
        f32x4 bv[2][2];
#pragma unroll
        for (int bj = 0; bj < 2; ++bj)
#pragma unroll
            for (int n = 0; n < 2; ++n) bv[bj][n] = bias ? *(const f32x4*)(bias + bcol0 + bj * HALF + 4 * n) : (f32x4){0.f, 0.f, 0.f, 0.f};
#pragma unroll
        for (int ai = 0; ai < 2; ++ai)
#pragma unroll
            for (int m = 0; m < 4; ++m) { bf16_t* rowp = base + (size_t)(row0 + ai * HALF + m * 16) * ldc + col0;
#pragma unroll
                for (int bj = 0; bj < 2; ++bj) { f32x4 v0 = acc[ai][bj][m][0] + bv[bj][0], v1 = acc[ai][bj][m][1] + bv[bj][1];
                    if (ACT == 1) { f32x2 a = gelu_pk((f32x2){v0[0], v0[1]}), b = gelu_pk((f32x2){v0[2], v0[3]}), c = gelu_pk((f32x2){v1[0], v1[1]}), d = gelu_pk((f32x2){v1[2], v1[3]});
                        v0 = (f32x4){a.x, a.y, b.x, b.y}; v1 = (f32x4){c.x, c.y, d.x, d.y}; }
                    v0 = v0 * sc; v1 = v1 * sc; u32x4 w; w.x = cvt_pk_bf16(v0[0], v0[1]); w.y = cvt_pk_bf16(v0[2], v0[3]); w.z = cvt_pk_bf16(v1[0], v1[1]); w.w = cvt_pk_bf16(v1[2], v1[3]);
                    *(u32x4*)(rowp + bj * HALF) = w; } }
    }
};

struct PanelStats {
    unsigned* xbuf;
    unsigned* cnt;
    unsigned* tmo;
    int ntn; float eps;
    unsigned code;
    __device__ __forceinline__ bool run(const f32x4 (&v)[2][2][4][2], const Unit& u, int wr, int wc, int fr, int fq, PG8_LAS unsigned char* lds, int wid, int lane) const {
        typedef float f32x2v __attribute__((ext_vector_type(2)));
        PG8_LAS f32x2v* P = (PG8_LAS f32x2v*)lds;
        PG8_LAS f32x2v* S = (PG8_LAS f32x2v*)(lds + 8192);
        PG8_LAS unsigned* flag = (PG8_LAS unsigned*)(lds + 8192 + 2048);
#pragma unroll
        for (int ai = 0; ai < 2; ++ai)
#pragma unroll
            for (int m = 0; m < 4; ++m) {
                float s = 0.f;
#pragma unroll
                for (int bj = 0; bj < 2; ++bj)
#pragma unroll
                    for (int n = 0; n < 2; ++n) { const f32x4 x = v[ai][bj][m][n]; s += (x[0] + x[1]) + (x[2] + x[3]); }
                s += __shfl_xor(s, 16); s += __shfl_xor(s, 32);
                const float mw = s * (1.0f / 64.0f); float q = 0.f;
#pragma unroll
                for (int bj = 0; bj < 2; ++bj)
#pragma unroll
                    for (int n = 0; n < 2; ++n) { const f32x4 d = v[ai][bj][m][n] - mw; q += (d[0] * d[0] + d[1] * d[1]) + (d[2] * d[2] + d[3] * d[3]); }
                q += __shfl_xor(q, 16); q += __shfl_xor(q, 32);
                if (fq == 0) P[(ai * HALF + wr * 64 + m * 16 + fr) * 4 + wc] = (f32x2v){mw, q};
            }
        asm volatile("s_waitcnt lgkmcnt(0)" ::: "memory"); __builtin_amdgcn_s_barrier(); asm volatile("" ::: "memory");
#if defined(BROKEN_EXCHANGE_NO_WAIT)
#warning BROKEN CONTROL BUILD: the row-statistics exchange does not wait; results are wrong by design
        if (blockIdx.x >= 64) { const long long t0_ = clock64(); while (clock64() - t0_ < 60000) __builtin_amdgcn_s_sleep(8); }
#endif
        const int row = wid * 32 + (lane & 31);
        if (lane < 32) {
            const f32x2v a = P[row * 4 + 0], b = P[row * 4 + 1], c = P[row * 4 + 2], d = P[row * 4 + 3];
            const float mt = (a.x + b.x + c.x + d.x) * 0.25f;
            const float da = a.x - mt, db = b.x - mt, dc = c.x - mt, dd = d.x - mt;
            const float m2 = (a.y + b.y) + (c.y + d.y) + 64.0f * ((da * da + db * db) + (dc * dc + dd * dd));
            unsigned long long* slot = (unsigned long long*)xbuf + ((size_t)(u.pm * BM + row) * 4 + u.pn);
            __hip_atomic_store(slot, ((unsigned long long)__float_as_uint(m2) << 32) | __float_as_uint(mt), __ATOMIC_RELAXED, __HIP_MEMORY_SCOPE_AGENT);
        }
        asm volatile("s_waitcnt vmcnt(0)" ::: "memory");
        if (lane == 0) __hip_atomic_fetch_add(cnt + 64 * u.pm, 1u, __ATOMIC_RELAXED, __HIP_MEMORY_SCOPE_AGENT);
        if (wid == 0) {
            bool dead = false; const unsigned long long t0 = __builtin_amdgcn_s_memrealtime(); const unsigned want = 8u * (unsigned)ntn;
            for (;;) {
#if defined(BROKEN_EXCHANGE_NO_WAIT)
                break;
#endif
                if ((unsigned)__builtin_amdgcn_readfirstlane(__hip_atomic_load(cnt + 64 * u.pm, __ATOMIC_RELAXED, __HIP_MEMORY_SCOPE_AGENT)) >= want) break;
                if (__builtin_amdgcn_s_memrealtime() - t0 > 2000000ull) {
                    if (lane == 0) { unsigned expect = 0u; __hip_atomic_compare_exchange_strong(tmo + 1, &expect, code | (unsigned)(u.pm & 0xff), __ATOMIC_RELAXED, __ATOMIC_RELAXED, __HIP_MEMORY_SCOPE_AGENT);
                                     __hip_atomic_store(tmo, 1u, __ATOMIC_RELAXED, __HIP_MEMORY_SCOPE_AGENT); }
                    dead = true; break; }
                __builtin_amdgcn_s_sleep(2);
            }
            __builtin_amdgcn_fence(__ATOMIC_ACQUIRE, "agent");
            if (lane == 0) flag[0] = dead ? 1u : 0u;
        }
        asm volatile("s_waitcnt vmcnt(0) lgkmcnt(0)" ::: "memory"); __builtin_amdgcn_s_barrier(); asm volatile("" ::: "memory");
        const bool bad = flag[0] != 0u;
        if (lane < 32) {
            const unsigned long long* slot = (const unsigned long long*)xbuf + (size_t)(u.pm * BM + row) * 4; float mt[4], m2[4]; float ms = 0.f;
#pragma unroll
            for (int t = 0; t < 4; ++t) { if (t < ntn) { const unsigned long long w = __hip_atomic_load(slot + t, __ATOMIC_RELAXED, __HIP_MEMORY_SCOPE_AGENT); mt[t] = __uint_as_float((unsigned)w); m2[t] = __uint_as_float((unsigned)(w >> 32)); } else { mt[t] = 0.f; m2[t] = 0.f; } ms += mt[t]; }
            const float mean = ms / (float)ntn; float q = 0.f;
#pragma unroll
            for (int t = 0; t < 4; ++t) if (t < ntn) { const float dm = mt[t] - mean; q += m2[t] + 256.0f * dm * dm; }
            S[row] = (f32x2v){mean, 1.0f / sqrtf(q / (256.0f * (float)ntn) + eps)};
        }
        asm volatile("s_waitcnt lgkmcnt(0)" ::: "memory"); __builtin_amdgcn_s_barrier(); asm volatile("" ::: "memory");
        return bad;
    }
};
struct EpiLnRes {
    static constexpr bool PERM = false, AFTER_DRAIN = true;
    const float* base; float* out; int ldc; const float* bias; PanelStats st; unsigned poison;
    __device__ __forceinline__ void fused(f32x4 (&acc)[2][2][4][2], const Unit& u, int wr, int wc, int fr, int fq, PG8_LAS unsigned char* lds, int wid, int lane) const {
        typedef float f32x2v __attribute__((ext_vector_type(2)));
        const PG8_LAS f32x2v* S = (const PG8_LAS f32x2v*)(lds + 8192);
        const int col0 = u.pn * BM + wc * 32 + 4 * fq;
#pragma unroll
        for (int bj = 0; bj < 2; ++bj)
#pragma unroll
            for (int n = 0; n < 2; ++n) { const f32x4 bv = bias ? *(const f32x4*)(bias + col0 + bj * HALF + n * 16) : (f32x4){0.f, 0.f, 0.f, 0.f};
#pragma unroll
                for (int ai = 0; ai < 2; ++ai)
#pragma unroll
                    for (int m = 0; m < 4; ++m) acc[ai][bj][m][n] += bv; }
        f32x4 pre[4][2][2];
#pragma unroll
        for (int m = 0; m < 4; ++m) { const size_t off = (size_t)(u.pm * BM + wr * 64 + m * 16 + fr) * ldc + col0;
#pragma unroll
            for (int bj = 0; bj < 2; ++bj)
#pragma unroll
                for (int n = 0; n < 2; ++n) pre[m][bj][n] = *(const f32x4*)(base + off + bj * HALF + n * 16); }
        const bool bad = st.run(acc, u, wr, wc, fr, fq, lds, wid, lane) || poison != 0u;
        const float qnan = __builtin_nanf("");
#pragma unroll
        for (int ai = 0; ai < 2; ++ai)
#pragma unroll
            for (int m = 0; m < 4; ++m) { const int r = ai * HALF + wr * 64 + m * 16 + fr; const f32x2v sr = S[r]; const size_t off = (size_t)(u.pm * BM + r) * ldc + col0;
#pragma unroll
                for (int bj = 0; bj < 2; ++bj)
#pragma unroll
                    for (int n = 0; n < 2; ++n) { const f32x4 bs = ai == 0 ? pre[m][bj][n] : *(const f32x4*)(base + off + bj * HALF + n * 16); f32x4 o = bs + (acc[ai][bj][m][n] - sr.x) * sr.y;
                        if (bad) o = (f32x4){qnan, qnan, qnan, qnan}; *(f32x4*)(out + off + bj * HALF + n * 16) = o; }
                if (m & 1) asm volatile("" ::: "memory"); }
    }
};
struct EpiLnResLn {
    static constexpr bool PERM = false, AFTER_DRAIN = true;
    const float* base; float* out; bf16_t* xn; int ldc; const float* bias; PanelStats st1, st2; unsigned poison;
    __device__ __forceinline__ void fused(f32x4 (&acc)[2][2][4][2], const Unit& u, int wr, int wc, int fr, int fq, PG8_LAS unsigned char* lds, int wid, int lane) const {
        typedef float f32x2v __attribute__((ext_vector_type(2))); typedef unsigned u32x2v __attribute__((ext_vector_type(2)));
        const PG8_LAS f32x2v* S = (const PG8_LAS f32x2v*)(lds + 8192);
        const int col0 = u.pn * BM + wc * 32 + 4 * fq;
#pragma unroll
        for (int bj = 0; bj < 2; ++bj)
#pragma unroll
            for (int n = 0; n < 2; ++n) { const f32x4 bv = bias ? *(const f32x4*)(bias + col0 + bj * HALF + n * 16) : (f32x4){0.f, 0.f, 0.f, 0.f};
#pragma unroll
                for (int ai = 0; ai < 2; ++ai)
#pragma unroll
                    for (int m = 0; m < 4; ++m) acc[ai][bj][m][n] += bv; }
        bool bad = st1.run(acc, u, wr, wc, fr, fq, lds, wid, lane) || poison != 0u;
        const float qnan = __builtin_nanf("");
#pragma unroll
        for (int ai = 0; ai < 2; ++ai)
#pragma unroll
            for (int m = 0; m < 4; ++m) { const int r = ai * HALF + wr * 64 + m * 16 + fr; const f32x2v sr = S[r]; const size_t off = (size_t)(u.pm * BM + r) * ldc + col0;
#pragma unroll
                for (int bj = 0; bj < 2; ++bj)
#pragma unroll
                    for (int n = 0; n < 2; ++n) { const f32x4 bs = *(const f32x4*)(base + off + bj * HALF + n * 16); acc[ai][bj][m][n] = bs + (acc[ai][bj][m][n] - sr.x) * sr.y; }
                asm volatile("" : "+v"(acc[ai][0][m][0]), "+v"(acc[ai][0][m][1]), "+v"(acc[ai][1][m][0]), "+v"(acc[ai][1][m][1]));
                if (m & 1) asm volatile("" ::: "memory"); }
        const bool bad1 = bad;
        bad = st2.run(acc, u, wr, wc, fr, fq, lds, wid, lane) || bad;
#pragma unroll
        for (int ai = 0; ai < 2; ++ai)
#pragma unroll
            for (int m = 0; m < 4; ++m) { const int r = ai * HALF + wr * 64 + m * 16 + fr; const f32x2v sr = S[r]; const size_t off = (size_t)(u.pm * BM + r) * ldc + col0;
#pragma unroll
                for (int bj = 0; bj < 2; ++bj)
#pragma unroll
                    for (int n = 0; n < 2; ++n) { const f32x4 x1 = acc[ai][bj][m][n]; *(f32x4*)(out + off + bj * HALF + n * 16) = bad1 ? (f32x4){qnan, qnan, qnan, qnan} : x1;
                        const f32x4 o = (x1 - sr.x) * sr.y; u32x2v w; w.x = cvt_pk_bf16(o[0], o[1]); w.y = cvt_pk_bf16(o[2], o[3]);
                        if (bad) { w.x = 0x7fc07fc0u; w.y = 0x7fc07fc0u; } *(u32x2v*)(xn + off + bj * HALF + n * 16) = w; }
                asm volatile("" ::: "memory"); }
    }
};

template <class Epi, class Sched, bool ALIGN_EPI = false, bool SP2 = false>
__device__ __forceinline__ void gemm_phase(PG8_LAS unsigned char* lds, const Gemm g, const Sched& S, const Epi& E) {
    int tid_ = threadIdx.x; asm volatile("" : "+v"(tid_));
    const int tid = tid_, wid = __builtin_amdgcn_readfirstlane(tid >> 6), lane = tid & 63, wr = wid >> 2, wc = wid & 3, fr = lane & 15, fq = lane >> 4;
    const int K = g.K, nt = K / BK;
    unsigned voffA[2], voffB[2];
#pragma unroll
    for (int i = 0; i < 2; ++i) { int R, C; stage_rc(tid * 16 + i * 8192, R, C); const int Rb = Epi::PERM ? ((R & ~31) + perm32(R & 31)) : R;
        voffA[i] = (unsigned)(R * K + C) * 2u; voffB[i] = (unsigned)(Rb * K + C) * 2u; }
    const size_t kstep = (size_t)(BK * 2);
    const size_t hstep = (size_t)HALF * K * 2;
    const size_t tstep = 2 * hstep;
    const unsigned ldsw = (unsigned)wid * 1024u;
    const int aoff = lds_byte(wr * 64 + fr, fq * 8), boff = lds_byte(wc * 32 + fr, fq * 8);
#define PG8_SA(b, h) (((b) * 2 + (h)) * HTB)
#define PG8_SB(b, h) ((4 + (b) * 2 + (h)) * HTB)
#define PG8_STAGE(bufoff, gbase, voff) do { _Pragma("unroll") for (int _i = 0; _i < 2; ++_i) \
        __builtin_amdgcn_global_load_lds((const unsigned*)((const char*)(gbase) + (voff)[_i]), (PG8_LAS unsigned*)(lds + (bufoff) + ldsw + _i * 8192), 16, 0, 0); } while (0)
#define PG8_LDA(dst, b, h) do { _Pragma("unroll") for (int m = 0; m < 4; ++m) _Pragma("unroll") for (int k = 0; k < 2; ++k) dst[m][k] = *(const PG8_LAS bf16x8*)(lds + PG8_SA(b, h) + aoff + m * 2048 + k * 1024); } while (0)
#define PG8_LDB(dst, b, h) do { _Pragma("unroll") for (int n = 0; n < 2; ++n) _Pragma("unroll") for (int k = 0; k < 2; ++k) dst[n][k] = *(const PG8_LAS bf16x8*)(lds + PG8_SB(b, h) + boff + n * 2048 + k * 1024); } while (0)
#define PG8_MMA(ai, bj, At, Bt) do { __builtin_amdgcn_s_setprio(1); _Pragma("unroll") for (int m = 0; m < 4; ++m) _Pragma("unroll") for (int n = 0; n < 2; ++n) _Pragma("unroll") for (int k = 0; k < 2; ++k) \
        acc[ai][bj][m][n] = __builtin_amdgcn_mfma_f32_16x16x32_bf16(Bt[n][k], At[m][k], acc[ai][bj][m][n], 0, 0, 0); __builtin_amdgcn_s_setprio(0); } while (0)
#define PG8_WAIT_V(n) asm volatile("s_waitcnt vmcnt(" #n ")" ::: "memory")
#define PG8_WAIT_L(n) asm volatile("s_waitcnt lgkmcnt(" #n ")" ::: "memory")
#define PG8_BAR __builtin_amdgcn_s_barrier()
#define PG8_SCHED __builtin_amdgcn_sched_barrier(0)
    Unit cur, nxt; int ui = 0;
    if (!S.next(0, cur)) return;
    f32x4 acc[2][2][4][2];
#pragma unroll
    for (int a = 0; a < 2; ++a)
#pragma unroll
        for (int b = 0; b < 2; ++b)
#pragma unroll
            for (int m = 0; m < 4; ++m)
#pragma unroll
                for (int n = 0; n < 2; ++n) acc[a][b][m][n] = (f32x4){0.f, 0.f, 0.f, 0.f};
    bf16x8 At[4][2], B0[2][2], B1[2][2];
    const char* cA = (const char*)g.A + (size_t)cur.pm * tstep; const char* cB = (const char*)g.Bt + (size_t)cur.pn * tstep;
    S.a_ready(cur);
    if constexpr (SP2) {
        PG8_STAGE(PG8_SB(0, 0), cB, voffB); PG8_STAGE(PG8_SB(0, 1), cB + hstep, voffB); PG8_STAGE(PG8_SA(0, 0), cA, voffA); PG8_STAGE(PG8_SA(0, 1), cA + hstep, voffA);
        if (wr == 1) PG8_BAR;
        PG8_WAIT_V(2); PG8_BAR;
        PG8_STAGE(PG8_SB(1, 0), cB + kstep, voffB); PG8_STAGE(PG8_SA(1, 0), cA + kstep, voffA); PG8_STAGE(PG8_SB(1, 1), cB + hstep + kstep, voffB);
        PG8_WAIT_V(6); PG8_BAR;
    } else {
        PG8_STAGE(PG8_SB(0, 0), cB, voffB); PG8_STAGE(PG8_SA(0, 0), cA, voffA); PG8_STAGE(PG8_SB(0, 1), cB + hstep, voffB); PG8_STAGE(PG8_SA(0, 1), cA + hstep, voffA);
        if (wr == 1) PG8_BAR;
        PG8_WAIT_V(4); PG8_BAR;
        PG8_STAGE(PG8_SB(1, 0), cB + kstep, voffB); PG8_STAGE(PG8_SA(1, 0), cA + kstep, voffA); PG8_STAGE(PG8_SB(1, 1), cB + hstep + kstep, voffB);
        PG8_WAIT_V(6); PG8_BAR;
    }
    for (;;) {
        const bool has_next = S.next(ui + 1, nxt);
        const char* nA = has_next ? (const char*)g.A + (size_t)nxt.pm * tstep : cA; const char* nB = has_next ? (const char*)g.Bt + (size_t)nxt.pn * tstep : cB;
        for (int t = 0; t < nt; t += 2) {
            const bool last = (t == nt - 2);
            const char* a1 = cA + (size_t)(t + 1) * kstep;
            const char* a2 = last ? nA : cA + (size_t)(t + 2) * kstep; const char* b2 = last ? nB : cB + (size_t)(t + 2) * kstep;
            const char* a3 = a2 + kstep; const char* b3 = b2 + kstep;
            if (last && has_next) S.a_ready(nxt);
            if constexpr (SP2) {
            PG8_LDB(B0, 0, 0); PG8_LDB(B1, 0, 1); PG8_SCHED; PG8_LDA(At, 0, 0); PG8_STAGE(PG8_SA(1, 1), a1 + hstep, voffA);
            PG8_WAIT_V(8); PG8_WAIT_L(0); PG8_BAR; PG8_MMA(0, 0, At, B0); PG8_MMA(0, 1, At, B1); PG8_BAR; PG8_SCHED;
            PG8_LDA(At, 0, 1); PG8_STAGE(PG8_SB(0, 0), b2, voffB); PG8_STAGE(PG8_SB(0, 1), b2 + hstep, voffB); PG8_STAGE(PG8_SA(0, 0), a2, voffA);
            PG8_WAIT_V(8); PG8_WAIT_L(0); PG8_BAR; PG8_MMA(1, 0, At, B0); PG8_MMA(1, 1, At, B1); PG8_BAR; PG8_SCHED;
            PG8_LDB(B0, 1, 0); PG8_LDB(B1, 1, 1); PG8_SCHED; PG8_LDA(At, 1, 0); PG8_STAGE(PG8_SA(0, 1), a2 + hstep, voffA);
            PG8_WAIT_V(8); PG8_WAIT_L(0); PG8_BAR; PG8_MMA(0, 0, At, B0); PG8_MMA(0, 1, At, B1); PG8_BAR; PG8_SCHED;
            PG8_LDA(At, 1, 1); PG8_STAGE(PG8_SB(1, 0), b3, voffB); PG8_STAGE(PG8_SB(1, 1), b3 + hstep, voffB); PG8_STAGE(PG8_SA(1, 0), a3, voffA);
            PG8_WAIT_V(8); PG8_WAIT_L(0); PG8_BAR; PG8_MMA(1, 0, At, B0); PG8_MMA(1, 1, At, B1); PG8_BAR; PG8_SCHED;
            } else {
            PG8_LDB(B0, 0, 0); PG8_SCHED; PG8_LDA(At, 0, 0); PG8_STAGE(PG8_SA(1, 1), a1 + hstep, voffA);
            PG8_WAIT_L(8); PG8_BAR; PG8_WAIT_L(0); PG8_MMA(0, 0, At, B0); PG8_BAR; PG8_SCHED;
            PG8_LDB(B1, 0, 1); PG8_STAGE(PG8_SB(0, 0), b2, voffB);
            PG8_BAR; PG8_WAIT_L(0); PG8_MMA(0, 1, At, B1); PG8_BAR;
            PG8_LDA(At, 0, 1); PG8_STAGE(PG8_SA(0, 0), a2, voffA);
            PG8_BAR; PG8_WAIT_L(0); PG8_MMA(1, 0, At, B0); PG8_BAR; PG8_SCHED;
            PG8_STAGE(PG8_SB(0, 1), b2 + hstep, voffB);
            PG8_WAIT_V(6); PG8_BAR; PG8_MMA(1, 1, At, B1); PG8_BAR;
            PG8_LDB(B0, 1, 0); PG8_SCHED; PG8_LDA(At, 1, 0); PG8_STAGE(PG8_SA(0, 1), a2 + hstep, voffA);
            PG8_WAIT_L(8); PG8_BAR; PG8_WAIT_L(0); PG8_MMA(0, 0, At, B0); PG8_BAR; PG8_SCHED;
            PG8_LDB(B1, 1, 1); PG8_STAGE(PG8_SB(1, 0), b3, voffB);
            PG8_BAR; PG8_WAIT_L(0); PG8_MMA(0, 1, At, B1); PG8_BAR;
            PG8_LDA(At, 1, 1); PG8_STAGE(PG8_SA(1, 0), a3, voffA);
            PG8_BAR; PG8_WAIT_L(0); PG8_MMA(1, 0, At, B0); PG8_BAR; PG8_SCHED;
            PG8_STAGE(PG8_SB(1, 1), b3 + hstep, voffB);
            PG8_WAIT_V(6); PG8_BAR; PG8_MMA(1, 1, At, B1); PG8_BAR;
            }
        }
        if constexpr (ALIGN_EPI) { if (wr == 0) PG8_BAR; }
        if constexpr (!Epi::AFTER_DRAIN) { E(acc, cur, wr, wc, fr, fq); S.done(cur); }
        if (!has_next) break;
#pragma unroll
        for (int a = 0; a < 2; ++a)
#pragma unroll
            for (int b = 0; b < 2; ++b)
#pragma unroll
                for (int m = 0; m < 4; ++m)
#pragma unroll
                    for (int n = 0; n < 2; ++n) acc[a][b][m][n] = (f32x4){0.f, 0.f, 0.f, 0.f};
        cur = nxt; cA = nA; cB = nB; ++ui;
        if constexpr (ALIGN_EPI) { if (wr == 1) PG8_BAR; }
    }
    PG8_WAIT_V(0);
    if constexpr (!ALIGN_EPI) { if (wr == 0) PG8_BAR; }
    PG8_BAR;
    if constexpr (Epi::AFTER_DRAIN) { E.fused(acc, cur, wr, wc, fr, fq, lds, wid, lane); S.done(cur); }
#undef PG8_SA
#undef PG8_SB
#undef PG8_STAGE
#undef PG8_LDA
#undef PG8_LDB
#undef PG8_MMA
#undef PG8_WAIT_V
#undef PG8_WAIT_L
#undef PG8_BAR
#undef PG8_SCHED
}
}
#include <hip/hip_bf16.h>
#include <cmath>
namespace attn_body {
using bf16=__hip_bfloat16;
using bf16x8=__attribute__((ext_vector_type(8)))short;
using s16x4=__attribute__((ext_vector_type(4)))short;
using f32x16=__attribute__((ext_vector_type(16)))float;
using u32x4=__attribute__((ext_vector_type(4)))unsigned;
constexpr int BATCH=8,NHEAD=8,SEQ=2048,D=64,DM=NHEAD*D,OP=1024,CLS_OFF=86016;
constexpr int NW=8,QBLK=32,QB=QBLK*NW,KVBLK=64,NQB=SEQ/QB;
constexpr int ATTN_PITCH=DM, ATTN_UNIT_ROWS=QB;
__device__ __forceinline__ int crow(int r,int hi){return (r&3)+8*(r>>2)+4*hi;}
#define SBAR() __builtin_amdgcn_sched_barrier(0)
__device__ __forceinline__ void cmask(f32x16&p0,f32x16&p1,int jb,int qrel,int hi){
  const float NEG=-INFINITY; int kb=64*jb+4*hi;
  #pragma unroll
  for(int r=0;r<16;++r){int kv=kb+(r&3)+8*(r>>2); if(kv>qrel)p0[r]=NEG; if(kv+32>qrel)p1[r]=NEG;}
}

constexpr int NSLOT=3, SLOTB=8192;
constexpr int LDS_K=0, LDS_V=NSLOT*SLOTB, LDS_WS=2*NSLOT*SLOTB, LDS_OST=LDS_WS+NW*64*4, LDS_BYTES=LDS_OST+NW*4096;
constexpr float C2=0.125f*1.4426950408889634f;
__device__ __forceinline__ void glds16(const void*gsrc,unsigned lds_dst){unsigned keep;
  asm volatile("s_mov_b32 %0, m0\n\ts_mov_b32 m0, %2\n\ts_nop 0\n\tglobal_load_lds_dwordx4 %1, off\n\ts_mov_b32 m0, %0":"=&s"(keep):"v"(gsrc),"s"(lds_dst):"memory");}
__device__ __forceinline__ float max3f(float a,float b,float c){float r;asm("v_max3_f32 %0, %1, %2, %3":"=v"(r):"v"(a),"v"(b),"v"(c));return r;}
__device__ __forceinline__ float max2f(float a,float b){float r;asm("v_max_f32_e32 %0, %1, %2":"=v"(r):"v"(a),"v"(b));return r;}
__device__ __forceinline__ float fadd_s(float a,float b){float r;asm("v_add_f32_e32 %0, %1, %2":"=v"(r):"v"(a),"v"(b));return r;}
__device__ __forceinline__ float fsub_s(float a,float b){float r;asm("v_sub_f32_e32 %0, %1, %2":"=v"(r):"v"(a),"v"(b));return r;}
typedef float f32x4_t __attribute__((ext_vector_type(4))); typedef float f32x2_t __attribute__((ext_vector_type(2))); typedef __bf16 bf16x2_t __attribute__((ext_vector_type(2)));
__device__ __forceinline__ unsigned cvtpk_s(float lo,float hi){f32x2_t v={lo,hi};bf16x2_t b=__builtin_convertvector(v,bf16x2_t);return __builtin_bit_cast(unsigned,b);}
#define WAIT_BAR(N) asm volatile("s_waitcnt vmcnt(" #N ") lgkmcnt(0)\n\ts_barrier":::"memory")

__device__ __forceinline__ void qkt(f32x16&p0,f32x16&p1,const char*Kslot,const bf16x8*qr,int r32,int hi){ const f32x16 negm=f32x16{};
  const char*kb=Kslot+hi*1024+r32*16;
  #pragma unroll
  for(int d0=0;d0<4;++d0){
    const bf16x8 b0=*reinterpret_cast<const bf16x8*>(kb+d0*2048);
    const bf16x8 b1=*reinterpret_cast<const bf16x8*>(kb+d0*2048+512);
    if(d0==0){p0=__builtin_amdgcn_mfma_f32_32x32x16_bf16(b0,qr[0],negm,0,0,0);p1=__builtin_amdgcn_mfma_f32_32x32x16_bf16(b1,qr[0],negm,0,0,0);}
    else{p0=__builtin_amdgcn_mfma_f32_32x32x16_bf16(b0,qr[d0],p0,0,0,0);p1=__builtin_amdgcn_mfma_f32_32x32x16_bf16(b1,qr[d0],p1,0,0,0);}}
}
typedef __attribute__((address_space(3))) const char* lds_cptr;
typedef short v4i16_t __attribute__((ext_vector_type(4)));
__device__ __forceinline__ void kload8(bf16x8*kf,lds_cptr kp){
  kf[0]=*(const __attribute__((address_space(3))) bf16x8*)(kp);      kf[1]=*(const __attribute__((address_space(3))) bf16x8*)(kp+512);
  kf[2]=*(const __attribute__((address_space(3))) bf16x8*)(kp+2048); kf[3]=*(const __attribute__((address_space(3))) bf16x8*)(kp+2560);
  kf[4]=*(const __attribute__((address_space(3))) bf16x8*)(kp+4096); kf[5]=*(const __attribute__((address_space(3))) bf16x8*)(kp+4608);
  kf[6]=*(const __attribute__((address_space(3))) bf16x8*)(kp+6144); kf[7]=*(const __attribute__((address_space(3))) bf16x8*)(kp+6656);
}
__device__ __forceinline__ void kload2(bf16x8*kf,lds_cptr kp,int j){ kf[2*j]=*(const __attribute__((address_space(3))) bf16x8*)(kp+j*2048); kf[2*j+1]=*(const __attribute__((address_space(3))) bf16x8*)(kp+j*2048+512); }
__device__ __forceinline__ s16x4 vtr(lds_cptr p){ return __builtin_bit_cast(s16x4,__builtin_amdgcn_ds_read_tr16_b64_v4i16((__attribute__((address_space(3))) v4i16_t*)p)); }
__device__ __forceinline__ float rowmax(const f32x16&p0,const f32x16&p1){
  float a=max3f(p0[0],p0[1],p1[0]),b=max3f(p0[2],p0[3],p1[1]);a=max3f(a,p1[2],p1[3]);
  #pragma unroll
  for(int r=4;r<16;r+=4){a=max3f(a,p0[r],p0[r+1]);b=max3f(b,p0[r+2],p0[r+3]);a=max3f(a,p1[r],p1[r+1]);b=max3f(b,p1[r+2],p1[r+3]);}
  const float m=max2f(a,b);
  auto rr=__builtin_amdgcn_permlane32_swap(__float_as_uint(m),__float_as_uint(m),false,false);
  return max2f(__uint_as_float(rr[0]),__uint_as_float(rr[1]));
}
__device__ __forceinline__ void pv(f32x16*o,int vb,bf16x8 pa0,bf16x8 pa1,bf16x8 pa2,bf16x8 pa3){
  #pragma unroll
  for(int d0=0;d0<2;++d0){s16x4 lo[4],hi[4];
    #pragma unroll
    for(int ks=0;ks<4;++ks){
      asm volatile("ds_read_b64_tr_b16 %0,%1 offset:%c2":"=&v"(lo[ks]):"v"(vb),"i"(d0*4096+ks*1024):"memory");
      asm volatile("ds_read_b64_tr_b16 %0,%1 offset:%c2":"=&v"(hi[ks]):"v"(vb),"i"(d0*4096+ks*1024+512):"memory");}
    asm volatile("s_waitcnt lgkmcnt(0)":::"memory");SBAR();
    #define PK(k) (bf16x8){lo[k][0],lo[k][1],lo[k][2],lo[k][3],hi[k][0],hi[k][1],hi[k][2],hi[k][3]}
    o[d0]=__builtin_amdgcn_mfma_f32_32x32x16_bf16(pa0,PK(0),o[d0],0,0,0);
    o[d0]=__builtin_amdgcn_mfma_f32_32x32x16_bf16(pa1,PK(1),o[d0],0,0,0);
    o[d0]=__builtin_amdgcn_mfma_f32_32x32x16_bf16(pa2,PK(2),o[d0],0,0,0);
    o[d0]=__builtin_amdgcn_mfma_f32_32x32x16_bf16(pa3,PK(3),o[d0],0,0,0);
    #undef PK
  }
}

#ifndef ATTN_STORE16
#define ATTN_STORE16(p,v) (*(u32x4*)(p)=(v))
#endif
template<int THRL> __device__ __forceinline__ void attn_unit(int b,int h,int qb,const bf16*Q,const bf16*__restrict__ K,const bf16*__restrict__ V,bf16*O,const float*__restrict__ CL,char*shm){
  const int tid=threadIdx.x,lane=tid&63,r32=lane&31,hi=lane>>5; const int wid=__builtin_amdgcn_readfirstlane(tid>>6);
  const long rowbase=(long)b*SEQ; const int q0=qb*QB;
  const bf16*Qw=Q+(rowbase+q0+wid*QBLK)*DM+h*D;
  const bf16*Kh=K+rowbase*DM+h*D,*Vh=V+rowbase*DM+h*D;
  const unsigned lds0=(unsigned)(uintptr_t)shm;
  float*wsf=(float*)(shm+LDS_WS)+wid*64;
  const bf16*ksrc=Kh+(long)lane*DM+wid*8;
  const bf16*vsrc=Vh+(long)(16*(wid&3)+(lane>>2))*DM+(wid>>2)*32+(lane&3)*8;
  const unsigned kdst=lds0+LDS_K+wid*1024, vdst=lds0+LDS_V+wid*1024;
  #define DMA_K(t,slot) glds16(ksrc+(long)(t)*KVBLK*DM,(unsigned)__builtin_amdgcn_readfirstlane(kdst+(slot)))
  #define DMA_V(t,slot) glds16(vsrc+(long)(t)*KVBLK*DM,(unsigned)__builtin_amdgcn_readfirstlane(vdst+(slot)))
  const int vb0=(int)(lds0+LDS_V)+((lane>>4)&1)*32+(lane&3)*8+(4*hi+((lane&15)>>2))*64;
  const char*Kbase=shm+LDS_K; bf16x8 kf[8];
  const lds_cptr shm3=(lds_cptr)shm; const lds_cptr kp0=shm3+LDS_K+hi*1024+r32*16; const lds_cptr vp0=shm3+LDS_V+((lane>>4)&1)*32+(lane&3)*8+(4*hi+((lane&15)>>2))*64;
  const int NT=(q0+QB)/KVBLK;
  __attribute__((address_space(3))) float*cls=(__attribute__((address_space(3))) float*)((__attribute__((address_space(3))) char*)shm+CLS_OFF);
  const float*CLh=CL+(long)(b*NHEAD+h)*SEQ;
  for(int i=tid;i<q0+QB;i+=NW*64)cls[i]=CLh[i];
  const float clq=CLh[q0+wid*QBLK+r32];
  asm volatile("s_waitcnt vmcnt(0) lgkmcnt(0)":::"memory");
  #define BIAS(P0,P1,t) do{ const __attribute__((address_space(3))) float*cb_=cls+64*(t)+4*hi; _Pragma("unroll") for(int g_=0;g_<4;++g_){ \
      const f32x4_t b0_=*(const __attribute__((address_space(3))) f32x4_t*)(cb_+8*g_), b1_=*(const __attribute__((address_space(3))) f32x4_t*)(cb_+32+8*g_); \
      _Pragma("unroll") for(int j_=0;j_<4;++j_){ P0[4*g_+j_]+=(nm-b0_[j_]); P1[4*g_+j_]+=(nm-b1_[j_]); } } }while(0)
  DMA_K(0,0);DMA_V(0,0);DMA_K(1,SLOTB);
  bf16x8 qr[4];
  #pragma unroll
  for(int d0=0;d0<4;++d0)qr[d0]=*reinterpret_cast<const bf16x8*>(&Qw[(long)r32*DM+d0*16+hi*8]);
  float l_reg=0.f;f32x16 o[2];o[0]=f32x16{};o[1]=f32x16{};float nm=clq; const f32x16 zero16=f32x16{};
  const int qrel=wid*QBLK+r32;
  #define CMASK(P0,P1,t) do{int jb_=(t)-(NT-4); if(jb_>=0)cmask(P0,P1,jb_,qrel,hi);}while(0)
  bool resc=false;
  #define START(P0,P1) do{ const float rm=rowmax(P0,P1); resc=false; \
    { const float dl=rm; \
      _Pragma("unroll") for(int r=0;r<16;++r){P0[r]=fsub_s(P0[r],dl);P1[r]=fsub_s(P1[r],dl);} \
      nm=fsub_s(nm,dl); } \
    _Pragma("unroll") for(int r=0;r<16;++r)P0[r]=__builtin_amdgcn_exp2f(P0[r]); }while(0)
  #define RESC() do{ if(resc){ asm volatile("s_waitcnt lgkmcnt(0)":::"memory"); \
      _Pragma("unroll") for(int d_=0;d_<2;++d_) _Pragma("unroll") for(int r=0;r<16;++r)o[d_][r]*=wsf[crow(r,hi)]; } }while(0)
  f32x16 pA0,pA1,pB0,pB1;
  int sl_prev=0,sl_cur=0,sl_next=SLOTB;
  #define ROT() do{sl_prev=sl_cur;sl_cur=sl_next;sl_next=(sl_next==(NSLOT-1)*SLOTB)?0:sl_next+SLOTB;}while(0)
  DMA_K(2,2*SLOTB);
  WAIT_BAR(3);
  qkt(pA0,pA1,Kbase,qr,r32,hi);asm volatile("s_nop 15\n\ts_nop 7":"+v"(pA0),"+v"(pA1));BIAS(pA0,pA1,0);CMASK(pA0,pA1,0);
  START(pA0,pA1);
  _Pragma("unroll") for(int r=0;r<16;++r)pA1[r]=__builtin_amdgcn_exp2f(pA1[r]);
  WAIT_BAR(0);
  DMA_K(3,0);DMA_V(1,SLOTB);
  ROT();
  kload8(kf,kp0+sl_cur);
  WAIT_BAR(2);
  s16x4 vlo[8],vhi[8]; u32x4 pw0,pw1,pw2,pw3;
  #define PKW(P,B) cvtpk_s(P[B],P[B+1])
  #define PAF(k) __builtin_bit_cast(bf16x8,pw##k)
  #define VFR(i) (bf16x8){vlo[i][0],vlo[i][1],vlo[i][2],vlo[i][3],vhi[i][0],vhi[i][1],vhi[i][2],vhi[i][3]}
  #define PIN(x) asm volatile("":"+v"(x))
  #define MX3(a,b,c) __builtin_fmaxf(__builtin_fmaxf((a),(b)),(c))
  #define GAPA(MF,A0,A1,A2,A3,W0,W1,PW) do{ MF; sacc+=A0; sacc+=A1; sacc+=A2; sacc+=A3; PIN(sacc); W0; W1; PIN(PW); SBAR(); }while(0)
  #define EX(v) __builtin_amdgcn_exp2f(v)
  #define GAPB(MF,X,B) do{ MF; X[B]=EX(X[B]); X[B+1]=EX(X[B+1]); X[B+2]=EX(X[B+2]); X[B+3]=EX(X[B+3]); PIN(X); SBAR(); }while(0)
  #define VRD(i) do{ vlo[i]=vtr(vp_+(((i)>>2)*4096+((i)&3)*1024)); vhi[i]=vtr(vp_+(((i)>>2)*4096+((i)&3)*1024+512)); }while(0)
  #define KRD(G,j) do{ if(G){ kload2(kf,kp0+sl_next,j); SBAR(); } }while(0)
  #define STEP(C0,C1,P0,P1,t,GK,GV,GL) do{ SBAR(); \
    const lds_cptr vp_=vp0+sl_prev; \
    VRD(0); SBAR(); float sacc=(P0[0]+P0[1]); \
    GAPA(C0=__builtin_amdgcn_mfma_f32_32x32x16_bf16(kf[0],qr[0],zero16,0,0,0), P0[2],P0[3],P0[4],P0[5],     pw0[0]=PKW(P0,0), pw0[1]=PKW(P0,2), pw0); \
    VRD(4); SBAR(); GAPA(C1=__builtin_amdgcn_mfma_f32_32x32x16_bf16(kf[1],qr[0],zero16,0,0,0), P0[6],P0[7],P0[8],P0[9],     pw0[2]=PKW(P0,4), pw0[3]=PKW(P0,6), pw0); \
    VRD(1); SBAR(); GAPA(C0=__builtin_amdgcn_mfma_f32_32x32x16_bf16(kf[2],qr[1],C0,0,0,0),   P0[10],P0[11],P0[12],P0[13], pw1[0]=PKW(P0,8), pw1[1]=PKW(P0,10), pw1); \
    VRD(5); SBAR(); GAPA(C1=__builtin_amdgcn_mfma_f32_32x32x16_bf16(kf[3],qr[1],C1,0,0,0),   P0[14],P0[15],P1[0],P1[1],   pw1[2]=PKW(P0,12),pw1[3]=PKW(P0,14), pw1); \
    VRD(2); SBAR(); GAPA(C0=__builtin_amdgcn_mfma_f32_32x32x16_bf16(kf[4],qr[2],C0,0,0,0),   P1[2],P1[3],P1[4],P1[5],     pw2[0]=PKW(P1,0), pw2[1]=PKW(P1,2), pw2); \
    VRD(6); SBAR(); GAPA(C1=__builtin_amdgcn_mfma_f32_32x32x16_bf16(kf[5],qr[2],C1,0,0,0),   P1[6],P1[7],P1[8],P1[9],     pw2[2]=PKW(P1,4), pw2[3]=PKW(P1,6), pw2); \
    VRD(3); SBAR(); GAPA(C0=__builtin_amdgcn_mfma_f32_32x32x16_bf16(kf[6],qr[3],C0,0,0,0),   P1[10],P1[11],P1[12],P1[13], pw3[0]=PKW(P1,8), pw3[1]=PKW(P1,10), pw3); \
    VRD(7); SBAR(); GAPA(C1=__builtin_amdgcn_mfma_f32_32x32x16_bf16(kf[7],qr[3],C1,0,0,0),   P1[14],P1[15],0.f,0.f,       pw3[2]=PKW(P1,12),pw3[3]=PKW(P1,14), pw3); \
    l_reg+=sacc; \
    if(GK){DMA_K((t)+3,sl_cur);} if(GV){DMA_V((t)+1,sl_next);} \
    BIAS(C0,C1,t); CMASK(C0,C1,t); \
    { float a=MX3(C0[0],C0[1],C1[0]),b=MX3(C0[2],C0[3],C1[1]); a=MX3(a,C1[2],C1[3]); \
      _Pragma("unroll") for(int r=4;r<16;r+=4){a=MX3(a,C0[r],C0[r+1]);b=MX3(b,C0[r+2],C0[r+3]);a=MX3(a,C1[r],C1[r+1]);b=MX3(b,C1[r+2],C1[r+3]);} \
      float rm=__builtin_fmaxf(a,b); { auto rr=__builtin_amdgcn_permlane32_swap(__float_as_uint(rm),__float_as_uint(rm),false,false); rm=__builtin_fmaxf(__uint_as_float(rr[0]),__uint_as_float(rr[1])); } \
      resc=false; \
      if(__builtin_expect(__any(rm>(float)THRL),0)){ const float dl=__builtin_fmaxf(rm,0.f); \
        _Pragma("unroll") for(int r=0;r<16;++r){C0[r]-=dl;C1[r]-=dl;} \
        nm-=dl; \
        const float f=__builtin_amdgcn_exp2f(-dl); l_reg*=f; if(hi==0)wsf[r32]=f; resc=true; } } \
    SBAR(); \
    GAPB(o[0]=__builtin_amdgcn_mfma_f32_32x32x16_bf16(PAF(0),VFR(0),o[0],0,0,0), C0,0); \
    GAPB(o[1]=__builtin_amdgcn_mfma_f32_32x32x16_bf16(PAF(0),VFR(4),o[1],0,0,0), C0,4); \
    KRD(GL,0); GAPB(o[0]=__builtin_amdgcn_mfma_f32_32x32x16_bf16(PAF(1),VFR(1),o[0],0,0,0), C0,8); \
    KRD(GL,1); GAPB(o[1]=__builtin_amdgcn_mfma_f32_32x32x16_bf16(PAF(1),VFR(5),o[1],0,0,0), C0,12); \
    KRD(GL,2); GAPB(o[0]=__builtin_amdgcn_mfma_f32_32x32x16_bf16(PAF(2),VFR(2),o[0],0,0,0), C1,0); \
    KRD(GL,3); GAPB(o[1]=__builtin_amdgcn_mfma_f32_32x32x16_bf16(PAF(2),VFR(6),o[1],0,0,0), C1,4); \
    GAPB(o[0]=__builtin_amdgcn_mfma_f32_32x32x16_bf16(PAF(3),VFR(3),o[0],0,0,0), C1,8); \
    GAPB(o[1]=__builtin_amdgcn_mfma_f32_32x32x16_bf16(PAF(3),VFR(7),o[1],0,0,0), C1,12); \
    }while(0)
  int t=1;
  #undef CMASK
  #define CMASK(P0,P1,t) do{}while(0)
  for(;t+5<NT;t+=2){
    STEP(pB0,pB1,pA0,pA1,t,true,true,true);     WAIT_BAR(2); RESC(); ROT();
    STEP(pA0,pA1,pB0,pB1,t+1,true,true,true);   WAIT_BAR(2); RESC(); ROT();
  }
  #undef CMASK
  #define CMASK(P0,P1,t) do{int jb_=(t)-(NT-4); if(jb_>=0)cmask(P0,P1,jb_,qrel,hi);}while(0)
  #define ENDW(tt) do{ if((tt)+3<NT){WAIT_BAR(2);} else if((tt)+2<NT){WAIT_BAR(1);} else {WAIT_BAR(0);} }while(0)
  for(;t+1<NT;t+=2){
    STEP(pB0,pB1,pA0,pA1,t,(t+3<NT),(t+1<NT),(t+1<NT));       ENDW(t);   RESC(); ROT();
    STEP(pA0,pA1,pB0,pB1,t+1,(t+4<NT),(t+2<NT),(t+2<NT));     ENDW(t+1); RESC(); ROT();
  }
  STEP(pB0,pB1,pA0,pA1,NT-1,false,false,false); RESC();
  { float sacc=pB0[0]+pB0[1]; _Pragma("unroll") for(int r=2;r<16;++r)sacc+=pB0[r]; _Pragma("unroll") for(int r=0;r<16;++r)sacc+=pB1[r]; l_reg+=sacc;
    pw0=(u32x4){PKW(pB0,0),PKW(pB0,2),PKW(pB0,4),PKW(pB0,6)};pw1=(u32x4){PKW(pB0,8),PKW(pB0,10),PKW(pB0,12),PKW(pB0,14)};pw2=(u32x4){PKW(pB1,0),PKW(pB1,2),PKW(pB1,4),PKW(pB1,6)};pw3=(u32x4){PKW(pB1,8),PKW(pB1,10),PKW(pB1,12),PKW(pB1,14)};
    SBAR(); pv(o,vb0+sl_cur,PAF(0),PAF(1),PAF(2),PAF(3)); }
  #undef PKW
  #undef PAF
  #undef VFR
  #undef PIN
  #undef MX3
  #undef GAPA
  #undef GAPB
  #undef EX
  #undef VRD
  #undef KRD
  #undef STEP
  #undef ENDW
  {auto rr=__builtin_amdgcn_permlane32_swap(__float_as_uint(l_reg),__float_as_uint(l_reg),false,false);l_reg=__uint_as_float(rr[0])+__uint_as_float(rr[1]);}
  if(hi==0)wsf[32+r32]=l_reg;asm volatile("s_waitcnt lgkmcnt(0)":::"memory");
  float rli[16];
  #pragma unroll
  for(int r=0;r<16;++r)rli[r]=__builtin_amdgcn_rcpf(wsf[32+crow(r,hi)]);
  bf16*Ow=O+(rowbase+q0+wid*QBLK)*OP+h*D;
  { bf16*stg=(bf16*)(shm+LDS_OST)+wid*2048;
    #pragma unroll
    for(int r=0;r<16;++r){const int orow=crow(r,hi);
      #pragma unroll
      for(int d0=0;d0<2;++d0)stg[orow*64+d0*32+r32]=__float2bfloat16(o[d0][r]*rli[r]);}
    asm volatile("s_waitcnt lgkmcnt(0)":::"memory");
    #pragma unroll
    for(int i=0;i<4;++i){const int row=i*8+(lane>>3),ch=lane&7; const u32x4 v=*(const u32x4*)(stg+row*64+ch*8); ATTN_STORE16(Ow+(long)row*OP+ch*8,v);} }
  asm volatile("s_waitcnt lgkmcnt(0)\n\ts_barrier":::"memory");
  #undef BIAS
  #undef DMA_K
  #undef DMA_V
  #undef CMASK
  #undef START
  #undef RESC
  #undef ROT
}
constexpr int ATTN_LDS_BYTES=LDS_BYTES;
struct AttnTensors { const bf16* Q; const bf16* K; const bf16* V; bf16* O; const float* CL; };
struct AttnUnit { int bh; int qb; };
struct StaticOrder {
  int vcu;
  __device__ __forceinline__ explicit StaticOrder(int grid,int block):vcu((block%8)*(grid/8)+block/8){}
  __device__ __forceinline__ bool next(int i,AttnUnit&u)const{ if(i>=2)return false; const int s=vcu&3; u.bh=vcu>>2; u.qb=(i==0)?7-s:s; return true; }
  __device__ __forceinline__ void a_ready(const AttnUnit&)const{}
  __device__ __forceinline__ void done(const AttnUnit&)const{}
};
template<class Sched,int THRL=8> __device__ __forceinline__ void attn_phase(char*lds,const AttnTensors&T,const Sched&S){
  AttnUnit u;
  for(int i=0;S.next(i,u);++i){ S.a_ready(u); attn_unit<THRL>(u.bh/NHEAD,u.bh%NHEAD,u.qb,T.Q,T.K,T.V,T.O,T.CL,lds); S.done(u); }
}
#undef SBAR
#undef WAIT_BAR
}

#define LAS __attribute__((address_space(3)))
typedef unsigned short bf16;
typedef unsigned v4u __attribute__((ext_vector_type(4)));
typedef unsigned v2u __attribute__((ext_vector_type(2)));
typedef float f32x4 __attribute__((ext_vector_type(4)));
constexpr int NWAVES = 8, NTHR = 512;
constexpr int BATCH = 8, SEQ = 2048, M = BATCH * SEQ, D = 1024, AW = 512, NH = 8, HD = 64, SW = 512, NG = 32, GS = 16, NP = 64, DFF = 2816, NUP = 2 * DFF, INC = 2056;
constexpr float EPS = 1e-6f;
constexpr size_t MiB = 1u << 20;
constexpr size_t WS_WIN = 1 * MiB, WS_WGLU = 5 * MiB, WS_WOUT = 6 * MiB, WS_WUP = 8 * MiB, WS_WDN = 19 * MiB;
constexpr size_t WS_TAB = 25 * MiB;
constexpr size_t TB_LOGF = 0, TB_CUM = 512 * 1024, TB_LB = 1024 * 1024, TB_BB = TB_LB + 16384, TB_BBP = 1536 * 1024, TB_CP = 1792 * 1024;
constexpr size_t WS_SS = 28 * MiB;
constexpr size_t WS_XB = 32 * MiB;
constexpr size_t WS_Q = 64 * MiB, WS_K = 80 * MiB, WS_V = 96 * MiB, WS_U = 112 * MiB, WS_YG = 128 * MiB, WS_MIX = 144 * MiB;
constexpr size_t WS_ACT = 152 * MiB, WS_HALO = 240 * MiB, WS_END = 248 * MiB;
constexpr size_t TB_SSQ2 = 2048 * 1024, TB_RSTD1 = 1408 * 1024;
constexpr int LDS_BYTES = 147456, RING_BYTES = 131072;

__device__ __forceinline__ float bf2f(unsigned v) { return __uint_as_float(v << 16); }
__device__ __forceinline__ unsigned f2bf(float f) { unsigned u = __float_as_uint(f); return (u + 0x7fffu + ((u >> 16) & 1u)) >> 16; }
__device__ __forceinline__ unsigned pk2(float lo, float hi) { return f2bf(lo) | (f2bf(hi) << 16); }
__device__ __forceinline__ float wave_sum(float v) {
#pragma unroll
    for (int o = 1; o < 64; o <<= 1) v += __shfl_xor(v, o);
    return v;
}
__device__ __forceinline__ void unpack8(const v4u w, float* f) {
    f[0] = bf2f(w.x & 0xffffu); f[1] = bf2f(w.x >> 16); f[2] = bf2f(w.y & 0xffffu); f[3] = bf2f(w.y >> 16);
    f[4] = bf2f(w.z & 0xffffu); f[5] = bf2f(w.z >> 16); f[6] = bf2f(w.w & 0xffffu); f[7] = bf2f(w.w >> 16);
}
__device__ __forceinline__ v4u pack8(const float* f) { v4u w; w.x = pk2(f[0], f[1]); w.y = pk2(f[2], f[3]); w.z = pk2(f[4], f[5]); w.w = pk2(f[6], f[7]); return w; }

namespace pg8 {
struct EpiPlain {
    static constexpr bool PERM = true, AFTER_DRAIN = false;
    bf16_t* O; int ldc; int split_cols; size_t split_stride;
    __device__ __forceinline__ void operator()(const f32x4 (&acc)[2][2][4][2], const Unit& u, int wr, int wc, int fr, int fq) const {
        const int row0 = u.pm * BM + wr * 64 + fr; int colt = u.pn * BM; bf16_t* base = O;
        if (split_cols) { const int t = colt / split_cols; base += (size_t)t * split_stride; colt -= t * split_cols; }
        const int col0 = colt + wc * 32 + 8 * fq;
#pragma unroll
        for (int ai = 0; ai < 2; ++ai)
#pragma unroll
            for (int m = 0; m < 4; ++m) { bf16_t* rowp = base + (size_t)(row0 + ai * HALF + m * 16) * ldc + col0;
#pragma unroll
                for (int bj = 0; bj < 2; ++bj) { const f32x4 v0 = acc[ai][bj][m][0], v1 = acc[ai][bj][m][1];
                    u32x4 w; w.x = cvt_pk_bf16(v0[0], v0[1]); w.y = cvt_pk_bf16(v0[2], v0[3]); w.z = cvt_pk_bf16(v1[0], v1[1]); w.w = cvt_pk_bf16(v1[2], v1[3]);
                    *(u32x4*)(rowp + bj * HALF) = w; } }
    }
};
struct EpiGlu {
    static constexpr bool PERM = true, AFTER_DRAIN = false;
    const bf16_t* YG; const float* bias; bf16_t* O; int ldo; int ocol0;
    __device__ __forceinline__ void operator()(const f32x4 (&acc)[2][2][4][2], const Unit& u, int wr, int wc, int fr, int fq) const {
        const int row0 = u.pm * BM + wr * 64 + fr; const int col0 = u.pn * BM + wc * 32 + 8 * fq;
#pragma unroll
        for (int ai = 0; ai < 2; ++ai)
#pragma unroll
            for (int m = 0; m < 4; ++m) { const int row = row0 + ai * HALF + m * 16;
#pragma unroll
                for (int bj = 0; bj < 2; ++bj) { const int col = col0 + bj * HALF;
                    const f32x4 b0 = *(const f32x4*)(bias + col), b1 = *(const f32x4*)(bias + col + 4);
                    const f32x4 v0 = acc[ai][bj][m][0] + b0, v1 = acc[ai][bj][m][1] + b1;
                    const u32x4 yw = *(const u32x4*)(YG + (size_t)row * 512 + col);
                    float y[8]; y[0] = __uint_as_float(yw.x << 16); y[1] = __uint_as_float(yw.x & 0xffff0000u); y[2] = __uint_as_float(yw.y << 16); y[3] = __uint_as_float(yw.y & 0xffff0000u);
                    y[4] = __uint_as_float(yw.z << 16); y[5] = __uint_as_float(yw.z & 0xffff0000u); y[6] = __uint_as_float(yw.w << 16); y[7] = __uint_as_float(yw.w & 0xffff0000u);
                    float o[8];
#pragma unroll
                    for (int i = 0; i < 4; ++i) { o[i] = y[i] / (1.f + __expf(-v0[i])); o[4 + i] = y[4 + i] / (1.f + __expf(-v1[i])); }
                    u32x4 w; w.x = cvt_pk_bf16(o[0], o[1]); w.y = cvt_pk_bf16(o[2], o[3]); w.z = cvt_pk_bf16(o[4], o[5]); w.w = cvt_pk_bf16(o[6], o[7]);
                    *(u32x4*)(O + (size_t)row * ldo + ocol0 + col) = w; } }
    }
};
struct EpiRes {
    static constexpr bool PERM = true, AFTER_DRAIN = false;
    const float* base; float* out; int ldc;
    __device__ __forceinline__ void operator()(const f32x4 (&acc)[2][2][4][2], const Unit& u, int wr, int wc, int fr, int fq) const {
        const int row0 = u.pm * BM + wr * 64 + fr; const int col0 = u.pn * BM + wc * 32 + 8 * fq;
#pragma unroll
        for (int ai = 0; ai < 2; ++ai)
#pragma unroll
            for (int m = 0; m < 4; ++m) { const size_t off = (size_t)(row0 + ai * HALF + m * 16) * ldc + col0;
#pragma unroll
                for (int bj = 0; bj < 2; ++bj) {
                    const f32x4 x0 = *(const f32x4*)(base + off + bj * HALF), x1 = *(const f32x4*)(base + off + bj * HALF + 4);
                    *(f32x4*)(out + off + bj * HALF) = x0 + acc[ai][bj][m][0]; *(f32x4*)(out + off + bj * HALF + 4) = x1 + acc[ai][bj][m][1]; } }
    }
};

struct EpiResB {
    static constexpr bool PERM = true, AFTER_DRAIN = false;
    const bf16_t* XB; float* out; int ldc;
    __device__ __forceinline__ void operator()(const f32x4 (&acc)[2][2][4][2], const Unit& u, int wr, int wc, int fr, int fq) const {
        const int row0 = u.pm * BM + wr * 64 + fr; const int col0 = u.pn * BM + wc * 32 + 8 * fq;
        u32x4 wres[2][4][2];
#pragma unroll
        for (int ai = 0; ai < 2; ++ai)
#pragma unroll
            for (int m = 0; m < 4; ++m)
#pragma unroll
                for (int bj = 0; bj < 2; ++bj) wres[ai][m][bj] = *(const u32x4*)(XB + (size_t)(row0 + ai * HALF + m * 16) * ldc + col0 + bj * HALF);
#pragma unroll
        for (int ai = 0; ai < 2; ++ai)
#pragma unroll
            for (int m = 0; m < 4; ++m) { const size_t off = (size_t)(row0 + ai * HALF + m * 16) * ldc + col0;
#pragma unroll
                for (int bj = 0; bj < 2; ++bj) { const u32x4 w = wres[ai][m][bj];
                    const f32x4 x0 = (f32x4){__uint_as_float(w.x << 16), __uint_as_float(w.x & 0xffff0000u), __uint_as_float(w.y << 16), __uint_as_float(w.y & 0xffff0000u)};
                    const f32x4 x1 = (f32x4){__uint_as_float(w.z << 16), __uint_as_float(w.z & 0xffff0000u), __uint_as_float(w.w << 16), __uint_as_float(w.w & 0xffff0000u)};
                    *(f32x4*)(out + off + bj * HALF) = x0 + acc[ai][bj][m][0]; *(f32x4*)(out + off + bj * HALF + 4) = x1 + acc[ai][bj][m][1]; } }
    }
};
struct EpiX1 {
    static constexpr bool PERM = true, AFTER_DRAIN = false;
    const float* base; float* out; bf16_t* XB; float* SSQ; int ldc;
    __device__ __forceinline__ void operator()(const f32x4 (&acc)[2][2][4][2], const Unit& u, int wr, int wc, int fr, int fq) const {
        const int row0 = u.pm * BM + wr * 64 + fr; const int col0 = u.pn * BM + wc * 32 + 8 * fq;
#pragma unroll
        for (int ai = 0; ai < 2; ++ai) {
            f32x4 xres[4][2][2];
#pragma unroll
            for (int m = 0; m < 4; ++m)
#pragma unroll
                for (int bj = 0; bj < 2; ++bj) { const size_t off = (size_t)(row0 + ai * HALF + m * 16) * ldc + col0 + bj * HALF; xres[m][bj][0] = *(const f32x4*)(base + off); xres[m][bj][1] = *(const f32x4*)(base + off + 4); }
#pragma unroll
            for (int m = 0; m < 4; ++m) { const int row = row0 + ai * HALF + m * 16; const size_t off = (size_t)row * ldc + col0; float q = 0.f;
#pragma unroll
                for (int bj = 0; bj < 2; ++bj) {
                    const f32x4 x0 = xres[m][bj][0] + acc[ai][bj][m][0], x1 = xres[m][bj][1] + acc[ai][bj][m][1];
                    q += (x0[0] * x0[0] + x0[1] * x0[1]) + (x0[2] * x0[2] + x0[3] * x0[3]) + (x1[0] * x1[0] + x1[1] * x1[1]) + (x1[2] * x1[2] + x1[3] * x1[3]);
                    u32x4 w; w.x = cvt_pk_bf16(x0[0], x0[1]); w.y = cvt_pk_bf16(x0[2], x0[3]); w.z = cvt_pk_bf16(x1[0], x1[1]); w.w = cvt_pk_bf16(x1[2], x1[3]);
                    *(u32x4*)(XB + off + bj * HALF) = w; }
                q += __shfl_xor(q, 16); q += __shfl_xor(q, 32);
                if (fq == 0) SSQ[(size_t)row * 16 + u.pn * 4 + wc] = q; } }
    }
};
__device__ __forceinline__ float row_up1(float prev, float cur) { float t; asm volatile("s_nop 1\n\tv_mov_b32_dpp %0, %1 row_ror:1 row_mask:0xf bank_mask:0xf\n\tv_mov_b32_dpp %0, %2 row_shr:1 row_mask:0xf bank_mask:0xf" : "=&v"(t) : "v"(prev), "v"(cur)); return t; }
__device__ __forceinline__ float row_up2(float prev, float cur) { float t; asm volatile("s_nop 1\n\tv_mov_b32_dpp %0, %1 row_ror:2 row_mask:0xf bank_mask:0xf\n\tv_mov_b32_dpp %0, %2 row_shr:2 row_mask:0xf bank_mask:0xf" : "=&v"(t) : "v"(prev), "v"(cur)); return t; }

struct EpiIn {
    static constexpr bool PERM = true, AFTER_DRAIN = false;
    const float* rstd1; const float* gq; const float* gk; bf16_t* O; size_t stride; float c2;
    __device__ __forceinline__ void operator()(const f32x4 (&acc)[2][2][4][2], const Unit& u, int wr, int wc, int fr, int fq) const {
        const int row0 = u.pm * BM + wr * 64 + fr; const int t = u.pn >> 1; bf16_t* base = O + (size_t)t * stride + ((u.pn & 1) * 4 + wc) * 64 + 8 * fq;
        f32x4 gv[2][2];
        if (t < 2) { const float* gp = t ? gk : gq; const float sc = t ? 1.f : c2;
#pragma unroll
            for (int bj = 0; bj < 2; ++bj)
#pragma unroll
                for (int n = 0; n < 2; ++n) gv[bj][n] = *(const f32x4*)(gp + 32 * bj + 8 * fq + 4 * n) * sc; }
        float rsA[2][4];
#pragma unroll
        for (int ai = 0; ai < 2; ++ai)
#pragma unroll
            for (int m = 0; m < 4; ++m) rsA[ai][m] = rstd1[row0 + ai * HALF + m * 16];
#pragma unroll
        for (int ai = 0; ai < 2; ++ai)
#pragma unroll
            for (int m = 0; m < 4; ++m) { const int row = row0 + ai * HALF + m * 16; float rs = rsA[ai][m];
                f32x4 v[2][2];
#pragma unroll
                for (int bj = 0; bj < 2; ++bj)
#pragma unroll
                    for (int n = 0; n < 2; ++n) v[bj][n] = acc[ai][bj][m][n] * rs;
                if (t < 2) { float q = 0.f;
#pragma unroll
                    for (int bj = 0; bj < 2; ++bj)
#pragma unroll
                        for (int n = 0; n < 2; ++n) q += (v[bj][n][0] * v[bj][n][0] + v[bj][n][1] * v[bj][n][1]) + (v[bj][n][2] * v[bj][n][2] + v[bj][n][3] * v[bj][n][3]);
                    q += __shfl_xor(q, 16); q += __shfl_xor(q, 32);
                    const float hr = __builtin_amdgcn_rsqf(q * (1.f / 64.f) + 1e-6f);
#pragma unroll
                    for (int bj = 0; bj < 2; ++bj)
#pragma unroll
                        for (int n = 0; n < 2; ++n) v[bj][n] = v[bj][n] * gv[bj][n] * hr; }
#pragma unroll
                for (int bj = 0; bj < 2; ++bj) { u32x4 w; w.x = cvt_pk_bf16(v[bj][0][0], v[bj][0][1]); w.y = cvt_pk_bf16(v[bj][0][2], v[bj][0][3]); w.z = cvt_pk_bf16(v[bj][1][0], v[bj][1][1]); w.w = cvt_pk_bf16(v[bj][1][2], v[bj][1][3]);
                    *(u32x4*)(base + (size_t)row * 512 + 32 * bj) = w; } }
    }
};
struct EpiUpConv {
    static constexpr bool PERM = true, AFTER_DRAIN = false;
    const float* SSQ; const float* cw; const float* cb; bf16_t* ACT; float* HALO; __attribute__((address_space(3))) float* XCH;
    __device__ __forceinline__ void operator()(f32x4 (&acc)[2][2][4][2], const Unit& u, int wr, int wc, int fr, int fq) const {
        const int row0 = u.pm * BM + wr * 64 + fr; const int tcol = wc * 32 + 8 * fq;
        const int ac0 = u.pn * HALF + tcol;
        f32x4 prm[2][8];
#define LOAD_PRM(n) do { prm[n][0] = *(const f32x4*)(cb + ac0 + 4 * (n)); prm[n][1] = *(const f32x4*)(cb + 2816 + ac0 + 4 * (n)); \
            _Pragma("unroll") for (int j = 0; j < 3; ++j) { prm[n][2 + 2 * j] = *(const f32x4*)(cw + j * 5632 + ac0 + 4 * (n)); prm[n][3 + 2 * j] = *(const f32x4*)(cw + j * 5632 + 2816 + ac0 + 4 * (n)); } } while (0)
        LOAD_PRM(0);
#pragma unroll
        for (int ai = 0; ai < 2; ++ai)
#pragma unroll
            for (int m = 0; m < 4; ++m) { const f32x4 a0 = *(const f32x4*)(SSQ + (size_t)(row0 + ai * HALF + m * 16) * 16 + 4 * fq);
                float tot = (a0[0] + a0[1]) + (a0[2] + a0[3]); tot += __shfl_xor(tot, 16); tot += __shfl_xor(tot, 32);
                const float rstd = __builtin_amdgcn_rsqf(tot * (1.f / 1024.f) + 1e-6f);
#pragma unroll
                for (int bj = 0; bj < 2; ++bj) { acc[ai][bj][m][0] *= rstd; acc[ai][bj][m][1] *= rstd; }
                __builtin_amdgcn_sched_barrier(0); }
        if (fr >= 14) {
#pragma unroll
            for (int ai = 0; ai < 2; ++ai)
#pragma unroll
                for (int bj = 0; bj < 2; ++bj)
#pragma unroll
                    for (int n = 0; n < 2; ++n) { XCH[((ai * 2 + wr) * 2 + (fr - 14)) * 256 + bj * HALF + tcol + 4 * n + 0] = acc[ai][bj][3][n][0]; XCH[((ai * 2 + wr) * 2 + (fr - 14)) * 256 + bj * HALF + tcol + 4 * n + 1] = acc[ai][bj][3][n][1];
                        XCH[((ai * 2 + wr) * 2 + (fr - 14)) * 256 + bj * HALF + tcol + 4 * n + 2] = acc[ai][bj][3][n][2]; XCH[((ai * 2 + wr) * 2 + (fr - 14)) * 256 + bj * HALF + tcol + 4 * n + 3] = acc[ai][bj][3][n][3]; }
            if (wr == 1) {
#pragma unroll
                for (int bj = 0; bj < 2; ++bj)
#pragma unroll
                    for (int n = 0; n < 2; ++n) *(f32x4*)(HALO + ((size_t)u.pm * 4 + (fr - 14)) * 5632 + u.pn * BM + bj * HALF + tcol + 4 * n) = acc[1][bj][3][n];
            }
        }
        if (fr < 2 && wr == 0) {
#pragma unroll
            for (int bj = 0; bj < 2; ++bj)
#pragma unroll
                for (int n = 0; n < 2; ++n) *(f32x4*)(HALO + ((size_t)u.pm * 4 + 2 + fr) * 5632 + u.pn * BM + bj * HALF + tcol + 4 * n) = acc[0][bj][0][n];
        }
        asm volatile("s_waitcnt lgkmcnt(0)" ::: "memory"); __builtin_amdgcn_s_barrier(); asm volatile("" ::: "memory");
        LOAD_PRM(1);
#undef LOAD_PRM
#pragma unroll
        for (int n = 0; n < 2; ++n) {
            const f32x4 cbg = prm[n][0], cbv = prm[n][1], w0g = prm[n][2], w0v = prm[n][3], w1g = prm[n][4], w1v = prm[n][5], w2g = prm[n][6], w2v = prm[n][7];
#pragma unroll
            for (int ai = 0; ai < 2; ++ai)
#pragma unroll
                for (int m = 3; m >= 0; --m) {
                    f32x4 pg, pv;
                    if (m > 0) { pg = acc[ai][0][m - 1][n]; pv = acc[ai][1][m - 1][n]; }
                    else { const int blk = (wr == 1) ? ai * 2 : 1; const bool have = (wr == 1) || (ai == 1);
                        pg = (f32x4){0.f, 0.f, 0.f, 0.f}; pv = pg;
                        if (have && fr >= 14) { pg = *(const __attribute__((address_space(3))) f32x4*)(XCH + (blk * 2 + (fr - 14)) * 256 + tcol + 4 * n); pv = *(const __attribute__((address_space(3))) f32x4*)(XCH + (blk * 2 + (fr - 14)) * 256 + HALF + tcol + 4 * n); } }
                    const f32x4 cg = acc[ai][0][m][n], cv = acc[ai][1][m][n]; f32x4 o;
#pragma unroll
                    for (int i = 0; i < 4; ++i) {
                        const float g1 = row_up1(pg[i], cg[i]), g2 = row_up2(pg[i], cg[i]), v1 = row_up1(pv[i], cv[i]), v2 = row_up2(pv[i], cv[i]);
                        const float hg = cbg[i] + w0g[i] * g2 + w1g[i] * g1 + w2g[i] * cg[i], hv = cbv[i] + w0v[i] * v2 + w1v[i] * v1 + w2v[i] * cv[i];
                        float oi = hg * __builtin_amdgcn_rcpf(1.f + __expf(-hg)) * hv; asm volatile("" : "+v"(oi)); o[i] = oi; }
                    acc[ai][0][m][n] = o; __builtin_amdgcn_sched_barrier(0); }
        }
#pragma unroll
        for (int ai = 0; ai < 2; ++ai)
#pragma unroll
            for (int m = 0; m < 4; ++m) { const f32x4 v0 = acc[ai][0][m][0], v1 = acc[ai][0][m][1];
                u32x4 w; w.x = cvt_pk_bf16(v0[0], v0[1]); w.y = cvt_pk_bf16(v0[2], v0[3]); w.z = cvt_pk_bf16(v1[0], v1[1]); w.w = cvt_pk_bf16(v1[2], v1[3]);
                *(u32x4*)(ACT + (size_t)(row0 + ai * HALF + m * 16) * 2816 + ac0) = w; }
    }
};
}

struct Args { const float* in[24]; float* out; unsigned char* ws; int ph_lo, ph_hi; };

__device__ __forceinline__ float log_sigmoid(float z) { return fminf(z, 0.f) - log1pf(expf(-fabsf(z))); }
typedef short s16x8p __attribute__((ext_vector_type(8)));
constexpr int WF_LO_OFF = 32768;
__device__ __forceinline__ void p0_prologue(const Args& a, LAS unsigned char* lds, int vcu, int gw, int NGW, int tid, int wave, int lane) {
    unsigned char* ws = a.ws;
    {
        const float* x = a.in[0]; const float* gm = a.in[1]; const float* win = a.in[2]; const float* bfv = a.in[3];
        float* logf = (float*)(ws + WS_TAB + TB_LOGF); float* rstd1 = (float*)(ws + WS_TAB + TB_RSTD1); bf16* XB = (bf16*)(ws + WS_XB);
        for (int i = tid; i < 16384; i += NTHR) ((LAS unsigned*)lds)[i] = 0u;
        __syncthreads();
        for (int k = tid; k < D; k += NTHR) { const float g = gm[k]; const f32x4 w0 = *(const f32x4*)(win + (size_t)k * INC + 1536), w1 = *(const f32x4*)(win + (size_t)k * INC + 1540);
            const float w[8] = {w0[0] * g, w0[1] * g, w0[2] * g, w0[3] * g, w1[0] * g, w1[1] * g, w1[2] * g, w1[3] * g};
            const int ks = k >> 5, q = (k >> 3) & 3, i = k & 7;
#pragma unroll
            for (int h = 0; h < 8; ++h) { const unsigned hb = f2bf(w[h]); const float lo = w[h] - bf2f(hb); const int off = ((ks * 4 + q) * 16 + h) * 16 + i * 2;
                *(LAS bf16*)(lds + off) = (bf16)hb; *(LAS bf16*)(lds + WF_LO_OFF + off) = (bf16)f2bf(lo); } }
        __syncthreads();
        const int m = lane & 15, q = lane >> 4, half = wave & 1;
        LAS float* XR = (LAS float*)(lds + 65536);
        for (int blk = vcu * 4 + (wave >> 1); blk < M / 16; blk += (NGW / 8) * 4) {
            const size_t row = (size_t)blk * 16 + m; const float* xr = x + row * D + 512 * half + 8 * q;
            f32x4 acc = (f32x4){0.f, 0.f, 0.f, 0.f}; float ssq = 0.f;
#pragma unroll
            for (int ks = 0; ks < 16; ++ks) {
                const f32x4 x0 = *(const f32x4*)(xr + 32 * ks), x1 = *(const f32x4*)(xr + 32 * ks + 4);
                const float xv[8] = {x0[0], x0[1], x0[2], x0[3], x1[0], x1[1], x1[2], x1[3]};
                unsigned hb[8]; float lo[8];
#pragma unroll
                for (int i = 0; i < 8; ++i) { hb[i] = f2bf(xv[i]); lo[i] = xv[i] - bf2f(hb[i]); ssq += xv[i] * xv[i]; }
                v4u hw; hw.x = hb[0] | (hb[1] << 16); hw.y = hb[2] | (hb[3] << 16); hw.z = hb[4] | (hb[5] << 16); hw.w = hb[6] | (hb[7] << 16);
                const v4u lw = pack8(lo);
                *(v4u*)(XB + row * D + 512 * half + 32 * ks + 8 * q) = hw;
                const int kst = 16 * half + ks;
                const s16x8p bh = *(const LAS s16x8p*)(lds + ((kst * 4 + q) * 16 + m) * 16), bl = *(const LAS s16x8p*)(lds + WF_LO_OFF + ((kst * 4 + q) * 16 + m) * 16);
                const s16x8p ah = __builtin_bit_cast(s16x8p, hw), al = __builtin_bit_cast(s16x8p, lw);
                acc = __builtin_amdgcn_mfma_f32_16x16x32_bf16(ah, bh, acc, 0, 0, 0);
                acc = __builtin_amdgcn_mfma_f32_16x16x32_bf16(ah, bl, acc, 0, 0, 0);
                acc = __builtin_amdgcn_mfma_f32_16x16x32_bf16(al, bh, acc, 0, 0, 0);
            }
            ssq += __shfl_xor(ssq, 16); ssq += __shfl_xor(ssq, 32);
            __syncthreads();
            if (half) { LAS float* p = XR + ((wave >> 1) * 64 + lane) * 5; p[0] = acc[0]; p[1] = acc[1]; p[2] = acc[2]; p[3] = acc[3]; p[4] = ssq; }
            __syncthreads();
            if (!half) { const LAS float* p = XR + ((wave >> 1) * 64 + lane) * 5; acc[0] += p[0]; acc[1] += p[1]; acc[2] += p[2]; acc[3] += p[3]; ssq += p[4];
                const float rstd = 1.f / sqrtf(ssq * (1.f / D) + EPS);
                if (q == 0) rstd1[row] = rstd;
#pragma unroll
                for (int j = 0; j < 4; ++j) { const float rt = __shfl(rstd, 4 * q + j); if (m < 8) logf[((size_t)blk * 16 + 4 * q + j) * 8 + m] = log_sigmoid(acc[j] * rt + bfv[m]); } }
        }
        __syncthreads();
    }
    {
        constexpr int I_IN = 32 * 32, I_GLU = 8 * 16, I_OUT = 16 * 32, I_UP = 88 * 32, I_DN = 16 * 88, NITEMS = I_IN + I_GLU + I_OUT + I_UP + I_DN;
        struct WItem { const float* src; const float* g; bf16* dst; int ldn; int frag; };
        auto decode = [&](int it, WItem& w) {
            int r = it;
            if (r < I_IN) { const int nb = r / 32, kb = r % 32, dn = 64 * nb + lane, tl = dn >> 8, c = dn & 255;
                int sn = tl * 256 + 64 * ((c >> 5) & 3) + 32 * (c >> 7) + (c & 31); if (sn >= 1536) sn += 8;
                w.src = a.in[2] + (size_t)(32 * kb) * INC + sn; w.ldn = INC; w.g = a.in[1] + 32 * kb; w.dst = (bf16*)(ws + WS_WIN) + (size_t)dn * D + 32 * kb; w.frag = 0; return; } r -= I_IN;
            if (r < I_GLU) { const int nb = r / 16, kb = r % 16, dn = 64 * nb + lane;
                w.src = a.in[14] + (size_t)(32 * kb) * SW + dn; w.ldn = SW; w.g = nullptr; w.dst = (bf16*)(ws + WS_WGLU) + ((size_t)(kb * 32 + (dn >> 4)) * 64 + (dn & 15)) * 8; w.frag = 1; return; } r -= I_GLU;
            if (r < I_OUT) { const int nb = r / 32, kb = r % 32, dn = 64 * nb + lane, k0 = 32 * kb;
                w.src = a.in[18] + (size_t)k0 * D + dn; w.ldn = D; w.g = (k0 < AW) ? a.in[16] + k0 : a.in[17] + (k0 - AW); w.dst = (bf16*)(ws + WS_WOUT) + (size_t)dn * D + k0; w.frag = 0; return; } r -= I_OUT;
            if (r < I_UP) { const int nb = r / 32, kb = r % 32, dn = 64 * nb + lane, tl = dn >> 8, cc = dn & 255, sn = cc < 128 ? 128 * tl + cc : DFF + 128 * tl + cc - 128;
                w.src = a.in[20] + (size_t)(32 * kb) * NUP + sn; w.ldn = NUP; w.g = a.in[19] + 32 * kb; w.dst = (bf16*)(ws + WS_WUP) + (size_t)dn * D + 32 * kb; w.frag = 0; return; } r -= I_UP;
            { const int nb = r / 88, kb = r % 88, dn = 64 * nb + lane;
                w.src = a.in[23] + (size_t)(32 * kb) * D + dn; w.ldn = D; w.g = nullptr; w.dst = (bf16*)(ws + WS_WDN) + (size_t)dn * DFF + 32 * kb; w.frag = 0; }
        };
        for (int it = gw; it < NITEMS; it += 2 * NGW) {
            const bool two = it + NGW < NITEMS;
            WItem w0, w1; decode(it, w0); decode(two ? it + NGW : it, w1);
            float v0[32], v1[32];
#pragma unroll
            for (int i = 0; i < 32; ++i) v0[i] = w0.src[(size_t)i * w0.ldn];
            if (two) {
#pragma unroll
                for (int i = 0; i < 32; ++i) v1[i] = w1.src[(size_t)i * w1.ldn]; }
            if (w0.g) {
#pragma unroll
                for (int i = 0; i < 32; ++i) v0[i] *= w0.g[i]; }
            if (two && w1.g) {
#pragma unroll
                for (int i = 0; i < 32; ++i) v1[i] *= w1.g[i]; }
#pragma unroll
            for (int j = 0; j < 4; ++j) *(v4u*)(w0.dst + (w0.frag ? j * 128 : 8 * j)) = pack8(v0 + 8 * j);
            if (two) {
#pragma unroll
                for (int j = 0; j < 4; ++j) *(v4u*)(w1.dst + (w1.frag ? j * 128 : 8 * j)) = pack8(v1 + 8 * j); }
        }
    }
    {
        const float* lre = a.in[6]; const float* lim = a.in[7]; const float* lst = a.in[8]; const float* bre = a.in[9]; const float* bim = a.in[10]; const float* cre = a.in[11]; const float* cim = a.in[12];
        float* LB = (float*)(ws + WS_TAB + TB_LB); bf16* BBP = (bf16*)(ws + WS_TAB + TB_BBP); unsigned* CP = (unsigned*)(ws + WS_TAB + TB_CP);
        for (int j = gw * 64 + lane; j < NG * NP * GS; j += NGW * 64) {
            const int i = j >> 4, h = j & 15, g = i / NP, p = i % NP, n = p & 31, slot = p >> 5;
            const float lr = lre[i], li = lim[i], lsv = lst[g], br = bre[j], bi = bim[j], cr = cre[(size_t)(g * GS + h) * NP + p], ci = cim[(size_t)(g * GS + h) * NP + p];
            const float step = expf(lsv), er = expf(lr * step), ar = er * cosf(li * step), ai = er * sinf(li * step);
            const float nr = ar - 1.f, ni = ai, den = lr * lr + li * li;
            const float fr = (nr * lr + ni * li) / den, fi = (ni * lr - nr * li) / den;
            if (h == 0) { LB[2 * i] = ar; LB[2 * i + 1] = ai; }
            BBP[((size_t)(g * 4 + slot) * 32 + n) * 16 + h] = (bf16)f2bf(fr * br - fi * bi); BBP[((size_t)(g * 4 + 2 + slot) * 32 + n) * 16 + h] = (bf16)f2bf(fr * bi + fi * br);
            CP[(size_t)(g * GS + h) * 64 + p] = pk2(cr, -ci);
        }
    }
}

__device__ __forceinline__ void cumsum_bh(const Args& a, LAS unsigned char* lds, int bh, int wave, int lane) {
    const float* logf = (const float*)(a.ws + WS_TAB + TB_LOGF); float* cum = (float*)(a.ws + WS_TAB + TB_CUM);
    LAS float* tot = (LAS float*)(lds + RING_BYTES + 8192);
    const int b = bh / NH, h = bh % NH, t = 256 * wave + 4 * lane; float loc[4]; float acc = 0.f;
#pragma unroll
    for (int i = 0; i < 4; ++i) { acc += logf[((size_t)b * SEQ + t + i) * 8 + h]; loc[i] = acc; }
    float incl = acc;
#pragma unroll
    for (int o = 1; o < 64; o <<= 1) { const float nn = __shfl_up(incl, o); if (lane >= o) incl += nn; }
    if (lane == 63) tot[wave] = incl;
    __syncthreads();
    float off = incl - acc;
#pragma unroll
    for (int w = 0; w < 8; ++w) off += (w < wave) ? tot[w] : 0.f;
    f32x4 o4;
#pragma unroll
    for (int i = 0; i < 4; ++i) o4[i] = (loc[i] + off) * 1.4426950408889634f;
    *(f32x4*)(cum + (size_t)bh * SEQ + t) = o4;
    __syncthreads();
}

__device__ __forceinline__ float gelu_tanh(float x) { const float u = 0.7978845608028654f * (x + 0.044715f * x * x * x); const float e = __expf(2.f * u); return x * (1.f - __builtin_amdgcn_rcpf(e + 1.f)); }
typedef short s16x8 __attribute__((ext_vector_type(8)));
typedef float v2f __attribute__((ext_vector_type(2)));
typedef float f32x16v __attribute__((ext_vector_type(16)));
#define CFMA(xr, xi, lr, li, br, bi) do { const float nr_ = fmaf(lr, xr, fmaf(-(li), xi, br)), ni_ = fmaf(lr, xi, fmaf(li, xr, bi)); xr = nr_; xi = ni_; } while (0)
#define CSQR(r, i) do { const float nr_ = r * r - i * i, ni_ = 2.f * r * i; r = nr_; i = ni_; } while (0)
__device__ __forceinline__ void ssm_a_unit(const Args& a, int unit, int wave, int lane) {
    unsigned char* ws = a.ws;
    const int b = unit >> 5, c = unit & 31; const size_t t0 = (size_t)b * SEQ + 64 * c;
    const int n = lane & 31, hi = lane >> 5, sig = 16 * ((n >> 2) & 1) + 4 * (n >> 3) + (n & 3);
    const bf16* U = (const bf16*)(ws + WS_U); const float* LB = (const float*)(ws + WS_TAB + TB_LB); const bf16* BBP = (const bf16*)(ws + WS_TAB + TB_BBP); float* SS = (float*)(ws + WS_SS);
    const f32x16v zero = f32x16v{};
#pragma unroll 1
    for (int gi = 0; gi < 4; ++gi) {
        const int g = wave * 4 + gi;
        float lr[2], li[2], l16r[2], l16i[2];
#pragma unroll
        for (int sl = 0; sl < 2; ++sl) { lr[sl] = LB[2 * (g * NP + n + 32 * sl)]; li[sl] = LB[2 * (g * NP + n + 32 * sl) + 1]; l16r[sl] = lr[sl]; l16i[sl] = li[sl];
#pragma unroll
            for (int q = 0; q < 4; ++q) CSQR(l16r[sl], l16i[sl]); }
        s16x8 bfr[4];
#pragma unroll
        for (int nb = 0; nb < 4; ++nb) bfr[nb] = *(const s16x8*)(BBP + ((size_t)(g * 4 + nb) * 32 + n) * 16 + 8 * hi);
        float tr[2] = {0.f, 0.f}, ti[2] = {0.f, 0.f};
#pragma unroll
        for (int sb = 0; sb < 2; ++sb) {
            const s16x8 afr = *(const s16x8*)(U + (t0 + 32 * sb + sig) * SW + 16 * g + 8 * hi);
            f32x16v d[4];
#pragma unroll
            for (int nb = 0; nb < 4; ++nb) d[nb] = __builtin_amdgcn_mfma_f32_32x32x16_bf16(afr, bfr[nb], zero, 0, 0, 0);
#pragma unroll
            for (int sl = 0; sl < 2; ++sl) { float sr = 0.f, si = 0.f;
#pragma unroll
                for (int r = 0; r < 16; ++r) CFMA(sr, si, lr[sl], li[sl], d[sl][r], d[2 + sl][r]);
                if (sb == 0) { float qr = l16r[sl], qi = l16i[sl]; CSQR(qr, qi); tr[sl] = qr * sr - qi * si; ti[sl] = qr * si + qi * sr; }
                else { tr[sl] += sr; ti[sl] += si; } }
        }
#pragma unroll
        for (int sl = 0; sl < 2; ++sl) {
            float vr = tr[sl], vi = ti[sl];
            if (hi == 0) { const float nr = l16r[sl] * vr - l16i[sl] * vi, ni = l16r[sl] * vi + l16i[sl] * vr; vr = nr; vi = ni; }
            vr += __shfl_xor(vr, 32); vi += __shfl_xor(vi, 32);
            if (hi == 0) { float* o = SS + ((((size_t)b * 32 + c) * NG + g) * NP + n + 32 * sl) * 2; o[0] = vr; o[1] = vi; }
        }
    }
}
constexpr int XT_PITCH = 68, XT_BYTES = 32 * XT_PITCH * 4, YT_OFF = 8 * XT_BYTES, YT_PITCH = 1040, RED_OFF = YT_OFF + 64 * YT_PITCH;
static_assert(RED_OFF + 2048 <= LDS_BYTES, "ssm LDS");
__device__ __forceinline__ void ssm_b_unit(const Args& a, LAS unsigned char* lds, int unit, int wave, int lane) {
    unsigned char* ws = a.ws;
    asm volatile("" : "+v"(lane));
    const int b = unit >> 5, c = unit & 31; const size_t t0 = (size_t)b * SEQ + 64 * c;
    const int n = lane & 31, hi = lane >> 5, fr = lane & 15, fq = lane >> 4, sig = 16 * ((n >> 2) & 1) + 4 * (n >> 3) + (n & 3);
    const bf16* U = (const bf16*)(ws + WS_U); const float* LB = (const float*)(ws + WS_TAB + TB_LB); const bf16* BBP = (const bf16*)(ws + WS_TAB + TB_BBP);
    const bf16* CP = (const bf16*)(ws + WS_TAB + TB_CP); const float* SS = (const float*)(ws + WS_SS); const float* dsk = a.in[13];
    LAS unsigned* XT = (LAS unsigned*)(lds + wave * XT_BYTES);
    LAS unsigned char* YT = lds + YT_OFF; LAS float* RED = (LAS float*)(lds + RED_OFF);
    const f32x16v zero = f32x16v{};
    float xcrA[4][2], xciA[4][2];
    {
        float l128r[4][2], l128i[4][2], wr_[4][2], wi_[4][2];
#pragma unroll
        for (int gi = 0; gi < 4; ++gi)
#pragma unroll
            for (int sl = 0; sl < 2; ++sl) { const int g = wave * 4 + gi; const v2f lb = *(const v2f*)(LB + 2 * (g * NP + n + 32 * sl));
                float r = lb.x, i = lb.y;
#pragma unroll
                for (int q = 0; q < 4; ++q) CSQR(r, i);
                CSQR(r, i); CSQR(r, i);
                wr_[gi][sl] = hi ? r : 1.f; wi_[gi][sl] = hi ? i : 0.f; CSQR(r, i); l128r[gi][sl] = r; l128i[gi][sl] = i; xcrA[gi][sl] = 0.f; xciA[gi][sl] = 0.f; }
        const float* sp0 = SS + ((((size_t)b * 32) * NG + wave * 4) * NP + n) * 2;
#pragma unroll 2
        for (int k = hi; k < c; k += 2) {
#pragma unroll
            for (int gi = 0; gi < 4; ++gi)
#pragma unroll
                for (int sl = 0; sl < 2; ++sl) { const v2f sv = *(const v2f*)(sp0 + (size_t)(c - 1 - k) * NG * NP * 2 + (gi * NP + 32 * sl) * 2);
                    xcrA[gi][sl] += wr_[gi][sl] * sv.x - wi_[gi][sl] * sv.y; xciA[gi][sl] += wr_[gi][sl] * sv.y + wi_[gi][sl] * sv.x;
                    const float nwr = wr_[gi][sl] * l128r[gi][sl] - wi_[gi][sl] * l128i[gi][sl], nwi = wr_[gi][sl] * l128i[gi][sl] + wi_[gi][sl] * l128r[gi][sl]; wr_[gi][sl] = nwr; wi_[gi][sl] = nwi; } }
#pragma unroll
        for (int gi = 0; gi < 4; ++gi)
#pragma unroll
            for (int sl = 0; sl < 2; ++sl) { xcrA[gi][sl] += __shfl_xor(xcrA[gi][sl], 32); xciA[gi][sl] += __shfl_xor(xciA[gi][sl], 32); }
    }
#pragma unroll 1
    for (int gp = 0; gp < 2; ++gp)
#pragma unroll
    for (int gi2 = 0; gi2 < 2; ++gi2) {
        const int gi = 2 * gp + gi2, g = wave * 4 + gi;
        float lr[2], li[2], l16r[2], l16i[2], xcr[2], xci[2];
#pragma unroll
        for (int sl = 0; sl < 2; ++sl) { const v2f lb = *(const v2f*)(LB + 2 * (g * NP + n + 32 * sl)); lr[sl] = lb.x; li[sl] = lb.y; l16r[sl] = lb.x; l16i[sl] = lb.y;
#pragma unroll
            for (int q = 0; q < 4; ++q) CSQR(l16r[sl], l16i[sl]);
            xcr[sl] = gp ? xcrA[2 + gi2][sl] : xcrA[gi2][sl]; xci[sl] = gp ? xciA[2 + gi2][sl] : xciA[gi2][sl]; }
        s16x8 bfr[4], cfr[4];
#pragma unroll
        for (int nb = 0; nb < 4; ++nb) bfr[nb] = *(const s16x8*)(BBP + ((size_t)(g * 4 + nb) * 32 + n) * 16 + 8 * hi);
#pragma unroll
        for (int kk = 0; kk < 4; ++kk) cfr[kk] = *(const s16x8*)(CP + (size_t)(g * GS + fr) * 128 + 32 * kk + 8 * fq);
        const f32x4 dk = *(const f32x4*)(dsk + g * GS + 4 * fq);
#pragma unroll
        for (int sb = 0; sb < 2; ++sb) {
            const s16x8 afr = *(const s16x8*)(U + (t0 + 32 * sb + sig) * SW + 16 * g + 8 * hi);
            f32x16v d[4];
#pragma unroll
            for (int nb = 0; nb < 4; ++nb) d[nb] = __builtin_amdgcn_mfma_f32_32x32x16_bf16(afr, bfr[nb], zero, 0, 0, 0);
#pragma unroll
            for (int sl = 0; sl < 2; ++sl) {
                float sr = 0.f, si = 0.f;
#pragma unroll
                for (int r = 0; r < 16; ++r) CFMA(sr, si, lr[sl], li[sl], d[sl][r], d[2 + sl][r]);
                const float orr = __shfl_xor(sr, 32), oii = __shfl_xor(si, 32);
                const float ser = hi ? orr : sr, sei = hi ? oii : si, sor = hi ? sr : orr, soi = hi ? si : oii;
                float xnr = xcr[sl], xni = xci[sl]; CFMA(xnr, xni, l16r[sl], l16i[sl], ser, sei);
                float xr = hi ? xnr : xcr[sl], xi = hi ? xni : xci[sl];
                float x2r = xnr, x2i = xni; CFMA(x2r, x2i, l16r[sl], l16i[sl], sor, soi); xcr[sl] = x2r; xci[sl] = x2i;
#pragma unroll
                for (int r = 0; r < 16; ++r) { CFMA(xr, xi, lr[sl], li[sl], d[sl][r], d[2 + sl][r]); XT[(16 * hi + r) * XT_PITCH + n + 32 * sl] = pg8::cvt_pk_bf16(xr, xi); }
            }
#pragma unroll
            for (int mb = 0; mb < 2; ++mb) {
                f32x4 acc = (f32x4){0.f, 0.f, 0.f, 0.f};
#pragma unroll
                for (int kk = 0; kk < 4; ++kk) { const s16x8 xf = *(const LAS s16x8*)(XT + (16 * mb + fr) * XT_PITCH + 16 * kk + 4 * fq); acc = __builtin_amdgcn_mfma_f32_16x16x32_bf16(cfr[kk], xf, acc, 0, 0, 0); }
                const int s = 32 * sb + 16 * mb + fr;
                const v2u uw = *(const v2u*)(U + (t0 + s) * SW + 16 * g + 4 * fq);
                const float y0 = gelu_tanh(acc[0] + dk[0] * bf2f(uw.x & 0xffffu)), y1 = gelu_tanh(acc[1] + dk[1] * bf2f(uw.x >> 16)), y2 = gelu_tanh(acc[2] + dk[2] * bf2f(uw.y & 0xffffu)), y3 = gelu_tanh(acc[3] + dk[3] * bf2f(uw.y >> 16));
                v2u yw; yw.x = pg8::cvt_pk_bf16(y0, y1); yw.y = pg8::cvt_pk_bf16(y2, y3);
                *(LAS v2u*)(YT + s * YT_PITCH + (16 * g + 4 * fq) * 2) = yw;
            }
        }
    }
    __syncthreads();
    const bf16* WG = (const bf16*)(ws + WS_WGLU); const float* bg = a.in[15]; bf16* MIX = (bf16*)(ws + WS_MIX);
    f32x4 acc[4][4];
#pragma unroll
    for (int mb = 0; mb < 4; ++mb)
#pragma unroll
        for (int nb = 0; nb < 4; ++nb) acc[mb][nb] = (f32x4){0.f, 0.f, 0.f, 0.f};
    v4u wat[8];
#pragma unroll
    for (int r = 0; r < 8; ++r) wat[r] = *(const v4u*)(MIX + (t0 + wave * 8 + r) * D + 8 * lane);
    s16x8 wq[4][4];
    const bf16* wpf = WG + ((size_t)(4 * wave) * 64 + lane) * 8;
#pragma unroll
    for (int st = 0; st < 3; ++st) {
#pragma unroll
        for (int nb = 0; nb < 4; ++nb) wq[st][nb] = *(const s16x8*)(wpf + nb * 512);
        wpf += 32 * 512; }
#pragma unroll 1
    for (int kk4 = 0; kk4 < 16; kk4 += 4) {
        asm volatile("" : "+v"(wpf));
#pragma unroll
        for (int j = 0; j < 4; ++j) {
            const int kk = kk4 + j;
            s16x8 wf[4], yf[4];
#pragma unroll
            for (int nb = 0; nb < 4; ++nb) wf[nb] = wq[j][nb];
            if (kk + 3 < 16) {
#pragma unroll
                for (int nb = 0; nb < 4; ++nb) wq[(j + 3) & 3][nb] = *(const s16x8*)(wpf + nb * 512);
                wpf += 32 * 512; }
#pragma unroll
            for (int mb = 0; mb < 4; ++mb) yf[mb] = *(const LAS s16x8*)(YT + (16 * mb + fr) * YT_PITCH + (32 * kk + 8 * fq) * 2);
#pragma unroll
            for (int mb = 0; mb < 4; ++mb)
#pragma unroll
                for (int nb = 0; nb < 4; ++nb) acc[mb][nb] = __builtin_amdgcn_mfma_f32_16x16x32_bf16(wf[nb], yf[mb], acc[mb][nb], 0, 0, 0);
        }
    }
#pragma unroll
    for (int mb = 0; mb < 4; ++mb) { float q = 0.f;
#pragma unroll
        for (int nb = 0; nb < 4; ++nb) { const int n0 = 64 * wave + 16 * nb + 4 * fq; const f32x4 bv = *(const f32x4*)(bg + n0);
            const v2u yw = *(const LAS v2u*)(YT + (16 * mb + fr) * YT_PITCH + n0 * 2);
            const float y[4] = {bf2f(yw.x & 0xffffu), bf2f(yw.x >> 16), bf2f(yw.y & 0xffffu), bf2f(yw.y >> 16)};
#pragma unroll
            for (int j = 0; j < 4; ++j) { const float o = y[j] * __builtin_amdgcn_rcpf(1.f + __expf(-(acc[mb][nb][j] + bv[j]))); acc[mb][nb][j] = o; q += o * o; } }
        q += __shfl_xor(q, 16); q += __shfl_xor(q, 32);
        if (fq == 0) RED[wave * 64 + 16 * mb + fr] = q; }
    __syncthreads();
#pragma unroll
    for (int mb = 0; mb < 4; ++mb) { const int s = 16 * mb + fr; float tot = 0.f;
#pragma unroll
        for (int w = 0; w < 8; ++w) tot += RED[w * 64 + s];
        const float rstd = 1.f / sqrtf(tot * (1.f / SW) + EPS);
#pragma unroll
        for (int nb = 0; nb < 4; ++nb) { v2u ow; ow.x = pg8::cvt_pk_bf16(acc[mb][nb][0] * rstd, acc[mb][nb][1] * rstd); ow.y = pg8::cvt_pk_bf16(acc[mb][nb][2] * rstd, acc[mb][nb][3] * rstd);
            *(v2u*)(MIX + (t0 + s) * D + AW + 64 * wave + 16 * nb + 4 * fq) = ow; } }
    {
#pragma unroll
      for (int r = 0; r < 8; ++r) { float f[8]; unpack8(wat[r], f); float q = 0.f;
#pragma unroll
          for (int i = 0; i < 8; ++i) q += f[i] * f[i];
          const float rstd = 1.f / sqrtf(wave_sum(q) * (1.f / AW) + EPS);
#pragma unroll
          for (int i = 0; i < 8; ++i) f[i] *= rstd;
          *(v4u*)(MIX + (t0 + wave * 8 + r) * D + 8 * lane) = pack8(f); } }
    __syncthreads();
}

__device__ __forceinline__ void p_fixup(const Args& a, int pm, int tid) {
    const float* HALO = (const float*)(a.ws + WS_HALO); bf16* ACT = (bf16*)(a.ws + WS_ACT); const float* cw = a.in[21]; const float* cb = a.in[22];
    if ((pm & 7) == 0) return;
    const float* hp = HALO + (size_t)(pm - 1) * 4 * 5632; const float* hc = HALO + (size_t)pm * 4 * 5632;
    v2u res[3];
#pragma unroll
    for (int k = 0; k < 3; ++k) {
        const int it = tid + k * NTHR, itc = it < 2 * (DFF / 4) ? it : 0, r = itc / (DFF / 4), ac = (itc % (DFF / 4)) * 4, cg = (ac >> 7) * 256 + (ac & 127), cv = cg + 128;
        const f32x4 g0 = *(const f32x4*)((r ? hp + 5632 : hp) + cg), g1 = *(const f32x4*)((r ? hc + 2 * 5632 : hp + 5632) + cg), g2 = *(const f32x4*)((r ? hc + 3 * 5632 : hc + 2 * 5632) + cg);
        const f32x4 v0 = *(const f32x4*)((r ? hp + 5632 : hp) + cv), v1 = *(const f32x4*)((r ? hc + 2 * 5632 : hp + 5632) + cv), v2 = *(const f32x4*)((r ? hc + 3 * 5632 : hc + 2 * 5632) + cv);
        const f32x4 hg = *(const f32x4*)(cb + ac) + *(const f32x4*)(cw + ac) * g0 + *(const f32x4*)(cw + NUP + ac) * g1 + *(const f32x4*)(cw + 2 * NUP + ac) * g2;
        const f32x4 hv = *(const f32x4*)(cb + DFF + ac) + *(const f32x4*)(cw + DFF + ac) * v0 + *(const f32x4*)(cw + NUP + DFF + ac) * v1 + *(const f32x4*)(cw + 2 * NUP + DFF + ac) * v2;
        float o[4];
#pragma unroll
        for (int i = 0; i < 4; ++i) o[i] = hg[i] * __builtin_amdgcn_rcpf(1.f + __expf(-hg[i])) * hv[i];
        res[k].x = pk2(o[0], o[1]); res[k].y = pk2(o[2], o[3]);
    }
#pragma unroll
    for (int k = 0; k < 3; ++k) { const int it = tid + k * NTHR; if (it < 2 * (DFF / 4)) { const int r = it / (DFF / 4), ac = (it % (DFF / 4)) * 4; *(v2u*)(ACT + (size_t)(pm * 256 + r) * DFF + ac) = res[k]; } }
}

#define XB_TMO      128
#define XB_XCNT(j)  (256  + 64 * (j))
#define XB_XSUB(j)  (1280 + 64 * (j))
#define XB_XGEN(j)  (2304 + 64 * (j))
#define XB_TOP      3328
#define XB_TOPGEN   3392
#define XCD_BAR_WORDS 3456
#define XB_SPIN_CAP (1u << 18)

__device__ __forceinline__ unsigned xb_ld(unsigned* p)              { return __hip_atomic_load(p, __ATOMIC_RELAXED, __HIP_MEMORY_SCOPE_AGENT); }
__device__ __forceinline__ unsigned xb_add(unsigned* p, unsigned v) { return __hip_atomic_fetch_add(p, v, __ATOMIC_RELAXED, __HIP_MEMORY_SCOPE_AGENT); }
__device__ __forceinline__ unsigned xb_xcc_id() { return (unsigned)__builtin_amdgcn_s_getreg((3 << 11) | 20) & 0xFu; }
#define XB_SPIN(cond, bar) do { unsigned _sp = 0; while (cond) { __builtin_amdgcn_s_sleep(1); \
    if ((++_sp & 255u) == 0u) { if (xb_ld(&(bar)[XB_TMO])) break; if (_sp > XB_SPIN_CAP) { atomicAdd(&(bar)[XB_TMO], 1u); break; } } } } while (0)

struct XcdBarrier {
    unsigned* bar; unsigned x;
    volatile LAS unsigned* st;
};

__device__ __forceinline__ XcdBarrier xcd_barrier_post(unsigned* bar, volatile LAS unsigned* st) {
    XcdBarrier b; b.bar = bar; b.x = xb_xcc_id(); b.st = st;
    if (threadIdx.x == 0) (void)xb_add(&bar[XB_XCNT(b.x)], 1u);
    return b;
}
__device__ __forceinline__ void xcd_barrier_complete(unsigned* bar, unsigned x, unsigned& nloc, unsigned& nx) {
    const unsigned G = gridDim.x * gridDim.y * gridDim.z;
    unsigned sum, cnt, mine, sp = 0u;
    for (;;) {
        sum = 0u; cnt = 0u; mine = 0u;
#pragma unroll
        for (unsigned j = 0; j < 16; ++j) { const unsigned c = xb_ld(&bar[XB_XCNT(j)]); sum += c; cnt += (c > 0u) ? 1u : 0u; mine = (j == x) ? c : mine; }
        if (sum == G) break;
        __builtin_amdgcn_s_sleep(1);
        if ((++sp & 255u) == 0u) { if (xb_ld(&bar[XB_TMO])) break; if (sp > XB_SPIN_CAP) { atomicAdd(&bar[XB_TMO], 1u); break; } }
    }
    nloc = mine > 0u ? mine : 1u; nx = cnt > 0u ? cnt : 1u;
}

__device__ __forceinline__ void xcd_barrier(const XcdBarrier& b) {
    asm volatile("s_waitcnt vmcnt(0)" ::: "memory");
    __syncthreads();
    if (threadIdx.x == 0) {
        unsigned* bar = b.bar;
        __builtin_amdgcn_s_waitcnt(0);
        unsigned nloc = b.st[0], nx = b.st[1];
        if (nloc == 0u) { xcd_barrier_complete(bar, b.x, nloc, nx); b.st[0] = nloc; b.st[1] = nx; }
        const unsigned old = xb_add(&bar[XB_XSUB(b.x)], 1u);
        const unsigned gen = old / nloc;
        if (old + 1u == (gen + 1u) * nloc) {
            __builtin_amdgcn_fence(__ATOMIC_RELEASE, "agent");
            asm volatile("s_waitcnt vmcnt(0)" ::: "memory");
            const unsigned og = xb_add(&bar[XB_TOP], 1u);
            const unsigned tg = og / nx;
            if (og + 1u == (tg + 1u) * nx) xb_add(&bar[XB_TOPGEN], 1u);
            else XB_SPIN(xb_ld(&bar[XB_TOPGEN]) == tg, bar);
            __builtin_amdgcn_fence(__ATOMIC_ACQUIRE, "agent");
            xb_add(&bar[XB_XGEN(b.x)], 1u);
            asm volatile("s_waitcnt vmcnt(0)" ::: "memory");
        } else {
            XB_SPIN(xb_ld(&bar[XB_XGEN(b.x)]) == gen, bar);
            __builtin_amdgcn_fence(__ATOMIC_ACQUIRE, "agent");
            asm volatile("s_waitcnt vmcnt(0)" ::: "memory");
        }
    }
    __syncthreads();
}

__global__ void __launch_bounds__(NTHR, 2) fwd_kernel(Args args) {
    extern __shared__ __attribute__((aligned(16))) unsigned char lds_raw[];
    LAS unsigned char* lds = (LAS unsigned char*)lds_raw;
    cg::grid_group grid = cg::this_grid();
    int tid = threadIdx.x, lane = tid & 63; const int wave = __builtin_amdgcn_readfirstlane(tid >> 6);
    const int G = gridDim.x, bx = blockIdx.x, vcu = (G % 8 == 0) ? (bx % 8) * (G / 8) + bx / 8 : bx;
    const int gw = vcu * NWAVES + wave, NGW = G * NWAVES, NT = G * NTHR; int gtid = vcu * NTHR + tid;
    unsigned char* ws = args.ws;
    const int lo = args.ph_lo, hi = args.ph_hi;
    volatile LAS unsigned* MISC = (volatile LAS unsigned*)(lds + LDS_BYTES - 128);
    if (tid < 32) MISC[tid] = 0u;
    __syncthreads();
    XcdBarrier bar; bar.bar = (unsigned*)ws + 4096; bar.x = 0; bar.st = nullptr;
    if (hi - lo > 1) {
        if (bx == 0) for (int i = tid; i < XCD_BAR_WORDS; i += NTHR) ((unsigned*)ws)[4096 + i] = 0u;
        grid.sync();
        bar = xcd_barrier_post((unsigned*)ws + 4096, MISC + 8); }
#define IN(k) (lo <= (k) && (k) < hi)
#define REFRESH() do { int t_ = threadIdx.x; asm volatile("" : "+v"(t_)); tid = t_; lane = tid & 63; gtid = vcu * NTHR + tid; } while (0)
#define SYNC(k) do { if (IN(k) && IN((k) + 1)) xcd_barrier(bar); REFRESH(); } while (0)
    if (IN(0)) { p0_prologue(args, lds, vcu, gw, NGW, tid, wave, lane); } SYNC(0);
    if (IN(1)) {
        if (bx < BATCH * NH) cumsum_bh(args, lds, bx, wave, lane);
        pg8::Gemm g{(const pg8::bf16_t*)(ws + WS_XB), (const pg8::bf16_t*)(ws + WS_WIN), M, 2048, D}; pg8::StaticOrder S; S.init(M, 2048, G, bx);
        pg8::EpiIn E{(const float*)(ws + WS_TAB + TB_RSTD1), args.in[4], args.in[5], (pg8::bf16_t*)(ws + WS_Q), (size_t)M * AW, attn_body::C2};
        pg8::gemm_phase<pg8::EpiIn, pg8::StaticOrder, true, true>(lds, g, S, E);
    } SYNC(1);
    if (IN(2)) {
        { const attn_body::AttnTensors AT{(const attn_body::bf16*)(ws + WS_Q), (const attn_body::bf16*)(ws + WS_K), (const attn_body::bf16*)(ws + WS_V), (attn_body::bf16*)(ws + WS_MIX), (const float*)(ws + WS_TAB + TB_CUM)};
          const attn_body::StaticOrder AS(G, bx); attn_body::attn_phase<attn_body::StaticOrder, 64>((char*)lds_raw, AT, AS); }
        for (int u = bx; u < BATCH * 32; u += G) ssm_a_unit(args, u, wave, lane);
    } SYNC(2);
    if (IN(3)) {
        for (int u = bx; u < BATCH * 32; u += G) ssm_b_unit(args, lds, u, wave, lane);
    } SYNC(3);
    if (IN(4)) {
        pg8::Gemm g{(const pg8::bf16_t*)(ws + WS_MIX), (const pg8::bf16_t*)(ws + WS_WOUT), M, D, D}; pg8::StaticOrder S; S.init(M, D, G, bx);
        pg8::EpiX1 E{args.in[0], args.out, (pg8::bf16_t*)(ws + WS_XB), (float*)(ws + WS_TAB + TB_SSQ2), D};
        pg8::gemm_phase<pg8::EpiX1, pg8::StaticOrder, true, true>(lds, g, S, E);
    } SYNC(4);
    if (IN(5)) {
        pg8::Gemm g{(const pg8::bf16_t*)(ws + WS_XB), (const pg8::bf16_t*)(ws + WS_WUP), M, NUP, D}; pg8::StaticOrder S; S.init(M, NUP, G, bx);
        pg8::EpiUpConv E{(const float*)(ws + WS_TAB + TB_SSQ2), args.in[21], args.in[22], (pg8::bf16_t*)(ws + WS_ACT), (float*)(ws + WS_HALO), (LAS float*)(lds + RING_BYTES)};
        pg8::gemm_phase<pg8::EpiUpConv, pg8::StaticOrder, true, true>(lds, g, S, E);
    } SYNC(5);
    if (IN(6)) {
        pg8::Gemm g{(const pg8::bf16_t*)(ws + WS_ACT), (const pg8::bf16_t*)(ws + WS_WDN), M, D, DFF}; pg8::StaticOrder S; S.init(M, D, G, bx);
        { pg8::Unit u0; for (int i = 0; S.next(i, u0); ++i) p_fixup(args, u0.pm, tid); asm volatile("s_waitcnt vmcnt(0)" ::: "memory"); __syncthreads(); }
        pg8::EpiResB E{(const pg8::bf16_t*)(ws + WS_XB), args.out, D};
        pg8::gemm_phase<pg8::EpiResB, pg8::StaticOrder, true, true>(lds, g, S, E);
    }
#undef IN
#undef SYNC
}

constexpr int N_PHASES = 7;
#ifndef MK_MULTI
#define MK_MULTI 0
#endif
extern "C" void kernel_launch(void* const* d_in, const int* in_sizes, int n_in, void* d_out, int out_size, void* d_ws, size_t ws_size, hipStream_t stream) {
    static int grid = 0;
    if (grid == 0) {
        if (n_in != 24 || out_size != M * D || ws_size < WS_END) { fprintf(stderr, "kernel_launch: unexpected sizes n_in %d out %d ws %zu\n", n_in, out_size, ws_size); grid = -1; return; }
        int dev = 0, cus = 0, per_cu = 0;
        hipGetDevice(&dev); hipDeviceGetAttribute(&cus, hipDeviceAttributeMultiprocessorCount, dev);
        hipFuncSetAttribute((const void*)fwd_kernel, hipFuncAttributeMaxDynamicSharedMemorySize, LDS_BYTES);
        hipOccupancyMaxActiveBlocksPerMultiprocessor(&per_cu, (const void*)fwd_kernel, NTHR, LDS_BYTES);
        (void)hipGetLastError();
        if (per_cu < 1) { fprintf(stderr, "kernel_launch: occupancy query says %d blocks per CU\n", per_cu); per_cu = 1; }
        grid = cus * 1;
        fprintf(stderr, "kernel_launch: cus %d per_cu %d grid %d\n", cus, per_cu, grid);
    }
    if (grid < 0) return;
    Args a{};
    for (int i = 0; i < 24; ++i) a.in[i] = (const float*)d_in[i];
    a.out = (float*)d_out; a.ws = (unsigned char*)d_ws;
#if MK_MULTI
    for (int p = 0; p < N_PHASES; ++p) { a.ph_lo = p; a.ph_hi = p + 1; hipLaunchKernelGGL(fwd_kernel, dim3(grid), dim3(NTHR), LDS_BYTES, stream, a); }
#else
    a.ph_lo = 0; a.ph_hi = N_PHASES;
    void* kargs[] = {&a};
    hipError_t e = hipLaunchCooperativeKernel((const void*)fwd_kernel, dim3(grid), dim3(NTHR), kargs, LDS_BYTES, stream);
    if (e != hipSuccess) fprintf(stderr, "cooperative launch failed: %s (grid %d)\n", hipGetErrorString(e), grid);
#endif
}
```

```cpp
#include <hip/hip_runtime.h>
#include <hip/hip_cooperative_groups.h>
#include <cstdio>
#include <cstdint>
namespace cg = cooperative_groups;
namespace pg8 {
#define PG8_LAS __attribute__((address_space(3)))
typedef unsigned short bf16_t;
typedef short bf16x8 __attribute__((ext_vector_type(8)));
typedef float f32x4 __attribute__((ext_vector_type(4)));
typedef unsigned u32x4 __attribute__((ext_vector_type(4)));
constexpr int BM = 256, BK = 64, HALF = 128, HTB = HALF * BK * 2  , STAGE_BYTES = 8 * HTB, NXCD = 8, WGM = 8;

__host__ __device__ __forceinline__ int lds_byte(int r, int c) { const int st = (r >> 4) * 2 + (c >> 5), rr = r & 15, cc = c & 31, ob = rr * 64 + cc * 2; return st * 1024 + (ob ^ (((ob >> 9) & 1) << 5)); }
__host__ __device__ __forceinline__ void stage_rc(int b, int& R, int& C) { const int st = b / 1024, sb = b % 1024, swz = sb ^ (((sb >> 9) & 1) << 5); R = (st >> 1) * 16 + swz / 64; C = (st & 1) * 32 + (swz % 64) / 2; }
__host__ __device__ __forceinline__ int perm32(int rho) { const int n = rho >> 4, i = rho & 15; return 8 * (i >> 2) + 4 * n + (i & 3); }

struct Unit { int pm, pn; };
struct Gemm { const bf16_t* A; const bf16_t* Bt; int M, N, K; };

struct StaticOrder {
    int nM, nN, nwg, G, c;
    __host__ __device__ void init(int M, int N, int G_, int c_) { nM = M / BM; nN = N / BM; nwg = nM * nN; G = G_; c = c_; }
    __host__ __device__ bool next(int i, Unit& u) const {
        const long L = (long)i * G + c; if (L >= nwg) return false;
        int wgid = (int)L; { const int q = nwg / NXCD, r = nwg % NXCD, xcd = wgid % NXCD, off = wgid / NXCD; wgid = (xcd < r ? xcd * (q + 1) : r * (q + 1) + (xcd - r) * q) + off; }
        const int nig = WGM * nN, gid = wgid / nig, fm = gid * WGM, gsz = (nM - fm) < WGM ? (nM - fm) : WGM;
        u.pm = fm + ((wgid % nig) % gsz); u.pn = (wgid % nig) / gsz; return true;
    }
    __device__ __forceinline__ void a_ready(const Unit&) const {}
    __device__ __forceinline__ void done(const Unit&) const {}
};

__device__ __forceinline__ unsigned cvt_pk_bf16(float lo, float hi) { unsigned r; asm volatile("v_cvt_pk_bf16_f32 %0, %1, %2" : "=v"(r) : "v"(lo), "v"(hi)); return r; }
typedef float f32x2 __attribute__((ext_vector_type(2)));
__device__ __forceinline__ f32x2 gelu_pk(f32x2 v) {
    const f32x2 av = __builtin_elementwise_abs(v), d = av * 0.2316418882f + 1.0f;
    f32x2 t; t.x = __builtin_amdgcn_rcpf(d.x); t.y = __builtin_amdgcn_rcpf(d.y);
    f32x2 q = t * 0.5307027145f + (-0.7265760135f); q = q * t + 0.7107068705f; q = q * t + (-0.142248368f); q = q * t + 0.127414796f; q = q * t;
    const f32x2 s = (v * v) * (-0.72134752044f);
    f32x2 e; e.x = __builtin_amdgcn_exp2f(s.x); e.y = __builtin_amdgcn_exp2f(s.y);
    const f32x2 m = v * (q * e), r = v - m;
    f32x2 o; o.x = v.x < 0.f ? m.x : r.x; o.y = v.y < 0.f ? m.y : r.y; return o;
}

template <int ACT  > struct EpiBf16 {
    static constexpr bool PERM = true, AFTER_DRAIN = false; static_assert(ACT == 0 || ACT == 1, "EpiBf16: ACT is 0 (none) or 1 (gelu_pk)");
    bf16_t* O; int ldc; const float* bias; int split_cols; size_t split_stride; float scale0;
    __device__ __forceinline__ void operator()(const f32x4 (&acc)[2][2][4][2], const Unit& u, int wr, int wc, int fr, int fq) const {
        const int row0 = u.pm * BM + wr * 64 + fr; int colt = u.pn * BM; bf16_t* base = O;
        float sc = 1.f; if (split_cols) { const int t = colt / split_cols; base += (size_t)t * split_stride; colt -= t * split_cols; if (t == 0) sc = scale0; }
        const int col0 = colt + wc * 32 + 8 * fq, bcol0 = u.pn * BM + wc * 32 + 8 * fq;
        f32x4 bv[2][2];
#pragma unroll
        for (int bj = 0; bj < 2; ++bj)
#pragma unroll
            for (int n = 0; n < 2; ++n) bv[bj][n] = bias ? *(const f32x4*)(bias + bcol0 + bj * HALF + 4 * n) : (f32x4){0.f, 0.f, 0.f, 0.f};
#pragma unroll
        for (int ai = 0; ai < 2; ++ai)
#pragma unroll
            for (int m = 0; m < 4; ++m) { bf16_t* rowp = base + (size_t)(row0 + ai * HALF + m * 16) * ldc + col0;
#pragma unroll
                for (int bj = 0; bj < 2; ++bj) { f32x4 v0 = acc[ai][bj][m][0] + bv[bj][0], v1 = acc[ai][bj][m][1] + bv[bj][1];
                    if (ACT == 1) { f32x2 a = gelu_pk((f32x2){v0[0], v0[1]}), b = gelu_pk((f32x2){v0[2], v0[3]}), c = gelu_pk((f32x2){v1[0], v1[1]}), d = gelu_pk((f32x2){v1[2], v1[3]});
                        v0 = (f32x4){a.x, a.y, b.x, b.y}; v1 = (f32x4){c.x, c.y, d.x, d.y}; }
                    v0 = v0 * sc; v1 = v1 * sc; u32x4 w; w.x = cvt_pk_bf16(v0[0], v0[1]); w.y = cvt_pk_bf16(v0[2], v0[3]); w.z = cvt_pk_bf16(v1[0], v1[1]); w.w = cvt_pk_bf16(v1[2], v1[3]);
                    *(u32x4*)(rowp + bj * HALF) = w; } }
    }
};

struct PanelStats {
    unsigned* xbuf;
    unsigned* cnt;
    unsigned* tmo;
    int ntn; float eps;
    unsigned code;
    __device__ __forceinline__ bool run(const f32x4 (&v)[2][2][4][2], const Unit& u, int wr, int wc, int fr, int fq, PG8_LAS unsigned char* lds, int wid, int lane) const {
        typedef float f32x2v __attribute__((ext_vector_type(2)));
        PG8_LAS f32x2v* P = (PG8_LAS f32x2v*)lds;
        PG8_LAS f32x2v* S = (PG8_LAS f32x2v*)(lds + 8192);
        PG8_LAS unsigned* flag = (PG8_LAS unsigned*)(lds + 8192 + 2048);
#pragma unroll
        for (int ai = 0; ai < 2; ++ai)
#pragma unroll
            for (int m = 0; m < 4; ++m) {
                float s = 0.f;
#pragma unroll
                for (int bj = 0; bj < 2; ++bj)
#pragma unroll
                    for (int n = 0; n < 2; ++n) { const f32x4 x = v[ai][bj][m][n]; s += (x[0] + x[1]) + (x[2] + x[3]); }
                s += __shfl_xor(s, 16); s += __shfl_xor(s, 32);
                const float mw = s * (1.0f / 64.0f); float q = 0.f;
#pragma unroll
                for (int bj = 0; bj < 2; ++bj)
#pragma unroll
                    for (int n = 0; n < 2; ++n) { const f32x4 d = v[ai][bj][m][n] - mw; q += (d[0] * d[0] + d[1] * d[1]) + (d[2] * d[2] + d[3] * d[3]); }
                q += __shfl_xor(q, 16); q += __shfl_xor(q, 32);
                if (fq == 0) P[(ai * HALF + wr * 64 + m * 16 + fr) * 4 + wc] = (f32x2v){mw, q};
            }
        asm volatile("s_waitcnt lgkmcnt(0)" ::: "memory"); __builtin_amdgcn_s_barrier(); asm volatile("" ::: "memory");
#if defined(BROKEN_EXCHANGE_NO_WAIT)
#warning BROKEN CONTROL BUILD: the row-statistics exchange does not wait; results are wrong by design
        if (blockIdx.x >= 64) { const long long t0_ = clock64(); while (clock64() - t0_ < 60000) __builtin_amdgcn_s_sleep(8); }
#endif
        const int row = wid * 32 + (lane & 31);
        if (lane < 32) {
            const f32x2v a = P[row * 4 + 0], b = P[row * 4 + 1], c = P[row * 4 + 2], d = P[row * 4 + 3];
            const float mt = (a.x + b.x + c.x + d.x) * 0.25f;
            const float da = a.x - mt, db = b.x - mt, dc = c.x - mt, dd = d.x - mt;
            const float m2 = (a.y + b.y) + (c.y + d.y) + 64.0f * ((da * da + db * db) + (dc * dc + dd * dd));
            unsigned long long* slot = (unsigned long long*)xbuf + ((size_t)(u.pm * BM + row) * 4 + u.pn);
            __hip_atomic_store(slot, ((unsigned long long)__float_as_uint(m2) << 32) | __float_as_uint(mt), __ATOMIC_RELAXED, __HIP_MEMORY_SCOPE_AGENT);
        }
        asm volatile("s_waitcnt vmcnt(0)" ::: "memory");
        if (lane == 0) __hip_atomic_fetch_add(cnt + 64 * u.pm, 1u, __ATOMIC_RELAXED, __HIP_MEMORY_SCOPE_AGENT);
        if (wid == 0) {
            bool dead = false; const unsigned long long t0 = __builtin_amdgcn_s_memrealtime(); const unsigned want = 8u * (unsigned)ntn;
            for (;;) {
#if defined(BROKEN_EXCHANGE_NO_WAIT)
                break;
#endif
                if ((unsigned)__builtin_amdgcn_readfirstlane(__hip_atomic_load(cnt + 64 * u.pm, __ATOMIC_RELAXED, __HIP_MEMORY_SCOPE_AGENT)) >= want) break;
                if (__builtin_amdgcn_s_memrealtime() - t0 > 2000000ull) {
                    if (lane == 0) { unsigned expect = 0u; __hip_atomic_compare_exchange_strong(tmo + 1, &expect, code | (unsigned)(u.pm & 0xff), __ATOMIC_RELAXED, __ATOMIC_RELAXED, __HIP_MEMORY_SCOPE_AGENT);
                                     __hip_atomic_store(tmo, 1u, __ATOMIC_RELAXED, __HIP_MEMORY_SCOPE_AGENT); }
                    dead = true; break; }
                __builtin_amdgcn_s_sleep(2);
            }
            __builtin_amdgcn_fence(__ATOMIC_ACQUIRE, "agent");
            if (lane == 0) flag[0] = dead ? 1u : 0u;
        }
        asm volatile("s_waitcnt vmcnt(0) lgkmcnt(0)" ::: "memory"); __builtin_amdgcn_s_barrier(); asm volatile("" ::: "memory");
        const bool bad = flag[0] != 0u;
        if (lane < 32) {
            const unsigned long long* slot = (const unsigned long long*)xbuf + (size_t)(u.pm * BM + row) * 4; float mt[4], m2[4]; float ms = 0.f;
#pragma unroll
            for (int t = 0; t < 4; ++t) { if (t < ntn) { const unsigned long long w = __hip_atomic_load(slot + t, __ATOMIC_RELAXED, __HIP_MEMORY_SCOPE_AGENT); mt[t] = __uint_as_float((unsigned)w); m2[t] = __uint_as_float((unsigned)(w >> 32)); } else { mt[t] = 0.f; m2[t] = 0.f; } ms += mt[t]; }
            const float mean = ms / (float)ntn; float q = 0.f;
#pragma unroll
            for (int t = 0; t < 4; ++t) if (t < ntn) { const float dm = mt[t] - mean; q += m2[t] + 256.0f * dm * dm; }
            S[row] = (f32x2v){mean, 1.0f / sqrtf(q / (256.0f * (float)ntn) + eps)};
        }
        asm volatile("s_waitcnt lgkmcnt(0)" ::: "memory"); __builtin_amdgcn_s_barrier(); asm volatile("" ::: "memory");
        return bad;
    }
};
struct EpiLnRes {
    static constexpr bool PERM = false, AFTER_DRAIN = true;
    const float* base; float* out; int ldc; const float* bias; PanelStats st; unsigned poison;
    __device__ __forceinline__ void fused(f32x4 (&acc)[2][2][4][2], const Unit& u, int wr, int wc, int fr, int fq, PG8_LAS unsigned char* lds, int wid, int lane) const {
        typedef float f32x2v __attribute__((ext_vector_type(2)));
        const PG8_LAS f32x2v* S = (const PG8_LAS f32x2v*)(lds + 8192);
        const int col0 = u.pn * BM + wc * 32 + 4 * fq;
#pragma unroll
        for (int bj = 0; bj < 2; ++bj)
#pragma unroll
            for (int n = 0; n < 2; ++n) { const f32x4 bv = bias ? *(const f32x4*)(bias + col0 + bj * HALF + n * 16) : (f32x4){0.f, 0.f, 0.f, 0.f};
#pragma unroll
                for (int ai = 0; ai < 2; ++ai)
#pragma unroll
                    for (int m = 0; m < 4; ++m) acc[ai][bj][m][n] += bv; }
        f32x4 pre[4][2][2];
#pragma unroll
        for (int m = 0; m < 4; ++m) { const size_t off = (size_t)(u.pm * BM + wr * 64 + m * 16 + fr) * ldc + col0;
#pragma unroll
            for (int bj = 0; bj < 2; ++bj)
#pragma unroll
                for (int n = 0; n < 2; ++n) pre[m][bj][n] = *(const f32x4*)(base + off + bj * HALF + n * 16); }
        const bool bad = st.run(acc, u, wr, wc, fr, fq, lds, wid, lane) || poison != 0u;
        const float qnan = __builtin_nanf("");
#pragma unroll
        for (int ai = 0; ai < 2; ++ai)
#pragma unroll
            for (int m = 0; m < 4; ++m) { const int r = ai * HALF + wr * 64 + m * 16 + fr; const f32x2v sr = S[r]; const size_t off = (size_t)(u.pm * BM + r) * ldc + col0;
#pragma unroll
                for (int bj = 0; bj < 2; ++bj)
#pragma unroll
                    for (int n = 0; n < 2; ++n) { const f32x4 bs = ai == 0 ? pre[m][bj][n] : *(const f32x4*)(base + off + bj * HALF + n * 16); f32x4 o = bs + (acc[ai][bj][m][n] - sr.x) * sr.y;
                        if (bad) o = (f32x4){qnan, qnan, qnan, qnan}; *(f32x4*)(out + off + bj * HALF + n * 16) = o; }
                if (m & 1) asm volatile("" ::: "memory"); }
    }
};
struct EpiLnResLn {
    static constexpr bool PERM = false, AFTER_DRAIN = true;
    const float* base; float* out; bf16_t* xn; int ldc; const float* bias; PanelStats st1, st2; unsigned poison;
    __device__ __forceinline__ void fused(f32x4 (&acc)[2][2][4][2], const Unit& u, int wr, int wc, int fr, int fq, PG8_LAS unsigned char* lds, int wid, int lane) const {
        typedef float f32x2v __attribute__((ext_vector_type(2))); typedef unsigned u32x2v __attribute__((ext_vector_type(2)));
        const PG8_LAS f32x2v* S = (const PG8_LAS f32x2v*)(lds + 8192);
        const int col0 = u.pn * BM + wc * 32 + 4 * fq;
#pragma unroll
        for (int bj = 0; bj < 2; ++bj)
#pragma unroll
            for (int n = 0; n < 2; ++n) { const f32x4 bv = bias ? *(const f32x4*)(bias + col0 + bj * HALF + n * 16) : (f32x4){0.f, 0.f, 0.f, 0.f};
#pragma unroll
                for (int ai = 0; ai < 2; ++ai)
#pragma unroll
                    for (int m = 0; m < 4; ++m) acc[ai][bj][m][n] += bv; }
        bool bad = st1.run(acc, u, wr, wc, fr, fq, lds, wid, lane) || poison != 0u;
        const float qnan = __builtin_nanf("");
#pragma unroll
        for (int ai = 0; ai < 2; ++ai)
#pragma unroll
            for (int m = 0; m < 4; ++m) { const int r = ai * HALF + wr * 64 + m * 16 + fr; const f32x2v sr = S[r]; const size_t off = (size_t)(u.pm * BM + r) * ldc + col0;
#pragma unroll
                for (int bj = 0; bj < 2; ++bj)
#pragma unroll
                    for (int n = 0; n < 2; ++n) { const f32x4 bs = *(const f32x4*)(base + off + bj * HALF + n * 16); acc[ai][bj][m][n] = bs + (acc[ai][bj][m][n] - sr.x) * sr.y; }
                asm volatile("" : "+v"(acc[ai][0][m][0]), "+v"(acc[ai][0][m][1]), "+v"(acc[ai][1][m][0]), "+v"(acc[ai][1][m][1]));
                if (m & 1) asm volatile("" ::: "memory"); }
        const bool bad1 = bad;
        bad = st2.run(acc, u, wr, wc, fr, fq, lds, wid, lane) || bad;
#pragma unroll
        for (int ai = 0; ai < 2; ++ai)
#pragma unroll
            for (int m = 0; m < 4; ++m) { const int r = ai * HALF + wr * 64 + m * 16 + fr; const f32x2v sr = S[r]; const size_t off = (size_t)(u.pm * BM + r) * ldc + col0;
#pragma unroll
                for (int bj = 0; bj < 2; ++bj)
#pragma unroll
                    for (int n = 0; n < 2; ++n) { const f32x4 x1 = acc[ai][bj][m][n]; *(f32x4*)(out + off + bj * HALF + n * 16) = bad1 ? (f32x4){qnan, qnan, qnan, qnan} : x1;
                        const f32x4 o = (x1 - sr.x) * sr.y; u32x2v w; w.x = cvt_pk_bf16(o[0], o[1]); w.y = cvt_pk_bf16(o[2], o[3]);
                        if (bad) { w.x = 0x7fc07fc0u; w.y = 0x7fc07fc0u; } *(u32x2v*)(xn + off + bj * HALF + n * 16) = w; }
                asm volatile("" ::: "memory"); }
    }
};

template <class Epi, class Sched, bool ALIGN_EPI = false, bool SP2 = false>
__device__ __forceinline__ void gemm_phase(PG8_LAS unsigned char* lds, const Gemm g, const Sched& S, const Epi& E) {
    int tid_ = threadIdx.x; asm volatile("" : "+v"(tid_));
    const int tid = tid_, wid = __builtin_amdgcn_readfirstlane(tid >> 6), lane = tid & 63, wr = wid >> 2, wc = wid & 3, fr = lane & 15, fq = lane >> 4;
    const int K = g.K, nt = K / BK;
    unsigned voffA[2], voffB[2];
#pragma unroll
    for (int i = 0; i < 2; ++i) { int R, C; stage_rc(tid * 16 + i * 8192, R, C); const int Rb = Epi::PERM ? ((R & ~31) + perm32(R & 31)) : R;
        voffA[i] = (unsigned)(R * K + C) * 2u; voffB[i] = (unsigned)(Rb * K + C) * 2u; }
    const size_t kstep = (size_t)(BK * 2);
    const size_t hstep = (size_t)HALF * K * 2;
    const size_t tstep = 2 * hstep;
    const unsigned ldsw = (unsigned)wid * 1024u;
    const int aoff = lds_byte(wr * 64 + fr, fq * 8), boff = lds_byte(wc * 32 + fr, fq * 8);
#define PG8_SA(b, h) (((b) * 2 + (h)) * HTB)
#define PG8_SB(b, h) ((4 + (b) * 2 + (h)) * HTB)
#define PG8_STAGE(bufoff, gbase, voff) do { _Pragma("unroll") for (int _i = 0; _i < 2; ++_i) \
        __builtin_amdgcn_global_load_lds((const unsigned*)((const char*)(gbase) + (voff)[_i]), (PG8_LAS unsigned*)(lds + (bufoff) + ldsw + _i * 8192), 16, 0, 0); } while (0)
#define PG8_LDA(dst, b, h) do { _Pragma("unroll") for (int m = 0; m < 4; ++m) _Pragma("unroll") for (int k = 0; k < 2; ++k) dst[m][k] = *(const PG8_LAS bf16x8*)(lds + PG8_SA(b, h) + aoff + m * 2048 + k * 1024); } while (0)
#define PG8_LDB(dst, b, h) do { _Pragma("unroll") for (int n = 0; n < 2; ++n) _Pragma("unroll") for (int k = 0; k < 2; ++k) dst[n][k] = *(const PG8_LAS bf16x8*)(lds + PG8_SB(b, h) + boff + n * 2048 + k * 1024); } while (0)
#define PG8_MMA(ai, bj, At, Bt) do { __builtin_amdgcn_s_setprio(1); _Pragma("unroll") for (int m = 0; m < 4; ++m) _Pragma("unroll") for (int n = 0; n < 2; ++n) _Pragma("unroll") for (int k = 0; k < 2; ++k) \
        acc[ai][bj][m][n] = __builtin_amdgcn_mfma_f32_16x16x32_bf16(Bt[n][k], At[m][k], acc[ai][bj][m][n], 0, 0, 0); __builtin_amdgcn_s_setprio(0); } while (0)
#define PG8_WAIT_V(n) asm volatile("s_waitcnt vmcnt(" #n ")" ::: "memory")
#define PG8_WAIT_L(n) asm volatile("s_waitcnt lgkmcnt(" #n ")" ::: "memory")
#define PG8_BAR __builtin_amdgcn_s_barrier()
#define PG8_SCHED __builtin_amdgcn_sched_barrier(0)
    Unit cur, nxt; int ui = 0;
    if (!S.next(0, cur)) return;
    f32x4 acc[2][2][4][2];
#pragma unroll
    for (int a = 0; a < 2; ++a)
#pragma unroll
        for (int b = 0; b < 2; ++b)
#pragma unroll
            for (int m = 0; m < 4; ++m)
#pragma unroll
                for (int n = 0; n < 2; ++n) acc[a][b][m][n] = (f32x4){0.f, 0.f, 0.f, 0.f};
    bf16x8 At[4][2], B0[2][2], B1[2][2];
    const char* cA = (const char*)g.A + (size_t)cur.pm * tstep; const char* cB = (const char*)g.Bt + (size_t)cur.pn * tstep;
    S.a_ready(cur);
    if constexpr (SP2) {
        PG8_STAGE(PG8_SB(0, 0), cB, voffB); PG8_STAGE(PG8_SB(0, 1), cB + hstep, voffB); PG8_STAGE(PG8_SA(0, 0), cA, voffA); PG8_STAGE(PG8_SA(0, 1), cA + hstep, voffA);
        if (wr == 1) PG8_BAR;
        PG8_WAIT_V(2); PG8_BAR;
        PG8_STAGE(PG8_SB(1, 0), cB + kstep, voffB); PG8_STAGE(PG8_SA(1, 0), cA + kstep, voffA); PG8_STAGE(PG8_SB(1, 1), cB + hstep + kstep, voffB);
        PG8_WAIT_V(6); PG8_BAR;
    } else {
        PG8_STAGE(PG8_SB(0, 0), cB, voffB); PG8_STAGE(PG8_SA(0, 0), cA, voffA); PG8_STAGE(PG8_SB(0, 1), cB + hstep, voffB); PG8_STAGE(PG8_SA(0, 1), cA + hstep, voffA);
        if (wr == 1) PG8_BAR;
        PG8_WAIT_V(4); PG8_BAR;
        PG8_STAGE(PG8_SB(1, 0), cB + kstep, voffB); PG8_STAGE(PG8_SA(1, 0), cA + kstep, voffA); PG8_STAGE(PG8_SB(1, 1), cB + hstep + kstep, voffB);
        PG8_WAIT_V(6); PG8_BAR;
    }
    for (;;) {
        const bool has_next = S.next(ui + 1, nxt);
        const char* nA = has_next ? (const char*)g.A + (size_t)nxt.pm * tstep : cA; const char* nB = has_next ? (const char*)g.Bt + (size_t)nxt.pn * tstep : cB;
        for (int t = 0; t < nt; t += 2) {
            const bool last = (t == nt - 2);
            const char* a1 = cA + (size_t)(t + 1) * kstep;
            const char* a2 = last ? nA : cA + (size_t)(t + 2) * kstep; const char* b2 = last ? nB : cB + (size_t)(t + 2) * kstep;
            const char* a3 = a2 + kstep; const char* b3 = b2 + kstep;
            if (last && has_next) S.a_ready(nxt);
            if constexpr (SP2) {
            PG8_LDB(B0, 0, 0); PG8_LDB(B1, 0, 1); PG8_SCHED; PG8_LDA(At, 0, 0); PG8_STAGE(PG8_SA(1, 1), a1 + hstep, voffA);
            PG8_WAIT_V(8); PG8_WAIT_L(0); PG8_BAR; PG8_MMA(0, 0, At, B0); PG8_MMA(0, 1, At, B1); PG8_BAR; PG8_SCHED;
            PG8_LDA(At, 0, 1); PG8_STAGE(PG8_SB(0, 0), b2, voffB); PG8_STAGE(PG8_SB(0, 1), b2 + hstep, voffB); PG8_STAGE(PG8_SA(0, 0), a2, voffA);
            PG8_WAIT_V(8); PG8_WAIT_L(0); PG8_BAR; PG8_MMA(1, 0, At, B0); PG8_MMA(1, 1, At, B1); PG8_BAR; PG8_SCHED;
            PG8_LDB(B0, 1, 0); PG8_LDB(B1, 1, 1); PG8_SCHED; PG8_LDA(At, 1, 0); PG8_STAGE(PG8_SA(0, 1), a2 + hstep, voffA);
            PG8_WAIT_V(8); PG8_WAIT_L(0); PG8_BAR; PG8_MMA(0, 0, At, B0); PG8_MMA(0, 1, At, B1); PG8_BAR; PG8_SCHED;
            PG8_LDA(At, 1, 1); PG8_STAGE(PG8_SB(1, 0), b3, voffB); PG8_STAGE(PG8_SB(1, 1), b3 + hstep, voffB); PG8_STAGE(PG8_SA(1, 0), a3, voffA);
            PG8_WAIT_V(8); PG8_WAIT_L(0); PG8_BAR; PG8_MMA(1, 0, At, B0); PG8_MMA(1, 1, At, B1); PG8_BAR; PG8_SCHED;
            } else {
            PG8_LDB(B0, 0, 0); PG8_SCHED; PG8_LDA(At, 0, 0); PG8_STAGE(PG8_SA(1, 1), a1 + hstep, voffA);
            PG8_WAIT_L(8); PG8_BAR; PG8_WAIT_L(0); PG8_MMA(0, 0, At, B0); PG8_BAR; PG8_SCHED;
            PG8_LDB(B1, 0, 1); PG8_STAGE(PG8_SB(0, 0), b2, voffB);
            PG8_BAR; PG8_WAIT_L(0); PG8_MMA(0, 1, At, B1); PG8_BAR;
            PG8_LDA(At, 0, 1); PG8_STAGE(PG8_SA(0, 0), a2, voffA);
            PG8_BAR; PG8_WAIT_L(0); PG8_MMA(1, 0, At, B0); PG8_BAR; PG8_SCHED;
            PG8_STAGE(PG8_SB(0, 1), b2 + hstep, voffB);
            PG8_WAIT_V(6); PG8_BAR; PG8_MMA(1, 1, At, B1); PG8_BAR;
            PG8_LDB(B0, 1, 0); PG8_SCHED; PG8_LDA(At, 1, 0); PG8_STAGE(PG8_SA(0, 1), a2 + hstep, voffA);
            PG8_WAIT_L(8); PG8_BAR; PG8_WAIT_L(0); PG8_MMA(0, 0, At, B0); PG8_BAR; PG8_SCHED;
            PG8_LDB(B1, 1, 1); PG8_STAGE(PG8_SB(1, 0), b3, voffB);
            PG8_BAR; PG8_WAIT_L(0); PG8_MMA(0, 1, At, B1); PG8_BAR;
            PG8_LDA(At, 1, 1); PG8_STAGE(PG8_SA(1, 0), a3, voffA);
            PG8_BAR; PG8_WAIT_L(0); PG8_MMA(1, 0, At, B0); PG8_BAR; PG8_SCHED;
            PG8_STAGE(PG8_SB(1, 1), b3 + hstep, voffB);
            PG8_WAIT_V(6); PG8_BAR; PG8_MMA(1, 1, At, B1); PG8_BAR;
            }
        }
        if constexpr (ALIGN_EPI) { if (wr == 0) PG8_BAR; }
        if constexpr (!Epi::AFTER_DRAIN) { E(acc, cur, wr, wc, fr, fq); S.done(cur); }
        if (!has_next) break;
#pragma unroll
        for (int a = 0; a < 2; ++a)
#pragma unroll
            for (int b = 0; b < 2; ++b)
#pragma unroll
                for (int m = 0; m < 4; ++m)
#pragma unroll
                    for (int n = 0; n < 2; ++n) acc[a][b][m][n] = (f32x4){0.f, 0.f, 0.f, 0.f};
        cur = nxt; cA = nA; cB = nB; ++ui;
        if constexpr (ALIGN_EPI) { if (wr == 1) PG8_BAR; }
    }
    PG8_WAIT_V(0);
    if constexpr (!ALIGN_EPI) { if (wr == 0) PG8_BAR; }
    PG8_BAR;
    if constexpr (Epi::AFTER_DRAIN) { E.fused(acc, cur, wr, wc, fr, fq, lds, wid, lane); S.done(cur); }
#undef PG8_SA
#undef PG8_SB
#undef PG8_STAGE
#undef PG8_LDA
#undef PG8_LDB
#undef PG8_MMA
#undef PG8_WAIT_V
#undef PG8_WAIT_L
#undef PG8_BAR
#undef PG8_SCHED
}
}
#include <hip/hip_bf16.h>
#include <cmath>
namespace attn_body {
using bf16=__hip_bfloat16;
using bf16x8=__attribute__((ext_vector_type(8)))short;
using s16x4=__attribute__((ext_vector_type(4)))short;
using f32x16=__attribute__((ext_vector_type(16)))float;
using u32x4=__attribute__((ext_vector_type(4)))unsigned;
constexpr int BATCH=8,NHEAD=8,SEQ=2048,D=64,DM=NHEAD*D,OP=1024,CLS_OFF=86016;
constexpr int NW=8,QBLK=32,QB=QBLK*NW,KVBLK=64,NQB=SEQ/QB;
constexpr int ATTN_PITCH=DM, ATTN_UNIT_ROWS=QB;
__device__ __forceinline__ int crow(int r,int hi){return (r&3)+8*(r>>2)+4*hi;}
#define SBAR() __builtin_amdgcn_sched_barrier(0)
__device__ __forceinline__ void cmask(f32x16&p0,f32x16&p1,int jb,int qrel,int hi){
  const float NEG=-INFINITY; int kb=64*jb+4*hi;
  #pragma unroll
  for(int r=0;r<16;++r){int kv=kb+(r&3)+8*(r>>2); if(kv>qrel)p0[r]=NEG; if(kv+32>qrel)p1[r]=NEG;}
}

constexpr int NSLOT=3, SLOTB=8192;
constexpr int LDS_K=0, LDS_V=NSLOT*SLOTB, LDS_WS=2*NSLOT*SLOTB, LDS_OST=LDS_WS+NW*64*4, LDS_BYTES=LDS_OST+NW*4096;
constexpr float C2=0.125f*1.4426950408889634f;
__device__ __forceinline__ void glds16(const void*gsrc,unsigned lds_dst){unsigned keep;
  asm volatile("s_mov_b32 %0, m0\n\ts_mov_b32 m0, %2\n\ts_nop 0\n\tglobal_load_lds_dwordx4 %1, off\n\ts_mov_b32 m0, %0":"=&s"(keep):"v"(gsrc),"s"(lds_dst):"memory");}
__device__ __forceinline__ float max3f(float a,float b,float c){float r;asm("v_max3_f32 %0, %1, %2, %3":"=v"(r):"v"(a),"v"(b),"v"(c));return r;}
__device__ __forceinline__ float max2f(float a,float b){float r;asm("v_max_f32_e32 %0, %1, %2":"=v"(r):"v"(a),"v"(b));return r;}
__device__ __forceinline__ float fadd_s(float a,float b){float r;asm("v_add_f32_e32 %0, %1, %2":"=v"(r):"v"(a),"v"(b));return r;}
__device__ __forceinline__ float fsub_s(float a,float b){float r;asm("v_sub_f32_e32 %0, %1, %2":"=v"(r):"v"(a),"v"(b));return r;}
typedef float f32x4_t __attribute__((ext_vector_type(4))); typedef float f32x2_t __attribute__((ext_vector_type(2))); typedef __bf16 bf16x2_t __attribute__((ext_vector_type(2)));
__device__ __forceinline__ unsigned cvtpk_s(float lo,float hi){f32x2_t v={lo,hi};bf16x2_t b=__builtin_convertvector(v,bf16x2_t);return __builtin_bit_cast(unsigned,b);}
#define WAIT_BAR(N) asm volatile("s_waitcnt vmcnt(" #N ") lgkmcnt(0)\n\ts_barrier":::"memory")

__device__ __forceinline__ void qkt(f32x16&p0,f32x16&p1,const char*Kslot,const bf16x8*qr,int r32,int hi){ const f32x16 negm=f32x16{};
  const char*kb=Kslot+hi*1024+r32*16;
  #pragma unroll
  for(int d0=0;d0<4;++d0){
    const bf16x8 b0=*reinterpret_cast<const bf16x8*>(kb+d0*2048);
    const bf16x8 b1=*reinterpret_cast<const bf16x8*>(kb+d0*2048+512);
    if(d0==0){p0=__builtin_amdgcn_mfma_f32_32x32x16_bf16(b0,qr[0],negm,0,0,0);p1=__builtin_amdgcn_mfma_f32_32x32x16_bf16(b1,qr[0],negm,0,0,0);}
    else{p0=__builtin_amdgcn_mfma_f32_32x32x16_bf16(b0,qr[d0],p0,0,0,0);p1=__builtin_amdgcn_mfma_f32_32x32x16_bf16(b1,qr[d0],p1,0,0,0);}}
}
typedef __attribute__((address_space(3))) const char* lds_cptr;
typedef short v4i16_t __attribute__((ext_vector_type(4)));
__device__ __forceinline__ void kload8(bf16x8*kf,lds_cptr kp){
  kf[0]=*(const __attribute__((address_space(3))) bf16x8*)(kp);      kf[1]=*(const __attribute__((address_space(3))) bf16x8*)(kp+512);
  kf[2]=*(const __attribute__((address_space(3))) bf16x8*)(kp+2048); kf[3]=*(const __attribute__((address_space(3))) bf16x8*)(kp+2560);
  kf[4]=*(const __attribute__((address_space(3))) bf16x8*)(kp+4096); kf[5]=*(const __attribute__((address_space(3))) bf16x8*)(kp+4608);
  kf[6]=*(const __attribute__((address_space(3))) bf16x8*)(kp+6144); kf[7]=*(const __attribute__((address_space(3))) bf16x8*)(kp+6656);
}
__device__ __forceinline__ void kload2(bf16x8*kf,lds_cptr kp,int j){ kf[2*j]=*(const __attribute__((address_space(3))) bf16x8*)(kp+j*2048); kf[2*j+1]=*(const __attribute__((address_space(3))) bf16x8*)(kp+j*2048+512); }
__device__ __forceinline__ s16x4 vtr(lds_cptr p){ return __builtin_bit_cast(s16x4,__builtin_amdgcn_ds_read_tr16_b64_v4i16((__attribute__((address_space(3))) v4i16_t*)p)); }
__device__ __forceinline__ float rowmax(const f32x16&p0,const f32x16&p1){
  float a=max3f(p0[0],p0[1],p1[0]),b=max3f(p0[2],p0[3],p1[1]);a=max3f(a,p1[2],p1[3]);
  #pragma unroll
  for(int r=4;r<16;r+=4){a=max3f(a,p0[r],p0[r+1]);b=max3f(b,p0[r+2],p0[r+3]);a=max3f(a,p1[r],p1[r+1]);b=max3f(b,p1[r+2],p1[r+3]);}
  const float m=max2f(a,b);
  auto rr=__builtin_amdgcn_permlane32_swap(__float_as_uint(m),__float_as_uint(m),false,false);
  return max2f(__uint_as_float(rr[0]),__uint_as_float(rr[1]));
}
__device__ __forceinline__ void pv(f32x16*o,int vb,bf16x8 pa0,bf16x8 pa1,bf16x8 pa2,bf16x8 pa3){
  #pragma unroll
  for(int d0=0;d0<2;++d0){s16x4 lo[4],hi[4];
    #pragma unroll
    for(int ks=0;ks<4;++ks){
      asm volatile("ds_read_b64_tr_b16 %0,%1 offset:%c2":"=&v"(lo[ks]):"v"(vb),"i"(d0*4096+ks*1024):"memory");
      asm volatile("ds_read_b64_tr_b16 %0,%1 offset:%c2":"=&v"(hi[ks]):"v"(vb),"i"(d0*4096+ks*1024+512):"memory");}
    asm volatile("s_waitcnt lgkmcnt(0)":::"memory");SBAR();
    #define PK(k) (bf16x8){lo[k][0],lo[k][1],lo[k][2],lo[k][3],hi[k][0],hi[k][1],hi[k][2],hi[k][3]}
    o[d0]=__builtin_amdgcn_mfma_f32_32x32x16_bf16(pa0,PK(0),o[d0],0,0,0);
    o[d0]=__builtin_amdgcn_mfma_f32_32x32x16_bf16(pa1,PK(1),o[d0],0,0,0);
    o[d0]=__builtin_amdgcn_mfma_f32_32x32x16_bf16(pa2,PK(2),o[d0],0,0,0);
    o[d0]=__builtin_amdgcn_mfma_f32_32x32x16_bf16(pa3,PK(3),o[d0],0,0,0);
    #undef PK
  }
}

#ifndef ATTN_STORE16
#define ATTN_STORE16(p,v) (*(u32x4*)(p)=(v))
#endif
template<int THRL> __device__ __forceinline__ void attn_unit(int b,int h,int qb,const bf16*Q,const bf16*__restrict__ K,const bf16*__restrict__ V,bf16*O,const float*__restrict__ CL,char*shm){
  const int tid=threadIdx.x,lane=tid&63,r32=lane&31,hi=lane>>5; const int wid=__builtin_amdgcn_readfirstlane(tid>>6);
  const long rowbase=(long)b*SEQ; const int q0=qb*QB;
  const bf16*Qw=Q+(rowbase+q0+wid*QBLK)*DM+h*D;
  const bf16*Kh=K+rowbase*DM+h*D,*Vh=V+rowbase*DM+h*D;
  const unsigned lds0=(unsigned)(uintptr_t)shm;
  float*wsf=(float*)(shm+LDS_WS)+wid*64;
  const bf16*ksrc=Kh+(long)lane*DM+wid*8;
  const bf16*vsrc=Vh+(long)(16*(wid&3)+(lane>>2))*DM+(wid>>2)*32+(lane&3)*8;
  const unsigned kdst=lds0+LDS_K+wid*1024, vdst=lds0+LDS_V+wid*1024;
  #define DMA_K(t,slot) glds16(ksrc+(long)(t)*KVBLK*DM,(unsigned)__builtin_amdgcn_readfirstlane(kdst+(slot)))
  #define DMA_V(t,slot) glds16(vsrc+(long)(t)*KVBLK*DM,(unsigned)__builtin_amdgcn_readfirstlane(vdst+(slot)))
  const int vb0=(int)(lds0+LDS_V)+((lane>>4)&1)*32+(lane&3)*8+(4*hi+((lane&15)>>2))*64;
  const char*Kbase=shm+LDS_K; bf16x8 kf[8];
  const lds_cptr shm3=(lds_cptr)shm; const lds_cptr kp0=shm3+LDS_K+hi*1024+r32*16; const lds_cptr vp0=shm3+LDS_V+((lane>>4)&1)*32+(lane&3)*8+(4*hi+((lane&15)>>2))*64;
  const int NT=(q0+QB)/KVBLK;
  __attribute__((address_space(3))) float*cls=(__attribute__((address_space(3))) float*)((__attribute__((address_space(3))) char*)shm+CLS_OFF);
  const float*CLh=CL+(long)(b*NHEAD+h)*SEQ;
  const float clq=CLh[q0+wid*QBLK+r32];
  glds16(CLh+wid*256+lane*4,(unsigned)__builtin_amdgcn_readfirstlane(lds0+CLS_OFF+wid*1024));
  #define BIAS(P0,P1,t) do{ const __attribute__((address_space(3))) float*cb_=cls+64*(t)+4*hi; _Pragma("unroll") for(int g_=0;g_<4;++g_){ \
      const f32x4_t b0_=*(const __attribute__((address_space(3))) f32x4_t*)(cb_+8*g_), b1_=*(const __attribute__((address_space(3))) f32x4_t*)(cb_+32+8*g_); \
      _Pragma("unroll") for(int j_=0;j_<4;++j_){ P0[4*g_+j_]+=(nm-b0_[j_]); P1[4*g_+j_]+=(nm-b1_[j_]); } } }while(0)
  DMA_K(0,0);DMA_V(0,0);DMA_K(1,SLOTB);
  bf16x8 qr[4];
  #pragma unroll
  for(int d0=0;d0<4;++d0)qr[d0]=*reinterpret_cast<const bf16x8*>(&Qw[(long)r32*DM+d0*16+hi*8]);
  float l_reg=0.f;f32x16 o[2];o[0]=f32x16{};o[1]=f32x16{};float nm=clq; const f32x16 zero16=f32x16{};
  const int qrel=wid*QBLK+r32;
  #define CMASK(P0,P1,t) do{int jb_=(t)-(NT-4); if(jb_>=0)cmask(P0,P1,jb_,qrel,hi);}while(0)
  bool resc=false;
  #define START(P0,P1) do{ const float rm=rowmax(P0,P1); resc=false; \
    { const float dl=rm; \
      _Pragma("unroll") for(int r=0;r<16;++r){P0[r]=fsub_s(P0[r],dl);P1[r]=fsub_s(P1[r],dl);} \
      nm=fsub_s(nm,dl); } \
    _Pragma("unroll") for(int r=0;r<16;++r)P0[r]=__builtin_amdgcn_exp2f(P0[r]); }while(0)
  #define RESC() do{ if(resc){ asm volatile("s_waitcnt lgkmcnt(0)":::"memory"); \
      _Pragma("unroll") for(int d_=0;d_<2;++d_) _Pragma("unroll") for(int r=0;r<16;++r)o[d_][r]*=wsf[crow(r,hi)]; } }while(0)
  f32x16 pA0,pA1,pB0,pB1;
  int sl_prev=0,sl_cur=0,sl_next=SLOTB;
  #define ROT() do{sl_prev=sl_cur;sl_cur=sl_next;sl_next=(sl_next==(NSLOT-1)*SLOTB)?0:sl_next+SLOTB;}while(0)
  DMA_K(2,2*SLOTB);
  WAIT_BAR(3);
  qkt(pA0,pA1,Kbase,qr,r32,hi);asm volatile("s_nop 15\n\ts_nop 7":"+v"(pA0),"+v"(pA1));BIAS(pA0,pA1,0);CMASK(pA0,pA1,0);
  START(pA0,pA1);
  _Pragma("unroll") for(int r=0;r<16;++r)pA1[r]=__builtin_amdgcn_exp2f(pA1[r]);
  WAIT_BAR(0);
  DMA_K(3,0);DMA_V(1,SLOTB);
  ROT();
  kload8(kf,kp0+sl_cur);
  WAIT_BAR(2);
  s16x4 vlo[8],vhi[8]; u32x4 pw0,pw1,pw2,pw3;
  #define PKW(P,B) cvtpk_s(P[B],P[B+1])
  #define PAF(k) __builtin_bit_cast(bf16x8,pw##k)
  #define VFR(i) (bf16x8){vlo[i][0],vlo[i][1],vlo[i][2],vlo[i][3],vhi[i][0],vhi[i][1],vhi[i][2],vhi[i][3]}
  #define PIN(x) asm volatile("":"+v"(x))
  #define MX3(a,b,c) __builtin_fmaxf(__builtin_fmaxf((a),(b)),(c))
  #define GAPA(MF,A0,A1,A2,A3,W0,W1,PW) do{ MF; sacc+=A0; sacc+=A1; sacc+=A2; sacc+=A3; PIN(sacc); W0; W1; PIN(PW); SBAR(); }while(0)
  #define EX(v) __builtin_amdgcn_exp2f(v)
  #define GAPB(MF,X,B) do{ MF; X[B]=EX(X[B]); X[B+1]=EX(X[B+1]); X[B+2]=EX(X[B+2]); X[B+3]=EX(X[B+3]); PIN(X); SBAR(); }while(0)
  #define VRD(i) do{ vlo[i]=vtr(vp_+(((i)>>2)*4096+((i)&3)*1024)); vhi[i]=vtr(vp_+(((i)>>2)*4096+((i)&3)*1024+512)); }while(0)
  #define KRD(G,j) do{ if(G){ kload2(kf,kp0+sl_next,j); SBAR(); } }while(0)
  #define STEP(C0,C1,P0,P1,t,GK,GV,GL) do{ SBAR(); \
    const lds_cptr vp_=vp0+sl_prev; \
    VRD(0); SBAR(); float sacc=(P0[0]+P0[1]); \
    GAPA(C0=__builtin_amdgcn_mfma_f32_32x32x16_bf16(kf[0],qr[0],zero16,0,0,0), P0[2],P0[3],P0[4],P0[5],     pw0[0]=PKW(P0,0), pw0[1]=PKW(P0,2), pw0); \
    VRD(4); SBAR(); GAPA(C1=__builtin_amdgcn_mfma_f32_32x32x16_bf16(kf[1],qr[0],zero16,0,0,0), P0[6],P0[7],P0[8],P0[9],     pw0[2]=PKW(P0,4), pw0[3]=PKW(P0,6), pw0); \
    VRD(1); SBAR(); GAPA(C0=__builtin_amdgcn_mfma_f32_32x32x16_bf16(kf[2],qr[1],C0,0,0,0),   P0[10],P0[11],P0[12],P0[13], pw1[0]=PKW(P0,8), pw1[1]=PKW(P0,10), pw1); \
    VRD(5); SBAR(); GAPA(C1=__builtin_amdgcn_mfma_f32_32x32x16_bf16(kf[3],qr[1],C1,0,0,0),   P0[14],P0[15],P1[0],P1[1],   pw1[2]=PKW(P0,12),pw1[3]=PKW(P0,14), pw1); \
    VRD(2); SBAR(); GAPA(C0=__builtin_amdgcn_mfma_f32_32x32x16_bf16(kf[4],qr[2],C0,0,0,0),   P1[2],P1[3],P1[4],P1[5],     pw2[0]=PKW(P1,0), pw2[1]=PKW(P1,2), pw2); \
    VRD(6); SBAR(); GAPA(C1=__builtin_amdgcn_mfma_f32_32x32x16_bf16(kf[5],qr[2],C1,0,0,0),   P1[6],P1[7],P1[8],P1[9],     pw2[2]=PKW(P1,4), pw2[3]=PKW(P1,6), pw2); \
    VRD(3); SBAR(); GAPA(C0=__builtin_amdgcn_mfma_f32_32x32x16_bf16(kf[6],qr[3],C0,0,0,0),   P1[10],P1[11],P1[12],P1[13], pw3[0]=PKW(P1,8), pw3[1]=PKW(P1,10), pw3); \
    VRD(7); SBAR(); GAPA(C1=__builtin_amdgcn_mfma_f32_32x32x16_bf16(kf[7],qr[3],C1,0,0,0),   P1[14],P1[15],0.f,0.f,       pw3[2]=PKW(P1,12),pw3[3]=PKW(P1,14), pw3); \
    l_reg+=sacc; \
    if(GK){DMA_K((t)+3,sl_cur);} if(GV){DMA_V((t)+1,sl_next);} \
    BIAS(C0,C1,t); CMASK(C0,C1,t); \
    { float a=MX3(C0[0],C0[1],C1[0]),b=MX3(C0[2],C0[3],C1[1]); a=MX3(a,C1[2],C1[3]); \
      _Pragma("unroll") for(int r=4;r<16;r+=4){a=MX3(a,C0[r],C0[r+1]);b=MX3(b,C0[r+2],C0[r+3]);a=MX3(a,C1[r],C1[r+1]);b=MX3(b,C1[r+2],C1[r+3]);} \
      float rm=__builtin_fmaxf(a,b); { auto rr=__builtin_amdgcn_permlane32_swap(__float_as_uint(rm),__float_as_uint(rm),false,false); rm=__builtin_fmaxf(__uint_as_float(rr[0]),__uint_as_float(rr[1])); } \
      resc=false; \
      if(__builtin_expect(__any(rm>(float)THRL),0)){ const float dl=__builtin_fmaxf(rm,0.f); \
        _Pragma("unroll") for(int r=0;r<16;++r){C0[r]-=dl;C1[r]-=dl;} \
        nm-=dl; \
        const float f=__builtin_amdgcn_exp2f(-dl); l_reg*=f; if(hi==0)wsf[r32]=f; resc=true; } } \
    SBAR(); \
    GAPB(o[0]=__builtin_amdgcn_mfma_f32_32x32x16_bf16(PAF(0),VFR(0),o[0],0,0,0), C0,0); \
    GAPB(o[1]=__builtin_amdgcn_mfma_f32_32x32x16_bf16(PAF(0),VFR(4),o[1],0,0,0), C0,4); \
    KRD(GL,0); GAPB(o[0]=__builtin_amdgcn_mfma_f32_32x32x16_bf16(PAF(1),VFR(1),o[0],0,0,0), C0,8); \
    KRD(GL,1); GAPB(o[1]=__builtin_amdgcn_mfma_f32_32x32x16_bf16(PAF(1),VFR(5),o[1],0,0,0), C0,12); \
    KRD(GL,2); GAPB(o[0]=__builtin_amdgcn_mfma_f32_32x32x16_bf16(PAF(2),VFR(2),o[0],0,0,0), C1,0); \
    KRD(GL,3); GAPB(o[1]=__builtin_amdgcn_mfma_f32_32x32x16_bf16(PAF(2),VFR(6),o[1],0,0,0), C1,4); \
    GAPB(o[0]=__builtin_amdgcn_mfma_f32_32x32x16_bf16(PAF(3),VFR(3),o[0],0,0,0), C1,8); \
    GAPB(o[1]=__builtin_amdgcn_mfma_f32_32x32x16_bf16(PAF(3),VFR(7),o[1],0,0,0), C1,12); \
    }while(0)
  int t=1;
  #undef CMASK
  #define CMASK(P0,P1,t) do{}while(0)
  for(;t+5<NT;t+=2){
    STEP(pB0,pB1,pA0,pA1,t,true,true,true);     WAIT_BAR(2); RESC(); ROT();
    STEP(pA0,pA1,pB0,pB1,t+1,true,true,true);   WAIT_BAR(2); RESC(); ROT();
  }
  #undef CMASK
  #define CMASK(P0,P1,t) do{int jb_=(t)-(NT-4); if(jb_>=0)cmask(P0,P1,jb_,qrel,hi);}while(0)
  #define ENDW(tt) do{ if((tt)+3<NT){WAIT_BAR(2);} else if((tt)+2<NT){WAIT_BAR(1);} else {WAIT_BAR(0);} }while(0)
  for(;t+1<NT;t+=2){
    STEP(pB0,pB1,pA0,pA1,t,(t+3<NT),(t+1<NT),(t+1<NT));       ENDW(t);   RESC(); ROT();
    STEP(pA0,pA1,pB0,pB1,t+1,(t+4<NT),(t+2<NT),(t+2<NT));     ENDW(t+1); RESC(); ROT();
  }
  STEP(pB0,pB1,pA0,pA1,NT-1,false,false,false); RESC();
  { float sacc=pB0[0]+pB0[1]; _Pragma("unroll") for(int r=2;r<16;++r)sacc+=pB0[r]; _Pragma("unroll") for(int r=0;r<16;++r)sacc+=pB1[r]; l_reg+=sacc;
    pw0=(u32x4){PKW(pB0,0),PKW(pB0,2),PKW(pB0,4),PKW(pB0,6)};pw1=(u32x4){PKW(pB0,8),PKW(pB0,10),PKW(pB0,12),PKW(pB0,14)};pw2=(u32x4){PKW(pB1,0),PKW(pB1,2),PKW(pB1,4),PKW(pB1,6)};pw3=(u32x4){PKW(pB1,8),PKW(pB1,10),PKW(pB1,12),PKW(pB1,14)};
    SBAR(); pv(o,vb0+sl_cur,PAF(0),PAF(1),PAF(2),PAF(3)); }
  #undef PKW
  #undef PAF
  #undef VFR
  #undef PIN
  #undef MX3
  #undef GAPA
  #undef GAPB
  #undef EX
  #undef VRD
  #undef KRD
  #undef STEP
  #undef ENDW
  {auto rr=__builtin_amdgcn_permlane32_swap(__float_as_uint(l_reg),__float_as_uint(l_reg),false,false);l_reg=__uint_as_float(rr[0])+__uint_as_float(rr[1]);}
  if(hi==0)wsf[32+r32]=l_reg;asm volatile("s_waitcnt lgkmcnt(0)":::"memory");
  float rli[16];
  #pragma unroll
  for(int r=0;r<16;++r)rli[r]=__builtin_amdgcn_rcpf(wsf[32+crow(r,hi)]);
  bf16*Ow=O+(rowbase+q0+wid*QBLK)*OP+h*D;
  { bf16*stg=(bf16*)(shm+LDS_OST)+wid*2048;
    #pragma unroll
    for(int r=0;r<16;++r){const int orow=crow(r,hi);
      #pragma unroll
      for(int d0=0;d0<2;++d0)stg[orow*64+d0*32+r32]=__float2bfloat16(o[d0][r]*rli[r]);}
    asm volatile("s_waitcnt lgkmcnt(0)":::"memory");
    #pragma unroll
    for(int i=0;i<4;++i){const int row=i*8+(lane>>3),ch=lane&7; const u32x4 v=*(const u32x4*)(stg+row*64+ch*8); ATTN_STORE16(Ow+(long)row*OP+ch*8,v);} }
  asm volatile("s_waitcnt lgkmcnt(0)\n\ts_barrier":::"memory");
  #undef BIAS
  #undef DMA_K
  #undef DMA_V
  #undef CMASK
  #undef START
  #undef RESC
  #undef ROT
}
constexpr int ATTN_LDS_BYTES=LDS_BYTES;
struct AttnTensors { const bf16* Q; const bf16* K; const bf16* V; bf16* O; const float* CL; };
struct AttnUnit { int bh; int qb; };
struct StaticOrder {
  int vcu;
  __device__ __forceinline__ explicit StaticOrder(int grid,int block):vcu((block%8)*(grid/8)+block/8){}
  __device__ __forceinline__ bool next(int i,AttnUnit&u)const{ if(i>=2)return false; const int s=vcu&3; u.bh=vcu>>2; u.qb=(i==0)?7-s:s; return true; }
  __device__ __forceinline__ void a_ready(const AttnUnit&)const{}
  __device__ __forceinline__ void done(const AttnUnit&)const{}
};
template<class Sched,int THRL=8> __device__ __forceinline__ void attn_phase(char*lds,const AttnTensors&T,const Sched&S){
  AttnUnit u;
  for(int i=0;S.next(i,u);++i){ S.a_ready(u); attn_unit<THRL>(u.bh/NHEAD,u.bh%NHEAD,u.qb,T.Q,T.K,T.V,T.O,T.CL,lds); S.done(u); }
}
#undef SBAR
#undef WAIT_BAR
}

#define LAS __attribute__((address_space(3)))
typedef unsigned short bf16;
typedef unsigned v4u __attribute__((ext_vector_type(4)));
typedef unsigned v2u __attribute__((ext_vector_type(2)));
typedef float f32x4 __attribute__((ext_vector_type(4)));
constexpr int NWAVES = 8, NTHR = 512;
constexpr int BATCH = 8, SEQ = 2048, M = BATCH * SEQ, D = 1024, AW = 512, NH = 8, HD = 64, SW = 512, NG = 32, GS = 16, NP = 64, DFF = 2816, NUP = 2 * DFF, INC = 2056;
constexpr float EPS = 1e-6f;
constexpr size_t MiB = 1u << 20;
constexpr size_t WS_WIN = 1 * MiB, WS_WGLU = 5 * MiB, WS_WOUT = 6 * MiB, WS_WUP = 8 * MiB, WS_WDN = 19 * MiB;
constexpr size_t WS_TAB = 25 * MiB;
constexpr size_t TB_LOGF = 0, TB_CUM = 512 * 1024, TB_LB = 1024 * 1024, TB_BB = TB_LB + 16384, TB_BBP = 1536 * 1024, TB_CP = 1792 * 1024;
constexpr size_t WS_SS = 28 * MiB;
constexpr size_t WS_XB = 32 * MiB;
constexpr size_t WS_Q = 64 * MiB, WS_K = 80 * MiB, WS_V = 96 * MiB, WS_U = 112 * MiB, WS_YG = 128 * MiB, WS_MIX = 144 * MiB;
constexpr size_t WS_ACT = 152 * MiB, WS_HALO = 240 * MiB, WS_END = 248 * MiB;
constexpr size_t TB_SSQ2 = 2048 * 1024, TB_RSTD1 = 1408 * 1024;
constexpr int LDS_BYTES = 147456, RING_BYTES = 131072;

__device__ __forceinline__ float bf2f(unsigned v) { return __uint_as_float(v << 16); }
__device__ __forceinline__ unsigned f2bf(float f) { unsigned u = __float_as_uint(f); return (u + 0x7fffu + ((u >> 16) & 1u)) >> 16; }
__device__ __forceinline__ unsigned pk2(float lo, float hi) { return f2bf(lo) | (f2bf(hi) << 16); }
__device__ __forceinline__ float wave_sum(float v) {
#pragma unroll
    for (int o = 1; o < 64; o <<= 1) v += __shfl_xor(v, o);
    return v;
}
__device__ __forceinline__ void unpack8(const v4u w, float* f) {
    f[0] = bf2f(w.x & 0xffffu); f[1] = bf2f(w.x >> 16); f[2] = bf2f(w.y & 0xffffu); f[3] = bf2f(w.y >> 16);
    f[4] = bf2f(w.z & 0xffffu); f[5] = bf2f(w.z >> 16); f[6] = bf2f(w.w & 0xffffu); f[7] = bf2f(w.w >> 16);
}
__device__ __forceinline__ v4u pack8(const float* f) { v4u w; w.x = pk2(f[0], f[1]); w.y = pk2(f[2], f[3]); w.z = pk2(f[4], f[5]); w.w = pk2(f[6], f[7]); return w; }

namespace pg8 {
struct EpiPlain {
    static constexpr bool PERM = true, AFTER_DRAIN = false;
    bf16_t* O; int ldc; int split_cols; size_t split_stride;
    __device__ __forceinline__ void operator()(const f32x4 (&acc)[2][2][4][2], const Unit& u, int wr, int wc, int fr, int fq) const {
        const int row0 = u.pm * BM + wr * 64 + fr; int colt = u.pn * BM; bf16_t* base = O;
        if (split_cols) { const int t = colt / split_cols; base += (size_t)t * split_stride; colt -= t * split_cols; }
        const int col0 = colt + wc * 32 + 8 * fq;
#pragma unroll
        for (int ai = 0; ai < 2; ++ai)
#pragma unroll
            for (int m = 0; m < 4; ++m) { bf16_t* rowp = base + (size_t)(row0 + ai * HALF + m * 16) * ldc + col0;
#pragma unroll
                for (int bj = 0; bj < 2; ++bj) { const f32x4 v0 = acc[ai][bj][m][0], v1 = acc[ai][bj][m][1];
                    u32x4 w; w.x = cvt_pk_bf16(v0[0], v0[1]); w.y = cvt_pk_bf16(v0[2], v0[3]); w.z = cvt_pk_bf16(v1[0], v1[1]); w.w = cvt_pk_bf16(v1[2], v1[3]);
                    *(u32x4*)(rowp + bj * HALF) = w; } }
    }
};
struct EpiGlu {
    static constexpr bool PERM = true, AFTER_DRAIN = false;
    const bf16_t* YG; const float* bias; bf16_t* O; int ldo; int ocol0;
    __device__ __forceinline__ void operator()(const f32x4 (&acc)[2][2][4][2], const Unit& u, int wr, int wc, int fr, int fq) const {
        const int row0 = u.pm * BM + wr * 64 + fr; const int col0 = u.pn * BM + wc * 32 + 8 * fq;
#pragma unroll
        for (int ai = 0; ai < 2; ++ai)
#pragma unroll
            for (int m = 0; m < 4; ++m) { const int row = row0 + ai * HALF + m * 16;
#pragma unroll
                for (int bj = 0; bj < 2; ++bj) { const int col = col0 + bj * HALF;
                    const f32x4 b0 = *(const f32x4*)(bias + col), b1 = *(const f32x4*)(bias + col + 4);
                    const f32x4 v0 = acc[ai][bj][m][0] + b0, v1 = acc[ai][bj][m][1] + b1;
                    const u32x4 yw = *(const u32x4*)(YG + (size_t)row * 512 + col);
                    float y[8]; y[0] = __uint_as_float(yw.x << 16); y[1] = __uint_as_float(yw.x & 0xffff0000u); y[2] = __uint_as_float(yw.y << 16); y[3] = __uint_as_float(yw.y & 0xffff0000u);
                    y[4] = __uint_as_float(yw.z << 16); y[5] = __uint_as_float(yw.z & 0xffff0000u); y[6] = __uint_as_float(yw.w << 16); y[7] = __uint_as_float(yw.w & 0xffff0000u);
                    float o[8];
#pragma unroll
                    for (int i = 0; i < 4; ++i) { o[i] = y[i] / (1.f + __expf(-v0[i])); o[4 + i] = y[4 + i] / (1.f + __expf(-v1[i])); }
                    u32x4 w; w.x = cvt_pk_bf16(o[0], o[1]); w.y = cvt_pk_bf16(o[2], o[3]); w.z = cvt_pk_bf16(o[4], o[5]); w.w = cvt_pk_bf16(o[6], o[7]);
                    *(u32x4*)(O + (size_t)row * ldo + ocol0 + col) = w; } }
    }
};
struct EpiRes {
    static constexpr bool PERM = true, AFTER_DRAIN = false;
    const float* base; float* out; int ldc;
    __device__ __forceinline__ void operator()(const f32x4 (&acc)[2][2][4][2], const Unit& u, int wr, int wc, int fr, int fq) const {
        const int row0 = u.pm * BM + wr * 64 + fr; const int col0 = u.pn * BM + wc * 32 + 8 * fq;
#pragma unroll
        for (int ai = 0; ai < 2; ++ai)
#pragma unroll
            for (int m = 0; m < 4; ++m) { const size_t off = (size_t)(row0 + ai * HALF + m * 16) * ldc + col0;
#pragma unroll
                for (int bj = 0; bj < 2; ++bj) {
                    const f32x4 x0 = *(const f32x4*)(base + off + bj * HALF), x1 = *(const f32x4*)(base + off + bj * HALF + 4);
                    *(f32x4*)(out + off + bj * HALF) = x0 + acc[ai][bj][m][0]; *(f32x4*)(out + off + bj * HALF + 4) = x1 + acc[ai][bj][m][1]; } }
    }
};

struct EpiResB {
    static constexpr bool PERM = true, AFTER_DRAIN = false;
    const bf16_t* XB; float* out; int ldc;
    __device__ __forceinline__ void operator()(const f32x4 (&acc)[2][2][4][2], const Unit& u, int wr, int wc, int fr, int fq) const {
        const int row0 = u.pm * BM + wr * 64 + fr; const int col0 = u.pn * BM + wc * 32 + 8 * fq;
        u32x4 wres[2][4][2];
#pragma unroll
        for (int ai = 0; ai < 2; ++ai)
#pragma unroll
            for (int m = 0; m < 4; ++m)
#pragma unroll
                for (int bj = 0; bj < 2; ++bj) wres[ai][m][bj] = *(const u32x4*)(XB + (size_t)(row0 + ai * HALF + m * 16) * ldc + col0 + bj * HALF);
#pragma unroll
        for (int ai = 0; ai < 2; ++ai)
#pragma unroll
            for (int m = 0; m < 4; ++m) { const size_t off = (size_t)(row0 + ai * HALF + m * 16) * ldc + col0;
#pragma unroll
                for (int bj = 0; bj < 2; ++bj) { const u32x4 w = wres[ai][m][bj];
                    const f32x4 x0 = (f32x4){__uint_as_float(w.x << 16), __uint_as_float(w.x & 0xffff0000u), __uint_as_float(w.y << 16), __uint_as_float(w.y & 0xffff0000u)};
                    const f32x4 x1 = (f32x4){__uint_as_float(w.z << 16), __uint_as_float(w.z & 0xffff0000u), __uint_as_float(w.w << 16), __uint_as_float(w.w & 0xffff0000u)};
                    *(f32x4*)(out + off + bj * HALF) = x0 + acc[ai][bj][m][0]; *(f32x4*)(out + off + bj * HALF + 4) = x1 + acc[ai][bj][m][1]; } }
    }
};
struct EpiX1 {
    static constexpr bool PERM = true, AFTER_DRAIN = false;
    const float* base; float* out; bf16_t* XB; float* SSQ; int ldc;
    __device__ __forceinline__ void operator()(const f32x4 (&acc)[2][2][4][2], const Unit& u, int wr, int wc, int fr, int fq) const {
        const int row0 = u.pm * BM + wr * 64 + fr; const int col0 = u.pn * BM + wc * 32 + 8 * fq;
#pragma unroll
        for (int ai = 0; ai < 2; ++ai) {
            f32x4 xres[4][2][2];
#pragma unroll
            for (int m = 0; m < 4; ++m)
#pragma unroll
                for (int bj = 0; bj < 2; ++bj) { const size_t off = (size_t)(row0 + ai * HALF + m * 16) * ldc + col0 + bj * HALF; xres[m][bj][0] = *(const f32x4*)(base + off); xres[m][bj][1] = *(const f32x4*)(base + off + 4); }
#pragma unroll
            for (int m = 0; m < 4; ++m) { const int row = row0 + ai * HALF + m * 16; const size_t off = (size_t)row * ldc + col0; float q = 0.f;
#pragma unroll
                for (int bj = 0; bj < 2; ++bj) {
                    const f32x4 x0 = xres[m][bj][0] + acc[ai][bj][m][0], x1 = xres[m][bj][1] + acc[ai][bj][m][1];
                    q += (x0[0] * x0[0] + x0[1] * x0[1]) + (x0[2] * x0[2] + x0[3] * x0[3]) + (x1[0] * x1[0] + x1[1] * x1[1]) + (x1[2] * x1[2] + x1[3] * x1[3]);
                    u32x4 w; w.x = cvt_pk_bf16(x0[0], x0[1]); w.y = cvt_pk_bf16(x0[2], x0[3]); w.z = cvt_pk_bf16(x1[0], x1[1]); w.w = cvt_pk_bf16(x1[2], x1[3]);
                    *(u32x4*)(XB + off + bj * HALF) = w; }
                q += __shfl_xor(q, 16); q += __shfl_xor(q, 32);
                if (fq == 0) SSQ[(size_t)row * 16 + u.pn * 4 + wc] = q; } }
    }
};
__device__ __forceinline__ float row_up1(float prev, float cur) { float t; asm volatile("s_nop 1\n\tv_mov_b32_dpp %0, %1 row_ror:1 row_mask:0xf bank_mask:0xf\n\tv_mov_b32_dpp %0, %2 row_shr:1 row_mask:0xf bank_mask:0xf" : "=&v"(t) : "v"(prev), "v"(cur)); return t; }
__device__ __forceinline__ float row_up2(float prev, float cur) { float t; asm volatile("s_nop 1\n\tv_mov_b32_dpp %0, %1 row_ror:2 row_mask:0xf bank_mask:0xf\n\tv_mov_b32_dpp %0, %2 row_shr:2 row_mask:0xf bank_mask:0xf" : "=&v"(t) : "v"(prev), "v"(cur)); return t; }

struct EpiIn {
    static constexpr bool PERM = true, AFTER_DRAIN = false;
    const float* rstd1; const float* gq; const float* gk; bf16_t* O; size_t stride; float c2;
    __device__ __forceinline__ void operator()(const f32x4 (&acc)[2][2][4][2], const Unit& u, int wr, int wc, int fr, int fq) const {
        const int row0 = u.pm * BM + wr * 64 + fr; const int t = u.pn >> 1; bf16_t* base = O + (size_t)t * stride + ((u.pn & 1) * 4 + wc) * 64 + 8 * fq;
        f32x4 gv[2][2];
        if (t < 2) { const float* gp = t ? gk : gq; const float sc = t ? 1.f : c2;
#pragma unroll
            for (int bj = 0; bj < 2; ++bj)
#pragma unroll
                for (int n = 0; n < 2; ++n) gv[bj][n] = *(const f32x4*)(gp + 32 * bj + 8 * fq + 4 * n) * sc; }
        float rsA[2][4];
#pragma unroll
        for (int ai = 0; ai < 2; ++ai)
#pragma unroll
            for (int m = 0; m < 4; ++m) rsA[ai][m] = rstd1[row0 + ai * HALF + m * 16];
#pragma unroll
        for (int ai = 0; ai < 2; ++ai)
#pragma unroll
            for (int m = 0; m < 4; ++m) { const int row = row0 + ai * HALF + m * 16; float rs = rsA[ai][m];
                f32x4 v[2][2];
#pragma unroll
                for (int bj = 0; bj < 2; ++bj)
#pragma unroll
                    for (int n = 0; n < 2; ++n) v[bj][n] = acc[ai][bj][m][n] * rs;
                if (t < 2) { float q = 0.f;
#pragma unroll
                    for (int bj = 0; bj < 2; ++bj)
#pragma unroll
                        for (int n = 0; n < 2; ++n) q += (v[bj][n][0] * v[bj][n][0] + v[bj][n][1] * v[bj][n][1]) + (v[bj][n][2] * v[bj][n][2] + v[bj][n][3] * v[bj][n][3]);
                    q += __shfl_xor(q, 16); q += __shfl_xor(q, 32);
                    const float hr = __builtin_amdgcn_rsqf(q * (1.f / 64.f) + 1e-6f);
#pragma unroll
                    for (int bj = 0; bj < 2; ++bj)
#pragma unroll
                        for (int n = 0; n < 2; ++n) v[bj][n] = v[bj][n] * gv[bj][n] * hr; }
#pragma unroll
                for (int bj = 0; bj < 2; ++bj) { u32x4 w; w.x = cvt_pk_bf16(v[bj][0][0], v[bj][0][1]); w.y = cvt_pk_bf16(v[bj][0][2], v[bj][0][3]); w.z = cvt_pk_bf16(v[bj][1][0], v[bj][1][1]); w.w = cvt_pk_bf16(v[bj][1][2], v[bj][1][3]);
                    *(u32x4*)(base + (size_t)row * 512 + 32 * bj) = w; } }
    }
};
struct EpiUpConv {
    static constexpr bool PERM = true, AFTER_DRAIN = false;
    const float* SSQ; const float* cw; const float* cb; bf16_t* ACT; float* HALO; __attribute__((address_space(3))) float* XCH;
    __device__ __forceinline__ void operator()(f32x4 (&acc)[2][2][4][2], const Unit& u, int wr, int wc, int fr, int fq) const {
        const int row0 = u.pm * BM + wr * 64 + fr; const int tcol = wc * 32 + 8 * fq;
        const int ac0 = u.pn * HALF + tcol;
        f32x4 prm[2][8];
#define LOAD_PRM(n) do { prm[n][0] = *(const f32x4*)(cb + ac0 + 4 * (n)); prm[n][1] = *(const f32x4*)(cb + 2816 + ac0 + 4 * (n)); \
            _Pragma("unroll") for (int j = 0; j < 3; ++j) { prm[n][2 + 2 * j] = *(const f32x4*)(cw + j * 5632 + ac0 + 4 * (n)); prm[n][3 + 2 * j] = *(const f32x4*)(cw + j * 5632 + 2816 + ac0 + 4 * (n)); } } while (0)
        LOAD_PRM(0);
#pragma unroll
        for (int ai = 0; ai < 2; ++ai)
#pragma unroll
            for (int m = 0; m < 4; ++m) { const f32x4 a0 = *(const f32x4*)(SSQ + (size_t)(row0 + ai * HALF + m * 16) * 16 + 4 * fq);
                float tot = (a0[0] + a0[1]) + (a0[2] + a0[3]); tot += __shfl_xor(tot, 16); tot += __shfl_xor(tot, 32);
                const float rstd = __builtin_amdgcn_rsqf(tot * (1.f / 1024.f) + 1e-6f);
#pragma unroll
                for (int bj = 0; bj < 2; ++bj) { acc[ai][bj][m][0] *= rstd; acc[ai][bj][m][1] *= rstd; }
                __builtin_amdgcn_sched_barrier(0); }
        if (fr >= 14) {
#pragma unroll
            for (int ai = 0; ai < 2; ++ai)
#pragma unroll
                for (int bj = 0; bj < 2; ++bj)
#pragma unroll
                    for (int n = 0; n < 2; ++n) { XCH[((ai * 2 + wr) * 2 + (fr - 14)) * 256 + bj * HALF + tcol + 4 * n + 0] = acc[ai][bj][3][n][0]; XCH[((ai * 2 + wr) * 2 + (fr - 14)) * 256 + bj * HALF + tcol + 4 * n + 1] = acc[ai][bj][3][n][1];
                        XCH[((ai * 2 + wr) * 2 + (fr - 14)) * 256 + bj * HALF + tcol + 4 * n + 2] = acc[ai][bj][3][n][2]; XCH[((ai * 2 + wr) * 2 + (fr - 14)) * 256 + bj * HALF + tcol + 4 * n + 3] = acc[ai][bj][3][n][3]; }
            if (wr == 1) {
#pragma unroll
                for (int bj = 0; bj < 2; ++bj)
#pragma unroll
                    for (int n = 0; n < 2; ++n) *(f32x4*)(HALO + ((size_t)u.pm * 4 + (fr - 14)) * 5632 + u.pn * BM + bj * HALF + tcol + 4 * n) = acc[1][bj][3][n];
            }
        }
        if (fr < 2 && wr == 0) {
#pragma unroll
            for (int bj = 0; bj < 2; ++bj)
#pragma unroll
                for (int n = 0; n < 2; ++n) *(f32x4*)(HALO + ((size_t)u.pm * 4 + 2 + fr) * 5632 + u.pn * BM + bj * HALF + tcol + 4 * n) = acc[0][bj][0][n];
        }
        asm volatile("s_waitcnt lgkmcnt(0)" ::: "memory"); __builtin_amdgcn_s_barrier(); asm volatile("" ::: "memory");
        LOAD_PRM(1);
#undef LOAD_PRM
#pragma unroll
        for (int n = 0; n < 2; ++n) {
            const f32x4 cbg = prm[n][0], cbv = prm[n][1], w0g = prm[n][2], w0v = prm[n][3], w1g = prm[n][4], w1v = prm[n][5], w2g = prm[n][6], w2v = prm[n][7];
#pragma unroll
            for (int ai = 0; ai < 2; ++ai)
#pragma unroll
                for (int m = 3; m >= 0; --m) {
                    f32x4 pg, pv;
                    if (m > 0) { pg = acc[ai][0][m - 1][n]; pv = acc[ai][1][m - 1][n]; }
                    else { const int blk = (wr == 1) ? ai * 2 : 1; const bool have = (wr == 1) || (ai == 1);
                        pg = (f32x4){0.f, 0.f, 0.f, 0.f}; pv = pg;
                        if (have && fr >= 14) { pg = *(const __attribute__((address_space(3))) f32x4*)(XCH + (blk * 2 + (fr - 14)) * 256 + tcol + 4 * n); pv = *(const __attribute__((address_space(3))) f32x4*)(XCH + (blk * 2 + (fr - 14)) * 256 + HALF + tcol + 4 * n); } }
                    const f32x4 cg = acc[ai][0][m][n], cv = acc[ai][1][m][n]; f32x4 o;
#pragma unroll
                    for (int i = 0; i < 4; ++i) {
                        const float g1 = row_up1(pg[i], cg[i]), g2 = row_up2(pg[i], cg[i]), v1 = row_up1(pv[i], cv[i]), v2 = row_up2(pv[i], cv[i]);
                        const float hg = cbg[i] + w0g[i] * g2 + w1g[i] * g1 + w2g[i] * cg[i], hv = cbv[i] + w0v[i] * v2 + w1v[i] * v1 + w2v[i] * cv[i];
                        float oi = hg * __builtin_amdgcn_rcpf(1.f + __expf(-hg)) * hv; asm volatile("" : "+v"(oi)); o[i] = oi; }
                    acc[ai][0][m][n] = o; __builtin_amdgcn_sched_barrier(0); }
        }
#pragma unroll
        for (int ai = 0; ai < 2; ++ai)
#pragma unroll
            for (int m = 0; m < 4; ++m) { const f32x4 v0 = acc[ai][0][m][0], v1 = acc[ai][0][m][1];
                u32x4 w; w.x = cvt_pk_bf16(v0[0], v0[1]); w.y = cvt_pk_bf16(v0[2], v0[3]); w.z = cvt_pk_bf16(v1[0], v1[1]); w.w = cvt_pk_bf16(v1[2], v1[3]);
                *(u32x4*)(ACT + (size_t)(row0 + ai * HALF + m * 16) * 2816 + ac0) = w; }
    }
};
}

struct Args { const float* in[24]; float* out; unsigned char* ws; int ph_lo, ph_hi; };

__device__ __forceinline__ float log_sigmoid(float z) { return fminf(z, 0.f) - log1pf(expf(-fabsf(z))); }
typedef short s16x8p __attribute__((ext_vector_type(8)));
constexpr int WF_LO_OFF = 32768;
__device__ __forceinline__ void p0_prologue(const Args& a, LAS unsigned char* lds, int vcu, int gw, int NGW, int tid, int wave, int lane) {
    unsigned char* ws = a.ws;
    {
        const float* x = a.in[0]; const float* gm = a.in[1]; const float* win = a.in[2]; const float* bfv = a.in[3];
        float* logf = (float*)(ws + WS_TAB + TB_LOGF); float* rstd1 = (float*)(ws + WS_TAB + TB_RSTD1); bf16* XB = (bf16*)(ws + WS_XB);
        for (int i = tid; i < 32768; i += NTHR) ((LAS unsigned*)lds)[i >> 1 << 1 | (i & 1)] = 0u;
        __syncthreads();
        for (int k = tid; k < D; k += NTHR) { const float g = gm[k]; const f32x4 w0 = *(const f32x4*)(win + (size_t)k * INC + 1536), w1 = *(const f32x4*)(win + (size_t)k * INC + 1540);
            const float w[8] = {w0[0] * g, w0[1] * g, w0[2] * g, w0[3] * g, w1[0] * g, w1[1] * g, w1[2] * g, w1[3] * g};
            const int ks = k >> 5, q = (k >> 3) & 3, i = k & 7;
#pragma unroll
            for (int h = 0; h < 8; ++h) { const unsigned hb = f2bf(w[h]); const float lo = w[h] - bf2f(hb); const int off = ((ks * 4 + q) * 16 + h) * 16 + i * 2;
                *(LAS bf16*)(lds + off) = (bf16)hb; *(LAS bf16*)(lds + WF_LO_OFF + off) = (bf16)f2bf(lo); } }
        __syncthreads();
        const int m = lane & 15, q = lane >> 4, half = wave & 1;
        LAS float* XR = (LAS float*)(lds + 65536);
        for (int blk = vcu * 4 + (wave >> 1); blk < M / 16; blk += (NGW / 8) * 4) {
            const size_t row = (size_t)blk * 16 + m; const float* xr = x + row * D + 512 * half + 8 * q;
            f32x4 acc = (f32x4){0.f, 0.f, 0.f, 0.f}; float ssq = 0.f;
#pragma unroll
            for (int ks = 0; ks < 16; ++ks) {
                const f32x4 x0 = *(const f32x4*)(xr + 32 * ks), x1 = *(const f32x4*)(xr + 32 * ks + 4);
                const float xv[8] = {x0[0], x0[1], x0[2], x0[3], x1[0], x1[1], x1[2], x1[3]};
                unsigned hb[8]; float lo[8];
#pragma unroll
                for (int i = 0; i < 8; ++i) { hb[i] = f2bf(xv[i]); lo[i] = xv[i] - bf2f(hb[i]); ssq += xv[i] * xv[i]; }
                v4u hw; hw.x = hb[0] | (hb[1] << 16); hw.y = hb[2] | (hb[3] << 16); hw.z = hb[4] | (hb[5] << 16); hw.w = hb[6] | (hb[7] << 16);
                const v4u lw = pack8(lo);
                *(v4u*)(XB + row * D + 512 * half + 32 * ks + 8 * q) = hw;
                const int kst = 16 * half + ks;
                const s16x8p bh = *(const LAS s16x8p*)(lds + ((kst * 4 + q) * 16 + m) * 16), bl = *(const LAS s16x8p*)(lds + WF_LO_OFF + ((kst * 4 + q) * 16 + m) * 16);
                const s16x8p ah = __builtin_bit_cast(s16x8p, hw), al = __builtin_bit_cast(s16x8p, lw);
                acc = __builtin_amdgcn_mfma_f32_16x16x32_bf16(ah, bh, acc, 0, 0, 0);
                acc = __builtin_amdgcn_mfma_f32_16x16x32_bf16(ah, bl, acc, 0, 0, 0);
                acc = __builtin_amdgcn_mfma_f32_16x16x32_bf16(al, bh, acc, 0, 0, 0);
            }
            ssq += __shfl_xor(ssq, 16); ssq += __shfl_xor(ssq, 32);
            __syncthreads();
            if (half) { LAS float* p = XR + ((wave >> 1) * 64 + lane) * 5; p[0] = acc[0]; p[1] = acc[1]; p[2] = acc[2]; p[3] = acc[3]; p[4] = ssq; }
            __syncthreads();
            if (!half) { const LAS float* p = XR + ((wave >> 1) * 64 + lane) * 5; acc[0] += p[0]; acc[1] += p[1]; acc[2] += p[2]; acc[3] += p[3]; ssq += p[4];
                const float rstd = 1.f / sqrtf(ssq * (1.f / D) + EPS);
                if (q == 0) rstd1[row] = rstd;
#pragma unroll
                for (int j = 0; j < 4; ++j) { const float rt = __shfl(rstd, 4 * q + j); if (m < 8) logf[((size_t)blk * 16 + 4 * q + j) * 8 + m] = log_sigmoid(acc[j] * rt + bfv[m]); } }
        }
        __syncthreads();
    }
    {
        constexpr int I_IN = 32 * 32, I_GLU = 8 * 16, I_OUT = 16 * 32, I_UP = 88 * 32, I_DN = 16 * 88, NITEMS = I_IN + I_GLU + I_OUT + I_UP + I_DN;
        struct WItem { const float* src; const float* g; bf16* dst; int ldn; int frag; };
        auto decode = [&](int it, WItem& w) {
            int r = it;
            if (r < I_IN) { const int nb = r / 32, kb = r % 32, dn = 64 * nb + lane, tl = dn >> 8, c = dn & 255;
                int sn = tl * 256 + 64 * ((c >> 5) & 3) + 32 * (c >> 7) + (c & 31); if (sn >= 1536) sn += 8;
                w.src = a.in[2] + (size_t)(32 * kb) * INC + sn; w.ldn = INC; w.g = a.in[1] + 32 * kb; w.dst = (bf16*)(ws + WS_WIN) + (size_t)dn * D + 32 * kb; w.frag = 0; return; } r -= I_IN;
            if (r < I_GLU) { const int nb = r / 16, kb = r % 16, dn = 64 * nb + lane;
                w.src = a.in[14] + (size_t)(32 * kb) * SW + dn; w.ldn = SW; w.g = nullptr; w.dst = (bf16*)(ws + WS_WGLU) + ((size_t)(kb * 32 + (dn >> 4)) * 64 + (dn & 15)) * 8; w.frag = 1; return; } r -= I_GLU;
            if (r < I_OUT) { const int nb = r / 32, kb = r % 32, dn = 64 * nb + lane, k0 = 32 * kb;
                w.src = a.in[18] + (size_t)k0 * D + dn; w.ldn = D; w.g = (k0 < AW) ? a.in[16] + k0 : a.in[17] + (k0 - AW); w.dst = (bf16*)(ws + WS_WOUT) + (size_t)dn * D + k0; w.frag = 0; return; } r -= I_OUT;
            if (r < I_UP) { const int nb = r / 32, kb = r % 32, dn = 64 * nb + lane, tl = dn >> 8, cc = dn & 255, sn = cc < 128 ? 128 * tl + cc : DFF + 128 * tl + cc - 128;
                w.src = a.in[20] + (size_t)(32 * kb) * NUP + sn; w.ldn = NUP; w.g = a.in[19] + 32 * kb; w.dst = (bf16*)(ws + WS_WUP) + (size_t)dn * D + 32 * kb; w.frag = 0; return; } r -= I_UP;
            { const int nb = r / 88, kb = r % 88, dn = 64 * nb + lane;
                w.src = a.in[23] + (size_t)(32 * kb) * D + dn; w.ldn = D; w.g = nullptr; w.dst = (bf16*)(ws + WS_WDN) + (size_t)dn * DFF + 32 * kb; w.frag = 0; }
        };
        for (int it = gw; it < NITEMS; it += 2 * NGW) {
            const bool two = it + NGW < NITEMS;
            WItem w0, w1; decode(it, w0); decode(two ? it + NGW : it, w1);
            float v0[32], v1[32];
#pragma unroll
            for (int i = 0; i < 32; ++i) v0[i] = w0.src[(size_t)i * w0.ldn];
            if (two) {
#pragma unroll
                for (int i = 0; i < 32; ++i) v1[i] = w1.src[(size_t)i * w1.ldn]; }
            if (w0.g) {
#pragma unroll
                for (int i = 0; i < 32; ++i) v0[i] *= w0.g[i]; }
            if (two && w1.g) {
#pragma unroll
                for (int i = 0; i < 32; ++i) v1[i] *= w1.g[i]; }
#pragma unroll
            for (int j = 0; j < 4; ++j) *(v4u*)(w0.dst + (w0.frag ? j * 128 : 8 * j)) = pack8(v0 + 8 * j);
            if (two) {
#pragma unroll
                for (int j = 0; j < 4; ++j) *(v4u*)(w1.dst + (w1.frag ? j * 128 : 8 * j)) = pack8(v1 + 8 * j); }
        }
    }
    {
        const float* lre = a.in[6]; const float* lim = a.in[7]; const float* lst = a.in[8]; const float* bre = a.in[9]; const float* bim = a.in[10]; const float* cre = a.in[11]; const float* cim = a.in[12];
        float* LB = (float*)(ws + WS_TAB + TB_LB); bf16* BBP = (bf16*)(ws + WS_TAB + TB_BBP); unsigned* CP = (unsigned*)(ws + WS_TAB + TB_CP);
        for (int j = gw * 64 + lane; j < NG * NP * GS; j += NGW * 64) {
            const int i = j >> 4, h = j & 15, g = i / NP, p = i % NP, n = p & 31, slot = p >> 5;
            const float lr = lre[i], li = lim[i], lsv = lst[g], br = bre[j], bi = bim[j], cr = cre[(size_t)(g * GS + h) * NP + p], ci = cim[(size_t)(g * GS + h) * NP + p];
            const float step = expf(lsv), er = expf(lr * step), ar = er * cosf(li * step), ai = er * sinf(li * step);
            const float nr = ar - 1.f, ni = ai, den = lr * lr + li * li;
            const float fr = (nr * lr + ni * li) / den, fi = (ni * lr - nr * li) / den;
            if (h == 0) { LB[2 * i] = ar; LB[2 * i + 1] = ai; }
            BBP[((size_t)(g * 4 + slot) * 32 + n) * 16 + h] = (bf16)f2bf(fr * br - fi * bi); BBP[((size_t)(g * 4 + 2 + slot) * 32 + n) * 16 + h] = (bf16)f2bf(fr * bi + fi * br);
            CP[(size_t)(g * GS + h) * 64 + p] = pk2(cr, -ci);
        }
    }
}

__device__ __forceinline__ void cumsum_bh(const Args& a, int bh, int lane) {
    const float* logf = (const float*)(a.ws + WS_TAB + TB_LOGF); float* cum = (float*)(a.ws + WS_TAB + TB_CUM);
    const int b = bh / NH, h = bh % NH; float loc[32]; float t = 0.f;
#pragma unroll
    for (int i = 0; i < 32; ++i) { t += logf[((size_t)b * SEQ + 32 * lane + i) * 8 + h]; loc[i] = t; }
    float incl = t;
#pragma unroll
    for (int o = 1; o < 64; o <<= 1) { const float nn = __shfl_up(incl, o); if (lane >= o) incl += nn; }
    const float excl = incl - t;
#pragma unroll
    for (int i = 0; i < 32; ++i) cum[(size_t)bh * SEQ + 32 * lane + i] = (loc[i] + excl) * 1.4426950408889634f;
}

__device__ __forceinline__ float gelu_tanh(float x) { const float u = 0.7978845608028654f * (x + 0.044715f * x * x * x); const float e = __expf(2.f * u); return x * (1.f - __builtin_amdgcn_rcpf(e + 1.f)); }
typedef short s16x8 __attribute__((ext_vector_type(8)));
typedef float v2f __attribute__((ext_vector_type(2)));
typedef float f32x16v __attribute__((ext_vector_type(16)));
#define CFMA(xr, xi, lr, li, br, bi) do { const float nr_ = fmaf(lr, xr, fmaf(-(li), xi, br)), ni_ = fmaf(lr, xi, fmaf(li, xr, bi)); xr = nr_; xi = ni_; } while (0)
#define CSQR(r, i) do { const float nr_ = r * r - i * i, ni_ = 2.f * r * i; r = nr_; i = ni_; } while (0)
__device__ __forceinline__ void ssm_a_unit(const Args& a, int unit, int wave, int lane) {
    unsigned char* ws = a.ws;
    const int b = unit >> 5, c = unit & 31; const size_t t0 = (size_t)b * SEQ + 64 * c;
    const int n = lane & 31, hi = lane >> 5, sig = 16 * ((n >> 2) & 1) + 4 * (n >> 3) + (n & 3);
    const bf16* U = (const bf16*)(ws + WS_U); const float* LB = (const float*)(ws + WS_TAB + TB_LB); const bf16* BBP = (const bf16*)(ws + WS_TAB + TB_BBP); float* SS = (float*)(ws + WS_SS);
    const f32x16v zero = f32x16v{};
#pragma unroll 1
    for (int gi = 0; gi < 4; ++gi) {
        const int g = wave * 4 + gi;
        float lr[2], li[2], l16r[2], l16i[2];
#pragma unroll
        for (int sl = 0; sl < 2; ++sl) { lr[sl] = LB[2 * (g * NP + n + 32 * sl)]; li[sl] = LB[2 * (g * NP + n + 32 * sl) + 1]; l16r[sl] = lr[sl]; l16i[sl] = li[sl];
#pragma unroll
            for (int q = 0; q < 4; ++q) CSQR(l16r[sl], l16i[sl]); }
        s16x8 bfr[4];
#pragma unroll
        for (int nb = 0; nb < 4; ++nb) bfr[nb] = *(const s16x8*)(BBP + ((size_t)(g * 4 + nb) * 32 + n) * 16 + 8 * hi);
        float tr[2] = {0.f, 0.f}, ti[2] = {0.f, 0.f};
#pragma unroll
        for (int sb = 0; sb < 2; ++sb) {
            const s16x8 afr = *(const s16x8*)(U + (t0 + 32 * sb + sig) * SW + 16 * g + 8 * hi);
            f32x16v d[4];
#pragma unroll
            for (int nb = 0; nb < 4; ++nb) d[nb] = __builtin_amdgcn_mfma_f32_32x32x16_bf16(afr, bfr[nb], zero, 0, 0, 0);
#pragma unroll
            for (int sl = 0; sl < 2; ++sl) { float sr = 0.f, si = 0.f;
#pragma unroll
                for (int r = 0; r < 16; ++r) CFMA(sr, si, lr[sl], li[sl], d[sl][r], d[2 + sl][r]);
                if (sb == 0) { float qr = l16r[sl], qi = l16i[sl]; CSQR(qr, qi); tr[sl] = qr * sr - qi * si; ti[sl] = qr * si + qi * sr; }
                else { tr[sl] += sr; ti[sl] += si; } }
        }
#pragma unroll
        for (int sl = 0; sl < 2; ++sl) {
            float vr = tr[sl], vi = ti[sl];
            if (hi == 0) { const float nr = l16r[sl] * vr - l16i[sl] * vi, ni = l16r[sl] * vi + l16i[sl] * vr; vr = nr; vi = ni; }
            vr += __shfl_xor(vr, 32); vi += __shfl_xor(vi, 32);
            if (hi == 0) { float* o = SS + ((((size_t)b * 32 + c) * NG + g) * NP + n + 32 * sl) * 2; o[0] = vr; o[1] = vi; }
        }
    }
}
constexpr int XT_PITCH = 68, XT_BYTES = 32 * XT_PITCH * 4, YT_OFF = 8 * XT_BYTES, YT_PITCH = 1040, RED_OFF = YT_OFF + 64 * YT_PITCH;
static_assert(RED_OFF + 2048 <= LDS_BYTES, "ssm LDS");
__device__ __forceinline__ void ssm_b_unit(const Args& a, LAS unsigned char* lds, int unit, int wave, int lane) {
    unsigned char* ws = a.ws;
    const int b = unit >> 5, c = unit & 31; const size_t t0 = (size_t)b * SEQ + 64 * c;
    const int n = lane & 31, hi = lane >> 5, fr = lane & 15, fq = lane >> 4, sig = 16 * ((n >> 2) & 1) + 4 * (n >> 3) + (n & 3);
    const bf16* U = (const bf16*)(ws + WS_U); const float* LB = (const float*)(ws + WS_TAB + TB_LB); const bf16* BBP = (const bf16*)(ws + WS_TAB + TB_BBP);
    const bf16* CP = (const bf16*)(ws + WS_TAB + TB_CP); const float* SS = (const float*)(ws + WS_SS); const float* dsk = a.in[13];
    LAS unsigned* XT = (LAS unsigned*)(lds + wave * XT_BYTES);
    LAS unsigned char* YT = lds + YT_OFF; LAS float* RED = (LAS float*)(lds + RED_OFF);
    const f32x16v zero = f32x16v{};
    float xcrA[4][2], xciA[4][2];
    {
        float l128r[4][2], l128i[4][2], wr_[4][2], wi_[4][2];
#pragma unroll
        for (int gi = 0; gi < 4; ++gi)
#pragma unroll
            for (int sl = 0; sl < 2; ++sl) { const int g = wave * 4 + gi; const v2f lb = *(const v2f*)(LB + 2 * (g * NP + n + 32 * sl));
                float r = lb.x, i = lb.y;
#pragma unroll
                for (int q = 0; q < 4; ++q) CSQR(r, i);
                CSQR(r, i); CSQR(r, i);
                wr_[gi][sl] = hi ? r : 1.f; wi_[gi][sl] = hi ? i : 0.f; CSQR(r, i); l128r[gi][sl] = r; l128i[gi][sl] = i; xcrA[gi][sl] = 0.f; xciA[gi][sl] = 0.f; }
        const float* sp0 = SS + ((((size_t)b * 32) * NG + wave * 4) * NP + n) * 2;
#pragma unroll 2
        for (int k = hi; k < c; k += 2) {
#pragma unroll
            for (int gi = 0; gi < 4; ++gi)
#pragma unroll
                for (int sl = 0; sl < 2; ++sl) { const v2f sv = *(const v2f*)(sp0 + (size_t)(c - 1 - k) * NG * NP * 2 + (gi * NP + 32 * sl) * 2);
                    xcrA[gi][sl] += wr_[gi][sl] * sv.x - wi_[gi][sl] * sv.y; xciA[gi][sl] += wr_[gi][sl] * sv.y + wi_[gi][sl] * sv.x;
                    const float nwr = wr_[gi][sl] * l128r[gi][sl] - wi_[gi][sl] * l128i[gi][sl], nwi = wr_[gi][sl] * l128i[gi][sl] + wi_[gi][sl] * l128r[gi][sl]; wr_[gi][sl] = nwr; wi_[gi][sl] = nwi; } }
#pragma unroll
        for (int gi = 0; gi < 4; ++gi)
#pragma unroll
            for (int sl = 0; sl < 2; ++sl) { xcrA[gi][sl] += __shfl_xor(xcrA[gi][sl], 32); xciA[gi][sl] += __shfl_xor(xciA[gi][sl], 32); }
    }
#pragma unroll 1
    for (int gp = 0; gp < 2; ++gp)
#pragma unroll
    for (int gi2 = 0; gi2 < 2; ++gi2) {
        const int gi = 2 * gp + gi2, g = wave * 4 + gi;
        float lr[2], li[2], l16r[2], l16i[2], xcr[2], xci[2];
#pragma unroll
        for (int sl = 0; sl < 2; ++sl) { const v2f lb = *(const v2f*)(LB + 2 * (g * NP + n + 32 * sl)); lr[sl] = lb.x; li[sl] = lb.y; l16r[sl] = lb.x; l16i[sl] = lb.y;
#pragma unroll
            for (int q = 0; q < 4; ++q) CSQR(l16r[sl], l16i[sl]);
            xcr[sl] = gp ? xcrA[2 + gi2][sl] : xcrA[gi2][sl]; xci[sl] = gp ? xciA[2 + gi2][sl] : xciA[gi2][sl]; }
        s16x8 bfr[4], cfr[4];
#pragma unroll
        for (int nb = 0; nb < 4; ++nb) bfr[nb] = *(const s16x8*)(BBP + ((size_t)(g * 4 + nb) * 32 + n) * 16 + 8 * hi);
#pragma unroll
        for (int kk = 0; kk < 4; ++kk) cfr[kk] = *(const s16x8*)(CP + (size_t)(g * GS + fr) * 128 + 32 * kk + 8 * fq);
        const f32x4 dk = *(const f32x4*)(dsk + g * GS + 4 * fq);
#pragma unroll
        for (int sb = 0; sb < 2; ++sb) {
            const s16x8 afr = *(const s16x8*)(U + (t0 + 32 * sb + sig) * SW + 16 * g + 8 * hi);
            f32x16v d[4];
#pragma unroll
            for (int nb = 0; nb < 4; ++nb) d[nb] = __builtin_amdgcn_mfma_f32_32x32x16_bf16(afr, bfr[nb], zero, 0, 0, 0);
#pragma unroll
            for (int sl = 0; sl < 2; ++sl) {
                float sr = 0.f, si = 0.f;
#pragma unroll
                for (int r = 0; r < 16; ++r) CFMA(sr, si, lr[sl], li[sl], d[sl][r], d[2 + sl][r]);
                const float orr = __shfl_xor(sr, 32), oii = __shfl_xor(si, 32);
                const float ser = hi ? orr : sr, sei = hi ? oii : si, sor = hi ? sr : orr, soi = hi ? si : oii;
                float xnr = xcr[sl], xni = xci[sl]; CFMA(xnr, xni, l16r[sl], l16i[sl], ser, sei);
                float xr = hi ? xnr : xcr[sl], xi = hi ? xni : xci[sl];
                float x2r = xnr, x2i = xni; CFMA(x2r, x2i, l16r[sl], l16i[sl], sor, soi); xcr[sl] = x2r; xci[sl] = x2i;
#pragma unroll
                for (int r = 0; r < 16; ++r) { CFMA(xr, xi, lr[sl], li[sl], d[sl][r], d[2 + sl][r]); XT[(16 * hi + r) * XT_PITCH + n + 32 * sl] = pg8::cvt_pk_bf16(xr, xi); }
            }
#pragma unroll
            for (int mb = 0; mb < 2; ++mb) {
                f32x4 acc = (f32x4){0.f, 0.f, 0.f, 0.f};
#pragma unroll
                for (int kk = 0; kk < 4; ++kk) { const s16x8 xf = *(const LAS s16x8*)(XT + (16 * mb + fr) * XT_PITCH + 16 * kk + 4 * fq); acc = __builtin_amdgcn_mfma_f32_16x16x32_bf16(cfr[kk], xf, acc, 0, 0, 0); }
                const int s = 32 * sb + 16 * mb + fr;
                const v2u uw = *(const v2u*)(U + (t0 + s) * SW + 16 * g + 4 * fq);
                const float y0 = gelu_tanh(acc[0] + dk[0] * bf2f(uw.x & 0xffffu)), y1 = gelu_tanh(acc[1] + dk[1] * bf2f(uw.x >> 16)), y2 = gelu_tanh(acc[2] + dk[2] * bf2f(uw.y & 0xffffu)), y3 = gelu_tanh(acc[3] + dk[3] * bf2f(uw.y >> 16));
                v2u yw; yw.x = pg8::cvt_pk_bf16(y0, y1); yw.y = pg8::cvt_pk_bf16(y2, y3);
                *(LAS v2u*)(YT + s * YT_PITCH + (16 * g + 4 * fq) * 2) = yw;
            }
        }
    }
    __syncthreads();
    const bf16* WG = (const bf16*)(ws + WS_WGLU); const float* bg = a.in[15]; bf16* MIX = (bf16*)(ws + WS_MIX);
    f32x4 acc[4][4];
#pragma unroll
    for (int mb = 0; mb < 4; ++mb)
#pragma unroll
        for (int nb = 0; nb < 4; ++nb) acc[mb][nb] = (f32x4){0.f, 0.f, 0.f, 0.f};
    s16x8 wq[4][4];
    const bf16* wpf = WG + ((size_t)(4 * wave) * 64 + lane) * 8;
#pragma unroll
    for (int st = 0; st < 3; ++st) {
#pragma unroll
        for (int nb = 0; nb < 4; ++nb) wq[st][nb] = *(const s16x8*)(wpf + nb * 512);
        wpf += 32 * 512; }
#pragma unroll 1
    for (int kk4 = 0; kk4 < 16; kk4 += 4) {
        asm volatile("" : "+v"(wpf));
#pragma unroll
        for (int j = 0; j < 4; ++j) {
            const int kk = kk4 + j;
            s16x8 wf[4], yf[4];
#pragma unroll
            for (int nb = 0; nb < 4; ++nb) wf[nb] = wq[j][nb];
            if (kk + 3 < 16) {
#pragma unroll
                for (int nb = 0; nb < 4; ++nb) wq[(j + 3) & 3][nb] = *(const s16x8*)(wpf + nb * 512);
                wpf += 32 * 512; }
#pragma unroll
            for (int mb = 0; mb < 4; ++mb) yf[mb] = *(const LAS s16x8*)(YT + (16 * mb + fr) * YT_PITCH + (32 * kk + 8 * fq) * 2);
#pragma unroll
            for (int mb = 0; mb < 4; ++mb)
#pragma unroll
                for (int nb = 0; nb < 4; ++nb) acc[mb][nb] = __builtin_amdgcn_mfma_f32_16x16x32_bf16(wf[nb], yf[mb], acc[mb][nb], 0, 0, 0);
        }
    }
#pragma unroll
    for (int mb = 0; mb < 4; ++mb) { float q = 0.f;
#pragma unroll
        for (int nb = 0; nb < 4; ++nb) { const int n0 = 64 * wave + 16 * nb + 4 * fq; const f32x4 bv = *(const f32x4*)(bg + n0);
            const v2u yw = *(const LAS v2u*)(YT + (16 * mb + fr) * YT_PITCH + n0 * 2);
            const float y[4] = {bf2f(yw.x & 0xffffu), bf2f(yw.x >> 16), bf2f(yw.y & 0xffffu), bf2f(yw.y >> 16)};
#pragma unroll
            for (int j = 0; j < 4; ++j) { const float o = y[j] * __builtin_amdgcn_rcpf(1.f + __expf(-(acc[mb][nb][j] + bv[j]))); acc[mb][nb][j] = o; q += o * o; } }
        q += __shfl_xor(q, 16); q += __shfl_xor(q, 32);
        if (fq == 0) RED[wave * 64 + 16 * mb + fr] = q; }
    __syncthreads();
#pragma unroll
    for (int mb = 0; mb < 4; ++mb) { const int s = 16 * mb + fr; float tot = 0.f;
#pragma unroll
        for (int w = 0; w < 8; ++w) tot += RED[w * 64 + s];
        const float rstd = 1.f / sqrtf(tot * (1.f / SW) + EPS);
#pragma unroll
        for (int nb = 0; nb < 4; ++nb) { v2u ow; ow.x = pg8::cvt_pk_bf16(acc[mb][nb][0] * rstd, acc[mb][nb][1] * rstd); ow.y = pg8::cvt_pk_bf16(acc[mb][nb][2] * rstd, acc[mb][nb][3] * rstd);
            *(v2u*)(MIX + (t0 + s) * D + AW + 64 * wave + 16 * nb + 4 * fq) = ow; } }
    { v4u w[8];
#pragma unroll
      for (int r = 0; r < 8; ++r) w[r] = *(const v4u*)(MIX + (t0 + wave * 8 + r) * D + 8 * lane);
#pragma unroll
      for (int r = 0; r < 8; ++r) { float f[8]; unpack8(w[r], f); float q = 0.f;
#pragma unroll
          for (int i = 0; i < 8; ++i) q += f[i] * f[i];
          const float rstd = 1.f / sqrtf(wave_sum(q) * (1.f / AW) + EPS);
#pragma unroll
          for (int i = 0; i < 8; ++i) f[i] *= rstd;
          *(v4u*)(MIX + (t0 + wave * 8 + r) * D + 8 * lane) = pack8(f); } }
    __syncthreads();
}

__device__ __forceinline__ void p_fixup(const Args& a, int pm, int tid) {
    const float* HALO = (const float*)(a.ws + WS_HALO); bf16* ACT = (bf16*)(a.ws + WS_ACT); const float* cw = a.in[21]; const float* cb = a.in[22];
    if ((pm & 7) == 0) return;
    const float* hp = HALO + (size_t)(pm - 1) * 4 * 5632; const float* hc = HALO + (size_t)pm * 4 * 5632;
    v2u res[3];
#pragma unroll
    for (int k = 0; k < 3; ++k) {
        const int it = tid + k * NTHR, itc = it < 2 * (DFF / 4) ? it : 0, r = itc / (DFF / 4), ac = (itc % (DFF / 4)) * 4, cg = (ac >> 7) * 256 + (ac & 127), cv = cg + 128;
        const f32x4 g0 = *(const f32x4*)((r ? hp + 5632 : hp) + cg), g1 = *(const f32x4*)((r ? hc + 2 * 5632 : hp + 5632) + cg), g2 = *(const f32x4*)((r ? hc + 3 * 5632 : hc + 2 * 5632) + cg);
        const f32x4 v0 = *(const f32x4*)((r ? hp + 5632 : hp) + cv), v1 = *(const f32x4*)((r ? hc + 2 * 5632 : hp + 5632) + cv), v2 = *(const f32x4*)((r ? hc + 3 * 5632 : hc + 2 * 5632) + cv);
        const f32x4 hg = *(const f32x4*)(cb + ac) + *(const f32x4*)(cw + ac) * g0 + *(const f32x4*)(cw + NUP + ac) * g1 + *(const f32x4*)(cw + 2 * NUP + ac) * g2;
        const f32x4 hv = *(const f32x4*)(cb + DFF + ac) + *(const f32x4*)(cw + DFF + ac) * v0 + *(const f32x4*)(cw + NUP + DFF + ac) * v1 + *(const f32x4*)(cw + 2 * NUP + DFF + ac) * v2;
        float o[4];
#pragma unroll
        for (int i = 0; i < 4; ++i) o[i] = hg[i] * __builtin_amdgcn_rcpf(1.f + __expf(-hg[i])) * hv[i];
        res[k].x = pk2(o[0], o[1]); res[k].y = pk2(o[2], o[3]);
    }
#pragma unroll
    for (int k = 0; k < 3; ++k) { const int it = tid + k * NTHR; if (it < 2 * (DFF / 4)) { const int r = it / (DFF / 4), ac = (it % (DFF / 4)) * 4; *(v2u*)(ACT + (size_t)(pm * 256 + r) * DFF + ac) = res[k]; } }
}

#define XB_TMO      128
#define XB_XCNT(j)  (256  + 64 * (j))
#define XB_XSUB(j)  (1280 + 64 * (j))
#define XB_XGEN(j)  (2304 + 64 * (j))
#define XB_TOP      3328
#define XB_TOPGEN   3392
#define XCD_BAR_WORDS 3456
#define XB_SPIN_CAP (1u << 18)

__device__ __forceinline__ unsigned xb_ld(unsigned* p)              { return __hip_atomic_load(p, __ATOMIC_RELAXED, __HIP_MEMORY_SCOPE_AGENT); }
__device__ __forceinline__ unsigned xb_add(unsigned* p, unsigned v) { return __hip_atomic_fetch_add(p, v, __ATOMIC_RELAXED, __HIP_MEMORY_SCOPE_AGENT); }
__device__ __forceinline__ unsigned xb_xcc_id() { return (unsigned)__builtin_amdgcn_s_getreg((3 << 11) | 20) & 0xFu; }
#define XB_SPIN(cond, bar) do { unsigned _sp = 0; while (cond) { __builtin_amdgcn_s_sleep(1); \
    if ((++_sp & 255u) == 0u) { if (xb_ld(&(bar)[XB_TMO])) break; if (_sp > XB_SPIN_CAP) { atomicAdd(&(bar)[XB_TMO], 1u); break; } } } } while (0)

struct XcdBarrier {
    unsigned* bar; unsigned x;
    volatile LAS unsigned* st;
};

__device__ __forceinline__ XcdBarrier xcd_barrier_post(unsigned* bar, volatile LAS unsigned* st) {
    XcdBarrier b; b.bar = bar; b.x = xb_xcc_id(); b.st = st;
    if (threadIdx.x == 0) (void)xb_add(&bar[XB_XCNT(b.x)], 1u);
    return b;
}
__device__ __forceinline__ void xcd_barrier_complete(unsigned* bar, unsigned x, unsigned& nloc, unsigned& nx) {
    const unsigned G = gridDim.x * gridDim.y * gridDim.z;
    unsigned sum, cnt, mine, sp = 0u;
    for (;;) {
        sum = 0u; cnt = 0u; mine = 0u;
#pragma unroll
        for (unsigned j = 0; j < 16; ++j) { const unsigned c = xb_ld(&bar[XB_XCNT(j)]); sum += c; cnt += (c > 0u) ? 1u : 0u; mine = (j == x) ? c : mine; }
        if (sum == G) break;
        __builtin_amdgcn_s_sleep(1);
        if ((++sp & 255u) == 0u) { if (xb_ld(&bar[XB_TMO])) break; if (sp > XB_SPIN_CAP) { atomicAdd(&bar[XB_TMO], 1u); break; } }
    }
    nloc = mine > 0u ? mine : 1u; nx = cnt > 0u ? cnt : 1u;
}

__device__ __forceinline__ void xcd_barrier(const XcdBarrier& b) {
    asm volatile("s_waitcnt vmcnt(0)" ::: "memory");
    __syncthreads();
    if (threadIdx.x == 0) {
        unsigned* bar = b.bar;
        __builtin_amdgcn_s_waitcnt(0);
        unsigned nloc = b.st[0], nx = b.st[1];
        if (nloc == 0u) { xcd_barrier_complete(bar, b.x, nloc, nx); b.st[0] = nloc; b.st[1] = nx; }
        const unsigned old = xb_add(&bar[XB_XSUB(b.x)], 1u);
        const unsigned gen = old / nloc;
        if (old + 1u == (gen + 1u) * nloc) {
            __builtin_amdgcn_fence(__ATOMIC_RELEASE, "agent");
            asm volatile("s_waitcnt vmcnt(0)" ::: "memory");
            const unsigned og = xb_add(&bar[XB_TOP], 1u);
            const unsigned tg = og / nx;
            if (og + 1u == (tg + 1u) * nx) xb_add(&bar[XB_TOPGEN], 1u);
            else XB_SPIN(xb_ld(&bar[XB_TOPGEN]) == tg, bar);
            __builtin_amdgcn_fence(__ATOMIC_ACQUIRE, "agent");
            xb_add(&bar[XB_XGEN(b.x)], 1u);
            asm volatile("s_waitcnt vmcnt(0)" ::: "memory");
        } else {
            XB_SPIN(xb_ld(&bar[XB_XGEN(b.x)]) == gen, bar);
            __builtin_amdgcn_fence(__ATOMIC_ACQUIRE, "agent");
            asm volatile("s_waitcnt vmcnt(0)" ::: "memory");
        }
    }
    __syncthreads();
}

__global__ void __launch_bounds__(NTHR, 2) fwd_kernel(Args args) {
    extern __shared__ __attribute__((aligned(16))) unsigned char lds_raw[];
    LAS unsigned char* lds = (LAS unsigned char*)lds_raw;
    cg::grid_group grid = cg::this_grid();
    int tid = threadIdx.x, lane = tid & 63; const int wave = __builtin_amdgcn_readfirstlane(tid >> 6);
    const int G = gridDim.x, bx = blockIdx.x, vcu = (G % 8 == 0) ? (bx % 8) * (G / 8) + bx / 8 : bx;
    const int gw = vcu * NWAVES + wave, NGW = G * NWAVES, NT = G * NTHR; int gtid = vcu * NTHR + tid;
    unsigned char* ws = args.ws;
    const int lo = args.ph_lo, hi = args.ph_hi;
    volatile LAS unsigned* MISC = (volatile LAS unsigned*)(lds + LDS_BYTES - 128);
    if (tid < 32) MISC[tid] = 0u;
    __syncthreads();
    XcdBarrier bar; bar.bar = (unsigned*)ws + 4096; bar.x = 0; bar.st = nullptr;
    if (hi - lo > 1) {
        if (bx == 0) for (int i = tid; i < XCD_BAR_WORDS; i += NTHR) ((unsigned*)ws)[4096 + i] = 0u;
        grid.sync();
        bar = xcd_barrier_post((unsigned*)ws + 4096, MISC + 8); }
#define IN(k) (lo <= (k) && (k) < hi)
#define REFRESH() do { int t_ = threadIdx.x; asm volatile("" : "+v"(t_)); tid = t_; lane = tid & 63; gtid = vcu * NTHR + tid; } while (0)
#define SYNC(k) do { if (IN(k) && IN((k) + 1)) xcd_barrier(bar); REFRESH(); } while (0)
    if (IN(0)) { p0_prologue(args, lds, vcu, gw, NGW, tid, wave, lane); } SYNC(0);
    if (IN(1)) {
        if (bx < BATCH * NH && wave == 0) cumsum_bh(args, bx, lane);
        pg8::Gemm g{(const pg8::bf16_t*)(ws + WS_XB), (const pg8::bf16_t*)(ws + WS_WIN), M, 2048, D}; pg8::StaticOrder S; S.init(M, 2048, G, bx);
        pg8::EpiIn E{(const float*)(ws + WS_TAB + TB_RSTD1), args.in[4], args.in[5], (pg8::bf16_t*)(ws + WS_Q), (size_t)M * AW, attn_body::C2};
        pg8::gemm_phase<pg8::EpiIn, pg8::StaticOrder, true, true>(lds, g, S, E);
    } SYNC(1);
    if (IN(2)) {
        { const attn_body::AttnTensors AT{(const attn_body::bf16*)(ws + WS_Q), (const attn_body::bf16*)(ws + WS_K), (const attn_body::bf16*)(ws + WS_V), (attn_body::bf16*)(ws + WS_MIX), (const float*)(ws + WS_TAB + TB_CUM)};
          const attn_body::StaticOrder AS(G, bx); attn_body::attn_phase<attn_body::StaticOrder, 64>((char*)lds_raw, AT, AS); }
        for (int u = bx; u < BATCH * 32; u += G) ssm_a_unit(args, u, wave, lane);
    } SYNC(2);
    if (IN(3)) {
        for (int u = bx; u < BATCH * 32; u += G) ssm_b_unit(args, lds, u, wave, lane);
    } SYNC(3);
    if (IN(4)) {
        pg8::Gemm g{(const pg8::bf16_t*)(ws + WS_MIX), (const pg8::bf16_t*)(ws + WS_WOUT), M, D, D}; pg8::StaticOrder S; S.init(M, D, G, bx);
        pg8::EpiX1 E{args.in[0], args.out, (pg8::bf16_t*)(ws + WS_XB), (float*)(ws + WS_TAB + TB_SSQ2), D};
        pg8::gemm_phase<pg8::EpiX1, pg8::StaticOrder, true, true>(lds, g, S, E);
    } SYNC(4);
    if (IN(5)) {
        pg8::Gemm g{(const pg8::bf16_t*)(ws + WS_XB), (const pg8::bf16_t*)(ws + WS_WUP), M, NUP, D}; pg8::StaticOrder S; S.init(M, NUP, G, bx);
        pg8::EpiUpConv E{(const float*)(ws + WS_TAB + TB_SSQ2), args.in[21], args.in[22], (pg8::bf16_t*)(ws + WS_ACT), (float*)(ws + WS_HALO), (LAS float*)(lds + RING_BYTES)};
        pg8::gemm_phase<pg8::EpiUpConv, pg8::StaticOrder, true, true>(lds, g, S, E);
    } SYNC(5);
    if (IN(6)) {
        pg8::Gemm g{(const pg8::bf16_t*)(ws + WS_ACT), (const pg8::bf16_t*)(ws + WS_WDN), M, D, DFF}; pg8::StaticOrder S; S.init(M, D, G, bx);
        { pg8::Unit u0; for (int i = 0; S.next(i, u0); ++i) p_fixup(args, u0.pm, tid); asm volatile("s_waitcnt vmcnt(0)" ::: "memory"); __syncthreads(); }
        pg8::EpiResB E{(const pg8::bf16_t*)(ws + WS_XB), args.out, D};
        pg8::gemm_phase<pg8::EpiResB, pg8::StaticOrder, true, true>(lds, g, S, E);
    }
#undef IN
#undef SYNC
}

constexpr int N_PHASES = 7;
#ifndef MK_MULTI
#define MK_MULTI 0
#endif
extern "C" void kernel_launch(void* const* d_in, const int* in_sizes, int n_in, void* d_out, int out_size, void* d_ws, size_t ws_size, hipStream_t stream) {
    static int grid = 0;
    if (grid == 0) {
        if (n_in != 24 || out_size != M * D || ws_size < WS_END) { fprintf(stderr, "kernel_launch: unexpected sizes n_in %d out %d ws %zu\n", n_in, out_size, ws_size); grid = -1; return; }
        int dev = 0, cus = 0, per_cu = 0;
        hipGetDevice(&dev); hipDeviceGetAttribute(&cus, hipDeviceAttributeMultiprocessorCount, dev);
        hipFuncSetAttribute((const void*)fwd_kernel, hipFuncAttributeMaxDynamicSharedMemorySize, LDS_BYTES);
        hipOccupancyMaxActiveBlocksPerMultiprocessor(&per_cu, (const void*)fwd_kernel, NTHR, LDS_BYTES);
        (void)hipGetLastError();
        if (per_cu < 1) { fprintf(stderr, "kernel_launch: occupancy query says %d blocks per CU\n", per_cu); per_cu = 1; }
        grid = cus * 1;
        fprintf(stderr, "kernel_launch: cus %d per_cu %d grid %d\n", cus, per_cu, grid);
    }
    if (grid < 0) return;
    Args a{};
    for (int i = 0; i < 24; ++i) a.in[i] = (const float*)d_in[i];
    a.out = (float*)d_out; a.ws = (unsigned char*)d_ws;
#if MK_MULTI
    for (int p = 0; p < N_PHASES; ++p) { a.ph_lo = p; a.ph_hi = p + 1; hipLaunchKernelGGL(fwd_kernel, dim3(grid), dim3(NTHR), LDS_BYTES, stream, a); }
#else
    a.ph_lo = 0; a.ph_hi = N_PHASES;
    void* kargs[] = {&a};
    hipError_t e = hipLaunchCooperativeKernel((const void*)fwd_kernel, dim3(grid), dim3(NTHR), kargs, LDS_BYTES, stream);
    if (e != hipSuccess) fprintf(stderr, "cooperative launch failed: %s (grid %d)\n", hipGetErrorString(e), grid);
#endif
}
```

```cpp
#include <hip/hip_runtime.h>
#include <hip/hip_cooperative_groups.h>
#include <cstdio>
#include <cstdint>
namespace cg = cooperative_groups;
namespace pg8 {
#define PG8_LAS __attribute__((address_space(3)))
typedef unsigned short bf16_t;
typedef short bf16x8 __attribute__((ext_vector_type(8)));
typedef float f32x4 __attribute__((ext_vector_type(4)));
typedef unsigned u32x4 __attribute__((ext_vector_type(4)));
constexpr int BM = 256, BK = 64, HALF = 128, HTB = HALF * BK * 2  , STAGE_BYTES = 8 * HTB, NXCD = 8, WGM = 8;

__host__ __device__ __forceinline__ int lds_byte(int r, int c) { const int st = (r >> 4) * 2 + (c >> 5), rr = r & 15, cc = c & 31, ob = rr * 64 + cc * 2; return st * 1024 + (ob ^ (((ob >> 9) & 1) << 5)); }
__host__ __device__ __forceinline__ void stage_rc(int b, int& R, int& C) { const int st = b / 1024, sb = b % 1024, swz = sb ^ (((sb >> 9) & 1) << 5); R = (st >> 1) * 16 + swz / 64; C = (st & 1) * 32 + (swz % 64) / 2; }
__host__ __device__ __forceinline__ int perm32(int rho) { const int n = rho >> 4, i = rho & 15; return 8 * (i >> 2) + 4 * n + (i & 3); }

struct Unit { int pm, pn; };
struct Gemm { const bf16_t* A; const bf16_t* Bt; int M, N, K; };

struct StaticOrder {
    int nM, nN, nwg, G, c;
    __host__ __device__ void init(int M, int N, int G_, int c_) { nM = M / BM; nN = N / BM; nwg = nM * nN; G = G_; c = c_; }
    __host__ __device__ bool next(int i, Unit& u) const {
        const long L = (long)i * G + c; if (L >= nwg) return false;
        int wgid = (int)L; { const int q = nwg / NXCD, r = nwg % NXCD, xcd = wgid % NXCD, off = wgid / NXCD; wgid = (xcd < r ? xcd * (q + 1) : r * (q + 1) + (xcd - r) * q) + off; }
        const int nig = WGM * nN, gid = wgid / nig, fm = gid * WGM, gsz = (nM - fm) < WGM ? (nM - fm) : WGM;
        u.pm = fm + ((wgid % nig) % gsz); u.pn = (wgid % nig) / gsz; return true;
    }
    __device__ __forceinline__ void a_ready(const Unit&) const {}
    __device__ __forceinline__ void done(const Unit&) const {}
};

__device__ __forceinline__ unsigned cvt_pk_bf16(float lo, float hi) { unsigned r; asm volatile("v_cvt_pk_bf16_f32 %0, %1, %2" : "=v"(r) : "v"(lo), "v"(hi)); return r; }
typedef float f32x2 __attribute__((ext_vector_type(2)));
__device__ __forceinline__ f32x2 gelu_pk(f32x2 v) {
    const f32x2 av = __builtin_elementwise_abs(v), d = av * 0.2316418882f + 1.0f;
    f32x2 t; t.x = __builtin_amdgcn_rcpf(d.x); t.y = __builtin_amdgcn_rcpf(d.y);
    f32x2 q = t * 0.5307027145f + (-0.7265760135f); q = q * t + 0.7107068705f; q = q * t + (-0.142248368f); q = q * t + 0.127414796f; q = q * t;
    const f32x2 s = (v * v) * (-0.72134752044f);
    f32x2 e; e.x = __builtin_amdgcn_exp2f(s.x); e.y = __builtin_amdgcn_exp2f(s.y);
    const f32x2 m = v * (q * e), r = v - m;
    f32x2 o; o.x = v.x < 0.f ? m.x : r.x; o.y = v.y < 0.f ? m.y : r.y; return o;
}

template <int ACT  > struct EpiBf16 {
    static constexpr bool PERM = true, AFTER_DRAIN = false; static_assert(ACT == 0 || ACT == 1, "EpiBf16: ACT is 0 (none) or 1 (gelu_pk)");
    bf16_t* O; int ldc; const float* bias; int split_cols; size_t split_stride; float scale0;
    __device__ __forceinline__ void operator()(const f32x4 (&acc)[2][2][4][2], const Unit& u, int wr, int wc, int fr, int fq) const {
        const int row0 = u.pm * BM + wr * 64 + fr; int colt = u.pn * BM; bf16_t* base = O;
        float sc = 1.f; if (split_cols) { const int t = colt / split_cols; base += (size_t)t * split_stride; colt -= t * split_cols; if (t == 0) sc = scale0; }
        const int col0 = colt + wc * 32 + 8 * fq, bcol0 = u.pn * BM + wc * 32 + 8 * fq;
        f32x4 bv[2][2];
#pragma unroll
        for (int bj = 0; bj < 2; ++bj)
#pragma unroll
            for (int n = 0; n < 2; ++n) bv[bj][n] = bias ? *(const f32x4*)(bias + bcol0 + bj * HALF + 4 * n) : (f32x4){0.f, 0.f, 0.f, 0.f};
#pragma unroll
        for (int ai = 0; ai < 2; ++ai)
#pragma unroll
            for (int m = 0; m < 4; ++m) { bf16_t* rowp = base + (size_t)(row0 + ai * HALF + m * 16) * ldc + col0;
#pragma unroll
                for (int bj = 0; bj < 2; ++bj) { f32x4 v0 = acc[ai][bj][m][0] + bv[bj][0], v1 = acc[ai][bj][m][1] + bv[bj][1];
                    if (ACT == 1) { f32x2 a = gelu_pk((f32x2){v0[0], v0[1]}), b = gelu_pk((f32x2){v0[2], v0[3]}), c = gelu_pk((f32x2){v1[0], v1[1]}), d = gelu_pk((f32x2){v1[2], v1[3]});
                        v0 = (f32x4){a.x, a.y, b.x, b.y}; v1 = (f32x4){c.x, c.y, d.x, d.y}; }
                    v0 = v0 * sc; v1 = v1 * sc; u32x4 w; w.x = cvt_pk_bf16(v0[0], v0[1]); w.y = cvt_pk_bf16(v0[2], v0[3]); w.z = cvt_pk_bf16(v1[0], v1[1]); w.w = cvt_pk_bf16(v1[2], v1[3]);
                    *(u32x4*)(rowp + bj * HALF) = w; } }
    }
};

struct PanelStats {
    unsigned* xbuf;
    unsigned* cnt;
    unsigned* tmo;
    int ntn; float eps;
    unsigned code;
    __device__ __forceinline__ bool run(const f32x4 (&v)[2][2][4][2], const Unit& u, int wr, int wc, int fr, int fq, PG8_LAS unsigned char* lds, int wid, int lane) const {
        typedef float f32x2v __attribute__((ext_vector_type(2)));
        PG8_LAS f32x2v* P = (PG8_LAS f32x2v*)lds;
        PG8_LAS f32x2v* S = (PG8_LAS f32x2v*)(lds + 8192);
        PG8_LAS unsigned* flag = (PG8_LAS unsigned*)(lds + 8192 + 2048);
#pragma unroll
        for (int ai = 0; ai < 2; ++ai)
#pragma unroll
            for (int m = 0; m < 4; ++m) {
                float s = 0.f;
#pragma unroll
                for (int bj = 0; bj < 2; ++bj)
#pragma unroll
                    for (int n = 0; n < 2; ++n) { const f32x4 x = v[ai][bj][m][n]; s += (x[0] + x[1]) + (x[2] + x[3]); }
                s += __shfl_xor(s, 16); s += __shfl_xor(s, 32);
                const float mw = s * (1.0f / 64.0f); float q = 0.f;
#pragma unroll
                for (int bj = 0; bj < 2; ++bj)
#pragma unroll
                    for (int n = 0; n < 2; ++n) { const f32x4 d = v[ai][bj][m][n] - mw; q += (d[0] * d[0] + d[1] * d[1]) + (d[2] * d[2] + d[3] * d[3]); }
                q += __shfl_xor(q, 16); q += __shfl_xor(q, 32);
                if (fq == 0) P[(ai * HALF + wr * 64 + m * 16 + fr) * 4 + wc] = (f32x2v){mw, q};
            }
        asm volatile("s_waitcnt lgkmcnt(0)" ::: "memory"); __builtin_amdgcn_s_barrier(); asm volatile("" ::: "memory");
#if defined(BROKEN_EXCHANGE_NO_WAIT)
#warning BROKEN CONTROL BUILD: the row-statistics exchange does not wait; results are wrong by design
        if (blockIdx.x >= 64) { const long long t0_ = clock64(); while (clock64() - t0_ < 60000) __builtin_amdgcn_s_sleep(8); }
#endif
        const int row = wid * 32 + (lane & 31);
        if (lane < 32) {
            const f32x2v a = P[row * 4 + 0], b = P[row * 4 + 1], c = P[row * 4 + 2], d = P[row * 4 + 3];
            const float mt = (a.x + b.x + c.x + d.x) * 0.25f;
            const float da = a.x - mt, db = b.x - mt, dc = c.x - mt, dd = d.x - mt;
            const float m2 = (a.y + b.y) + (c.y + d.y) + 64.0f * ((da * da + db * db) + (dc * dc + dd * dd));
            unsigned long long* slot = (unsigned long long*)xbuf + ((size_t)(u.pm * BM + row) * 4 + u.pn);
            __hip_atomic_store(slot, ((unsigned long long)__float_as_uint(m2) << 32) | __float_as_uint(mt), __ATOMIC_RELAXED, __HIP_MEMORY_SCOPE_AGENT);
        }
        asm volatile("s_waitcnt vmcnt(0)" ::: "memory");
        if (lane == 0) __hip_atomic_fetch_add(cnt + 64 * u.pm, 1u, __ATOMIC_RELAXED, __HIP_MEMORY_SCOPE_AGENT);
        if (wid == 0) {
            bool dead = false; const unsigned long long t0 = __builtin_amdgcn_s_memrealtime(); const unsigned want = 8u * (unsigned)ntn;
            for (;;) {
#if defined(BROKEN_EXCHANGE_NO_WAIT)
                break;
#endif
                if ((unsigned)__builtin_amdgcn_readfirstlane(__hip_atomic_load(cnt + 64 * u.pm, __ATOMIC_RELAXED, __HIP_MEMORY_SCOPE_AGENT)) >= want) break;
                if (__builtin_amdgcn_s_memrealtime() - t0 > 2000000ull) {
                    if (lane == 0) { unsigned expect = 0u; __hip_atomic_compare_exchange_strong(tmo + 1, &expect, code | (unsigned)(u.pm & 0xff), __ATOMIC_RELAXED, __ATOMIC_RELAXED, __HIP_MEMORY_SCOPE_AGENT);
                                     __hip_atomic_store(tmo, 1u, __ATOMIC_RELAXED, __HIP_MEMORY_SCOPE_AGENT); }
                    dead = true; break; }
                __builtin_amdgcn_s_sleep(2);
            }
            __builtin_amdgcn_fence(__ATOMIC_ACQUIRE, "agent");
            if (lane == 0) flag[0] = dead ? 1u : 0u;
        }
        asm volatile("s_waitcnt vmcnt(0) lgkmcnt(0)" ::: "memory"); __builtin_amdgcn_s_barrier(); asm volatile("" ::: "memory");
        const bool bad = flag[0] != 0u;
        if (lane < 32) {
            const unsigned long long* slot = (const unsigned long long*)xbuf + (size_t)(u.pm * BM + row) * 4; float mt[4], m2[4]; float ms = 0.f;
#pragma unroll
            for (int t = 0; t < 4; ++t) { if (t < ntn) { const unsigned long long w = __hip_atomic_load(slot + t, __ATOMIC_RELAXED, __HIP_MEMORY_SCOPE_AGENT); mt[t] = __uint_as_float((unsigned)w); m2[t] = __uint_as_float((unsigned)(w >> 32)); } else { mt[t] = 0.f; m2[t] = 0.f; } ms += mt[t]; }
            const float mean = ms / (float)ntn; float q = 0.f;
#pragma unroll
            for (int t = 0; t < 4; ++t) if (t < ntn) { const float dm = mt[t] - mean; q += m2[t] + 256.0f * dm * dm; }
            S[row] = (f32x2v){mean, 1.0f / sqrtf(q / (256.0f * (float)ntn) + eps)};
        }
        asm volatile("s_waitcnt lgkmcnt(0)" ::: "memory"); __builtin_amdgcn_s_barrier(); asm volatile("" ::: "memory");
        return bad;
    }
};
struct EpiLnRes {
    static constexpr bool PERM = false, AFTER_DRAIN = true;
    const float* base; float* out; int ldc; const float* bias; PanelStats st; unsigned poison;
    __device__ __forceinline__ void fused(f32x4 (&acc)[2][2][4][2], const Unit& u, int wr, int wc, int fr, int fq, PG8_LAS unsigned char* lds, int wid, int lane) const {
        typedef float f32x2v __attribute__((ext_vector_type(2)));
        const PG8_LAS f32x2v* S = (const PG8_LAS f32x2v*)(lds + 8192);
        const int col0 = u.pn * BM + wc * 32 + 4 * fq;
#pragma unroll
        for (int bj = 0; bj < 2; ++bj)
#pragma unroll
            for (int n = 0; n < 2; ++n) { const f32x4 bv = bias ? *(const f32x4*)(bias + col0 + bj * HALF + n * 16) : (f32x4){0.f, 0.f, 0.f, 0.f};
#pragma unroll
                for (int ai = 0; ai < 2; ++ai)
#pragma unroll
                    for (int m = 0; m < 4; ++m) acc[ai][bj][m][n] += bv; }
        f32x4 pre[4][2][2];
#pragma unroll
        for (int m = 0; m < 4; ++m) { const size_t off = (size_t)(u.pm * BM + wr * 64 + m * 16 + fr) * ldc + col0;
#pragma unroll
            for (int bj = 0; bj < 2; ++bj)
#pragma unroll
                for (int n = 0; n < 2; ++n) pre[m][bj][n] = *(const f32x4*)(base + off + bj * HALF + n * 16); }
        const bool bad = st.run(acc, u, wr, wc, fr, fq, lds, wid, lane) || poison != 0u;
        const float qnan = __builtin_nanf("");
#pragma unroll
        for (int ai = 0; ai < 2; ++ai)
#pragma unroll
            for (int m = 0; m < 4; ++m) { const int r = ai * HALF + wr * 64 + m * 16 + fr; const f32x2v sr = S[r]; const size_t off = (size_t)(u.pm * BM + r) * ldc + col0;
#pragma unroll
                for (int bj = 0; bj < 2; ++bj)
#pragma unroll
                    for (int n = 0; n < 2; ++n) { const f32x4 bs = ai == 0 ? pre[m][bj][n] : *(const f32x4*)(base + off + bj * HALF + n * 16); f32x4 o = bs + (acc[ai][bj][m][n] - sr.x) * sr.y;
                        if (bad) o = (f32x4){qnan, qnan, qnan, qnan}; *(f32x4*)(out + off + bj * HALF + n * 16) = o; }
                if (m & 1) asm volatile("" ::: "memory"); }
    }
};
struct EpiLnResLn {
    static constexpr bool PERM = false, AFTER_DRAIN = true;
    const float* base; float* out; bf16_t* xn; int ldc; const float* bias; PanelStats st1, st2; unsigned poison;
    __device__ __forceinline__ void fused(f32x4 (&acc)[2][2][4][2], const Unit& u, int wr, int wc, int fr, int fq, PG8_LAS unsigned char* lds, int wid, int lane) const {
        typedef float f32x2v __attribute__((ext_vector_type(2))); typedef unsigned u32x2v __attribute__((ext_vector_type(2)));
        const PG8_LAS f32x2v* S = (const PG8_LAS f32x2v*)(lds + 8192);
        const int col0 = u.pn * BM + wc * 32 + 4 * fq;
#pragma unroll
        for (int bj = 0; bj < 2; ++bj)
#pragma unroll
            for (int n = 0; n < 2; ++n) { const f32x4 bv = bias ? *(const f32x4*)(bias + col0 + bj * HALF + n * 16) : (f32x4){0.f, 0.f, 0.f, 0.f};
#pragma unroll
                for (int ai = 0; ai < 2; ++ai)
#pragma unroll
                    for (int m = 0; m < 4; ++m) acc[ai][bj][m][n] += bv; }
        bool bad = st1.run(acc, u, wr, wc, fr, fq, lds, wid, lane) || poison != 0u;
        const float qnan = __builtin_nanf("");
#pragma unroll
        for (int ai = 0; ai < 2; ++ai)
#pragma unroll
            for (int m = 0; m < 4; ++m) { const int r = ai * HALF + wr * 64 + m * 16 + fr; const f32x2v sr = S[r]; const size_t off = (size_t)(u.pm * BM + r) * ldc + col0;
#pragma unroll
                for (int bj = 0; bj < 2; ++bj)
#pragma unroll
                    for (int n = 0; n < 2; ++n) { const f32x4 bs = *(const f32x4*)(base + off + bj * HALF + n * 16); acc[ai][bj][m][n] = bs + (acc[ai][bj][m][n] - sr.x) * sr.y; }
                asm volatile("" : "+v"(acc[ai][0][m][0]), "+v"(acc[ai][0][m][1]), "+v"(acc[ai][1][m][0]), "+v"(acc[ai][1][m][1]));
                if (m & 1) asm volatile("" ::: "memory"); }
        const bool bad1 = bad;
        bad = st2.run(acc, u, wr, wc, fr, fq, lds, wid, lane) || bad;
#pragma unroll
        for (int ai = 0; ai < 2; ++ai)
#pragma unroll
            for (int m = 0; m < 4; ++m) { const int r = ai * HALF + wr * 64 + m * 16 + fr; const f32x2v sr = S[r]; const size_t off = (size_t)(u.pm * BM + r) * ldc + col0;
#pragma unroll
                for (int bj = 0; bj < 2; ++bj)
#pragma unroll
                    for (int n = 0; n < 2; ++n) { const f32x4 x1 = acc[ai][bj][m][n]; *(f32x4*)(out + off + bj * HALF + n * 16) = bad1 ? (f32x4){qnan, qnan, qnan, qnan} : x1;
                        const f32x4 o = (x1 - sr.x) * sr.y; u32x2v w; w.x = cvt_pk_bf16(o[0], o[1]); w.y = cvt_pk_bf16(o[2], o[3]);
                        if (bad) { w.x = 0x7fc07fc0u; w.y = 0x7fc07fc0u; } *(u32x2v*)(xn + off + bj * HALF + n * 16) = w; }
                asm volatile("" ::: "memory"); }
    }
};

template <class Epi, class Sched, bool ALIGN_EPI = false, bool SP2 = false>
__device__ __forceinline__ void gemm_phase(PG8_LAS unsigned char* lds, const Gemm g, const Sched& S, const Epi& E) {
    int tid_ = threadIdx.x; asm volatile("" : "+v"(tid_));
    const int tid = tid_, wid = __builtin_amdgcn_readfirstlane(tid >> 6), lane = tid & 63, wr = wid >> 2, wc = wid & 3, fr = lane & 15, fq = lane >> 4;
    const int K = g.K, nt = K / BK;
    unsigned voffA[2], voffB[2];
#pragma unroll
    for (int i = 0; i < 2; ++i) { int R, C; stage_rc(tid * 16 + i * 8192, R, C); const int Rb = Epi::PERM ? ((R & ~31) + perm32(R & 31)) : R;
        voffA[i] = (unsigned)(R * K + C) * 2u; voffB[i] = (unsigned)(Rb * K + C) * 2u; }
    const size_t kstep = (size_t)(BK * 2);
    const size_t hstep = (size_t)HALF * K * 2;
    const size_t tstep = 2 * hstep;
    const unsigned ldsw = (unsigned)wid * 1024u;
    const int aoff = lds_byte(wr * 64 + fr, fq * 8), boff = lds_byte(wc * 32 + fr, fq * 8);
#define PG8_SA(b, h) (((b) * 2 + (h)) * HTB)
#define PG8_SB(b, h) ((4 + (b) * 2 + (h)) * HTB)
#define PG8_STAGE(bufoff, gbase, voff) do { _Pragma("unroll") for (int _i = 0; _i < 2; ++_i) \
        __builtin_amdgcn_global_load_lds((const unsigned*)((const char*)(gbase) + (voff)[_i]), (PG8_LAS unsigned*)(lds + (bufoff) + ldsw + _i * 8192), 16, 0, 0); } while (0)
#define PG8_LDA(dst, b, h) do { _Pragma("unroll") for (int m = 0; m < 4; ++m) _Pragma("unroll") for (int k = 0; k < 2; ++k) dst[m][k] = *(const PG8_LAS bf16x8*)(lds + PG8_SA(b, h) + aoff + m * 2048 + k * 1024); } while (0)
#define PG8_LDB(dst, b, h) do { _Pragma("unroll") for (int n = 0; n < 2; ++n) _Pragma("unroll") for (int k = 0; k < 2; ++k) dst[n][k] = *(const PG8_LAS bf16x8*)(lds + PG8_SB(b, h) + boff + n * 2048 + k * 1024); } while (0)
#define PG8_MMA(ai, bj, At, Bt) do { __builtin_amdgcn_s_setprio(1); _Pragma("unroll") for (int m = 0; m < 4; ++m) _Pragma("unroll") for (int n = 0; n < 2; ++n) _Pragma("unroll") for (int k = 0; k < 2; ++k) \
        acc[ai][bj][m][n] = __builtin_amdgcn_mfma_f32_16x16x32_bf16(Bt[n][k], At[m][k], acc[ai][bj][m][n], 0, 0, 0); __builtin_amdgcn_s_setprio(0); } while (0)
#define PG8_WAIT_V(n) asm volatile("s_waitcnt vmcnt(" #n ")" ::: "memory")
#define PG8_WAIT_L(n) asm volatile("s_waitcnt lgkmcnt(" #n ")" ::: "memory")
#define PG8_BAR __builtin_amdgcn_s_barrier()
#define PG8_SCHED __builtin_amdgcn_sched_barrier(0)
    Unit cur, nxt; int ui = 0;
    if (!S.next(0, cur)) return;
    f32x4 acc[2][2][4][2];
#pragma unroll
    for (int a = 0; a < 2; ++a)
#pragma unroll
        for (int b = 0; b < 2; ++b)
#pragma unroll
            for (int m = 0; m < 4; ++m)
#pragma unroll
                for (int n = 0; n < 2; ++n) acc[a][b][m][n] = (f32x4){0.f, 0.f, 0.f, 0.f};
    bf16x8 At[4][2], B0[2][2], B1[2][2];
    const char* cA = (const char*)g.A + (size_t)cur.pm * tstep; const char* cB = (const char*)g.Bt + (size_t)cur.pn * tstep;
    S.a_ready(cur);
    if constexpr (SP2) {
        PG8_STAGE(PG8_SB(0, 0), cB, voffB); PG8_STAGE(PG8_SB(0, 1), cB + hstep, voffB); PG8_STAGE(PG8_SA(0, 0), cA, voffA); PG8_STAGE(PG8_SA(0, 1), cA + hstep, voffA);
        if (wr == 1) PG8_BAR;
        PG8_WAIT_V(2); PG8_BAR;
        PG8_STAGE(PG8_SB(1, 0), cB + kstep, voffB); PG8_STAGE(PG8_SA(1, 0), cA + kstep, voffA); PG8_STAGE(PG8_SB(1, 1), cB + hstep + kstep, voffB);
        PG8_WAIT_V(6); PG8_BAR;
    } else {
        PG8_STAGE(PG8_SB(0, 0), cB, voffB); PG8_STAGE(PG8_SA(0, 0), cA, voffA); PG8_STAGE(PG8_SB(0, 1), cB + hstep, voffB); PG8_STAGE(PG8_SA(0, 1), cA + hstep, voffA);
        if (wr == 1) PG8_BAR;
        PG8_WAIT_V(4); PG8_BAR;
        PG8_STAGE(PG8_SB(1, 0), cB + kstep, voffB); PG8_STAGE(PG8_SA(1, 0), cA + kstep, voffA); PG8_STAGE(PG8_SB(1, 1), cB + hstep + kstep, voffB);
        PG8_WAIT_V(6); PG8_BAR;
    }
    for (;;) {
        const bool has_next = S.next(ui + 1, nxt);
        const char* nA = has_next ? (const char*)g.A + (size_t)nxt.pm * tstep : cA; const char* nB = has_next ? (const char*)g.Bt + (size_t)nxt.pn * tstep : cB;
        for (int t = 0; t < nt; t += 2) {
            const bool last = (t == nt - 2);
            const char* a1 = cA + (size_t)(t + 1) * kstep;
            const char* a2 = last ? nA : cA + (size_t)(t + 2) * kstep; const char* b2 = last ? nB : cB + (size_t)(t + 2) * kstep;
            const char* a3 = a2 + kstep; const char* b3 = b2 + kstep;
            if (last && has_next) S.a_ready(nxt);
            if constexpr (SP2) {
            PG8_LDB(B0, 0, 0); PG8_LDB(B1, 0, 1); PG8_SCHED; PG8_LDA(At, 0, 0); PG8_STAGE(PG8_SA(1, 1), a1 + hstep, voffA);
            PG8_WAIT_V(8); PG8_WAIT_L(0); PG8_BAR; PG8_MMA(0, 0, At, B0); PG8_MMA(0, 1, At, B1); PG8_BAR; PG8_SCHED;
            PG8_LDA(At, 0, 1); PG8_STAGE(PG8_SB(0, 0), b2, voffB); PG8_STAGE(PG8_SB(0, 1), b2 + hstep, voffB); PG8_STAGE(PG8_SA(0, 0), a2, voffA);
            PG8_WAIT_V(8); PG8_WAIT_L(0); PG8_BAR; PG8_MMA(1, 0, At, B0); PG8_MMA(1, 1, At, B1); PG8_BAR; PG8_SCHED;
            PG8_LDB(B0, 1, 0); PG8_LDB(B1, 1, 1); PG8_SCHED; PG8_LDA(At, 1, 0); PG8_STAGE(PG8_SA(0, 1), a2 + hstep, voffA);
            PG8_WAIT_V(8); PG8_WAIT_L(0); PG8_BAR; PG8_MMA(0, 0, At, B0); PG8_MMA(0, 1, At, B1); PG8_BAR; PG8_SCHED;
            PG8_LDA(At, 1, 1); PG8_STAGE(PG8_SB(1, 0), b3, voffB); PG8_STAGE(PG8_SB(1, 1), b3 + hstep, voffB); PG8_STAGE(PG8_SA(1, 0), a3, voffA);
            PG8_WAIT_V(8); PG8_WAIT_L(0); PG8_BAR; PG8_MMA(1, 0, At, B0); PG8_MMA(1, 1, At, B1); PG8_BAR; PG8_SCHED;
            } else {
            PG8_LDB(B0, 0, 0); PG8_SCHED; PG8_LDA(At, 0, 0); PG8_STAGE(PG8_SA(1, 1), a1 + hstep, voffA);
            PG8_WAIT_L(8); PG8_BAR; PG8_WAIT_L(0); PG8_MMA(0, 0, At, B0); PG8_BAR; PG8_SCHED;
            PG8_LDB(B1, 0, 1); PG8_STAGE(PG8_SB(0, 0), b2, voffB);
            PG8_BAR; PG8_WAIT_L(0); PG8_MMA(0, 1, At, B1); PG8_BAR;
            PG8_LDA(At, 0, 1); PG8_STAGE(PG8_SA(0, 0), a2, voffA);
            PG8_BAR; PG8_WAIT_L(0); PG8_MMA(1, 0, At, B0); PG8_BAR; PG8_SCHED;
            PG8_STAGE(PG8_SB(0, 1), b2 + hstep, voffB);
            PG8_WAIT_V(6); PG8_BAR; PG8_MMA(1, 1, At, B1); PG8_BAR;
            PG8_LDB(B0, 1, 0); PG8_SCHED; PG8_LDA(At, 1, 0); PG8_STAGE(PG8_SA(0, 1), a2 + hstep, voffA);
            PG8_WAIT_L(8); PG8_BAR; PG8_WAIT_L(0); PG8_MMA(0, 0, At, B0); PG8_BAR; PG8_SCHED;
            PG8_LDB(B1, 1, 1); PG8_STAGE(PG8_SB(1, 0), b3, voffB);
            PG8_BAR; PG8_WAIT_L(0); PG8_MMA(0, 1, At, B1); PG8_BAR;
            PG8_LDA(At, 1, 1); PG8_STAGE(PG8_SA(1, 0), a3, voffA);
            PG8_BAR; PG8_WAIT_L(0); PG8_MMA(1, 0, At, B0); PG8_BAR; PG8_SCHED;
            PG8_STAGE(PG8_SB(1, 1), b3 + hstep, voffB);
            PG8_WAIT_V(6); PG8_BAR; PG8_MMA(1, 1, At, B1); PG8_BAR;
            }
        }
        if constexpr (ALIGN_EPI) { if (wr == 0) PG8_BAR; }
        if constexpr (!Epi::AFTER_DRAIN) { E(acc, cur, wr, wc, fr, fq); S.done(cur); }
        if (!has_next) break;
#pragma unroll
        for (int a = 0; a < 2; ++a)
#pragma unroll
            for (int b = 0; b < 2; ++b)
#pragma unroll
                for (int m = 0; m < 4; ++m)
#pragma unroll
                    for (int n = 0; n < 2; ++n) acc[a][b][m][n] = (f32x4){0.f, 0.f, 0.f, 0.f};
        cur = nxt; cA = nA; cB = nB; ++ui;
        if constexpr (ALIGN_EPI) { if (wr == 1) PG8_BAR; }
    }
    PG8_WAIT_V(0);
    if constexpr (!ALIGN_EPI) { if (wr == 0) PG8_BAR; }
    PG8_BAR;
    if constexpr (Epi::AFTER_DRAIN) { E.fused(acc, cur, wr, wc, fr, fq, lds, wid, lane); S.done(cur); }
#undef PG8_SA
#undef PG8_SB
#undef PG8_STAGE
#undef PG8_LDA
#undef PG8_LDB
#undef PG8_MMA
#undef PG8_WAIT_V
#undef PG8_WAIT_L
#undef PG8_BAR
#undef PG8_SCHED
}
}
#include <hip/hip_bf16.h>
#include <cmath>
namespace attn_body {
using bf16=__hip_bfloat16;
using bf16x8=__attribute__((ext_vector_type(8)))short;
using s16x4=__attribute__((ext_vector_type(4)))short;
using f32x16=__attribute__((ext_vector_type(16)))float;
using u32x4=__attribute__((ext_vector_type(4)))unsigned;
constexpr int BATCH=8,NHEAD=8,SEQ=2048,D=64,DM=NHEAD*D,OP=1024,CLS_OFF=86016;
constexpr int NW=8,QBLK=32,QB=QBLK*NW,KVBLK=64,NQB=SEQ/QB;
constexpr int ATTN_PITCH=DM, ATTN_UNIT_ROWS=QB;
__device__ __forceinline__ int crow(int r,int hi){return (r&3)+8*(r>>2)+4*hi;}
#define SBAR() __builtin_amdgcn_sched_barrier(0)
__device__ __forceinline__ void cmask(f32x16&p0,f32x16&p1,int jb,int qrel,int hi){
  const float NEG=-INFINITY; int kb=64*jb+4*hi;
  #pragma unroll
  for(int r=0;r<16;++r){int kv=kb+(r&3)+8*(r>>2); if(kv>qrel)p0[r]=NEG; if(kv+32>qrel)p1[r]=NEG;}
}

constexpr int NSLOT=3, SLOTB=8192;
constexpr int LDS_K=0, LDS_V=NSLOT*SLOTB, LDS_WS=2*NSLOT*SLOTB, LDS_OST=LDS_WS+NW*64*4, LDS_BYTES=LDS_OST+NW*4096;
constexpr float C2=0.125f*1.4426950408889634f;
__device__ __forceinline__ void glds16(const void*gsrc,unsigned lds_dst){unsigned keep;
  asm volatile("s_mov_b32 %0, m0\n\ts_mov_b32 m0, %2\n\ts_nop 0\n\tglobal_load_lds_dwordx4 %1, off\n\ts_mov_b32 m0, %0":"=&s"(keep):"v"(gsrc),"s"(lds_dst):"memory");}
__device__ __forceinline__ float max3f(float a,float b,float c){float r;asm("v_max3_f32 %0, %1, %2, %3":"=v"(r):"v"(a),"v"(b),"v"(c));return r;}
__device__ __forceinline__ float max2f(float a,float b){float r;asm("v_max_f32_e32 %0, %1, %2":"=v"(r):"v"(a),"v"(b));return r;}
__device__ __forceinline__ float fadd_s(float a,float b){float r;asm("v_add_f32_e32 %0, %1, %2":"=v"(r):"v"(a),"v"(b));return r;}
__device__ __forceinline__ float fsub_s(float a,float b){float r;asm("v_sub_f32_e32 %0, %1, %2":"=v"(r):"v"(a),"v"(b));return r;}
typedef float f32x4_t __attribute__((ext_vector_type(4))); typedef float f32x2_t __attribute__((ext_vector_type(2))); typedef __bf16 bf16x2_t __attribute__((ext_vector_type(2)));
__device__ __forceinline__ unsigned cvtpk_s(float lo,float hi){f32x2_t v={lo,hi};bf16x2_t b=__builtin_convertvector(v,bf16x2_t);return __builtin_bit_cast(unsigned,b);}
#define WAIT_BAR(N) asm volatile("s_waitcnt vmcnt(" #N ") lgkmcnt(0)\n\ts_barrier":::"memory")

__device__ __forceinline__ void qkt(f32x16&p0,f32x16&p1,const char*Kslot,const bf16x8*qr,int r32,int hi){ const f32x16 negm=f32x16{};
  const char*kb=Kslot+hi*1024+r32*16;
  #pragma unroll
  for(int d0=0;d0<4;++d0){
    const bf16x8 b0=*reinterpret_cast<const bf16x8*>(kb+d0*2048);
    const bf16x8 b1=*reinterpret_cast<const bf16x8*>(kb+d0*2048+512);
    if(d0==0){p0=__builtin_amdgcn_mfma_f32_32x32x16_bf16(b0,qr[0],negm,0,0,0);p1=__builtin_amdgcn_mfma_f32_32x32x16_bf16(b1,qr[0],negm,0,0,0);}
    else{p0=__builtin_amdgcn_mfma_f32_32x32x16_bf16(b0,qr[d0],p0,0,0,0);p1=__builtin_amdgcn_mfma_f32_32x32x16_bf16(b1,qr[d0],p1,0,0,0);}}
}
typedef __attribute__((address_space(3))) const char* lds_cptr;
typedef short v4i16_t __attribute__((ext_vector_type(4)));
__device__ __forceinline__ void kload8(bf16x8*kf,lds_cptr kp){
  kf[0]=*(const __attribute__((address_space(3))) bf16x8*)(kp);      kf[1]=*(const __attribute__((address_space(3))) bf16x8*)(kp+512);
  kf[2]=*(const __attribute__((address_space(3))) bf16x8*)(kp+2048); kf[3]=*(const __attribute__((address_space(3))) bf16x8*)(kp+2560);
  kf[4]=*(const __attribute__((address_space(3))) bf16x8*)(kp+4096); kf[5]=*(const __attribute__((address_space(3))) bf16x8*)(kp+4608);
  kf[6]=*(const __attribute__((address_space(3))) bf16x8*)(kp+6144); kf[7]=*(const __attribute__((address_space(3))) bf16x8*)(kp+6656);
}
__device__ __forceinline__ void kload2(bf16x8*kf,lds_cptr kp,int j){ kf[2*j]=*(const __attribute__((address_space(3))) bf16x8*)(kp+j*2048); kf[2*j+1]=*(const __attribute__((address_space(3))) bf16x8*)(kp+j*2048+512); }
__device__ __forceinline__ s16x4 vtr(lds_cptr p){ return __builtin_bit_cast(s16x4,__builtin_amdgcn_ds_read_tr16_b64_v4i16((__attribute__((address_space(3))) v4i16_t*)p)); }
__device__ __forceinline__ float rowmax(const f32x16&p0,const f32x16&p1){
  float a=max3f(p0[0],p0[1],p1[0]),b=max3f(p0[2],p0[3],p1[1]);a=max3f(a,p1[2],p1[3]);
  #pragma unroll
  for(int r=4;r<16;r+=4){a=max3f(a,p0[r],p0[r+1]);b=max3f(b,p0[r+2],p0[r+3]);a=max3f(a,p1[r],p1[r+1]);b=max3f(b,p1[r+2],p1[r+3]);}
  const float m=max2f(a,b);
  auto rr=__builtin_amdgcn_permlane32_swap(__float_as_uint(m),__float_as_uint(m),false,false);
  return max2f(__uint_as_float(rr[0]),__uint_as_float(rr[1]));
}
__device__ __forceinline__ void pv(f32x16*o,int vb,bf16x8 pa0,bf16x8 pa1,bf16x8 pa2,bf16x8 pa3){
  #pragma unroll
  for(int d0=0;d0<2;++d0){s16x4 lo[4],hi[4];
    #pragma unroll
    for(int ks=0;ks<4;++ks){
      asm volatile("ds_read_b64_tr_b16 %0,%1 offset:%c2":"=&v"(lo[ks]):"v"(vb),"i"(d0*4096+ks*1024):"memory");
      asm volatile("ds_read_b64_tr_b16 %0,%1 offset:%c2":"=&v"(hi[ks]):"v"(vb),"i"(d0*4096+ks*1024+512):"memory");}
    asm volatile("s_waitcnt lgkmcnt(0)":::"memory");SBAR();
    #define PK(k) (bf16x8){lo[k][0],lo[k][1],lo[k][2],lo[k][3],hi[k][0],hi[k][1],hi[k][2],hi[k][3]}
    o[d0]=__builtin_amdgcn_mfma_f32_32x32x16_bf16(pa0,PK(0),o[d0],0,0,0);
    o[d0]=__builtin_amdgcn_mfma_f32_32x32x16_bf16(pa1,PK(1),o[d0],0,0,0);
    o[d0]=__builtin_amdgcn_mfma_f32_32x32x16_bf16(pa2,PK(2),o[d0],0,0,0);
    o[d0]=__builtin_amdgcn_mfma_f32_32x32x16_bf16(pa3,PK(3),o[d0],0,0,0);
    #undef PK
  }
}

#ifndef ATTN_STORE16
#define ATTN_STORE16(p,v) (*(u32x4*)(p)=(v))
#endif
template<int THRL> __device__ __forceinline__ void attn_unit(int b,int h,int qb,const bf16*Q,const bf16*__restrict__ K,const bf16*__restrict__ V,bf16*O,const float*__restrict__ CL,char*shm){
  const int tid=threadIdx.x,lane=tid&63,r32=lane&31,hi=lane>>5; const int wid=__builtin_amdgcn_readfirstlane(tid>>6);
  const long rowbase=(long)b*SEQ; const int q0=qb*QB;
  const bf16*Qw=Q+(rowbase+q0+wid*QBLK)*DM+h*D;
  const bf16*Kh=K+rowbase*DM+h*D,*Vh=V+rowbase*DM+h*D;
  const unsigned lds0=(unsigned)(uintptr_t)shm;
  float*wsf=(float*)(shm+LDS_WS)+wid*64;
  const bf16*ksrc=Kh+(long)lane*DM+wid*8;
  const bf16*vsrc=Vh+(long)(16*(wid&3)+(lane>>2))*DM+(wid>>2)*32+(lane&3)*8;
  const unsigned kdst=lds0+LDS_K+wid*1024, vdst=lds0+LDS_V+wid*1024;
  #define DMA_K(t,slot) glds16(ksrc+(long)(t)*KVBLK*DM,(unsigned)__builtin_amdgcn_readfirstlane(kdst+(slot)))
  #define DMA_V(t,slot) glds16(vsrc+(long)(t)*KVBLK*DM,(unsigned)__builtin_amdgcn_readfirstlane(vdst+(slot)))
  const int vb0=(int)(lds0+LDS_V)+((lane>>4)&1)*32+(lane&3)*8+(4*hi+((lane&15)>>2))*64;
  const char*Kbase=shm+LDS_K; bf16x8 kf[8];
  const lds_cptr shm3=(lds_cptr)shm; const lds_cptr kp0=shm3+LDS_K+hi*1024+r32*16; const lds_cptr vp0=shm3+LDS_V+((lane>>4)&1)*32+(lane&3)*8+(4*hi+((lane&15)>>2))*64;
  const int NT=(q0+QB)/KVBLK;
  __attribute__((address_space(3))) float*cls=(__attribute__((address_space(3))) float*)((__attribute__((address_space(3))) char*)shm+CLS_OFF);
  const float*CLh=CL+(long)(b*NHEAD+h)*SEQ;
  const float clq=CLh[q0+wid*QBLK+r32];
  glds16(CLh+wid*256+lane*4,(unsigned)__builtin_amdgcn_readfirstlane(lds0+CLS_OFF+wid*1024));
  #define BIAS(P0,P1,t) do{ const __attribute__((address_space(3))) float*cb_=cls+64*(t)+4*hi; _Pragma("unroll") for(int g_=0;g_<4;++g_){ \
      const f32x4_t b0_=*(const __attribute__((address_space(3))) f32x4_t*)(cb_+8*g_), b1_=*(const __attribute__((address_space(3))) f32x4_t*)(cb_+32+8*g_); \
      _Pragma("unroll") for(int j_=0;j_<4;++j_){ P0[4*g_+j_]+=(nm-b0_[j_]); P1[4*g_+j_]+=(nm-b1_[j_]); } } }while(0)
  DMA_K(0,0);DMA_V(0,0);DMA_K(1,SLOTB);
  bf16x8 qr[4];
  #pragma unroll
  for(int d0=0;d0<4;++d0)qr[d0]=*reinterpret_cast<const bf16x8*>(&Qw[(long)r32*DM+d0*16+hi*8]);
  float l_reg=0.f;f32x16 o[2];o[0]=f32x16{};o[1]=f32x16{};float nm=clq; const f32x16 zero16=f32x16{};
  const int qrel=wid*QBLK+r32;
  #define CMASK(P0,P1,t) do{int jb_=(t)-(NT-4); if(jb_>=0)cmask(P0,P1,jb_,qrel,hi);}while(0)
  bool resc=false;
  #define START(P0,P1) do{ const float rm=rowmax(P0,P1); resc=false; \
    { const float dl=rm; \
      _Pragma("unroll") for(int r=0;r<16;++r){P0[r]=fsub_s(P0[r],dl);P1[r]=fsub_s(P1[r],dl);} \
      nm=fsub_s(nm,dl); } \
    _Pragma("unroll") for(int r=0;r<16;++r)P0[r]=__builtin_amdgcn_exp2f(P0[r]); }while(0)
  #define RESC() do{ if(resc){ asm volatile("s_waitcnt lgkmcnt(0)":::"memory"); \
      _Pragma("unroll") for(int d_=0;d_<2;++d_) _Pragma("unroll") for(int r=0;r<16;++r)o[d_][r]*=wsf[crow(r,hi)]; } }while(0)
  f32x16 pA0,pA1,pB0,pB1;
  int sl_prev=0,sl_cur=0,sl_next=SLOTB;
  #define ROT() do{sl_prev=sl_cur;sl_cur=sl_next;sl_next=(sl_next==(NSLOT-1)*SLOTB)?0:sl_next+SLOTB;}while(0)
  DMA_K(2,2*SLOTB);
  WAIT_BAR(3);
  qkt(pA0,pA1,Kbase,qr,r32,hi);asm volatile("s_nop 15\n\ts_nop 7":"+v"(pA0),"+v"(pA1));BIAS(pA0,pA1,0);CMASK(pA0,pA1,0);
  START(pA0,pA1);
  _Pragma("unroll") for(int r=0;r<16;++r)pA1[r]=__builtin_amdgcn_exp2f(pA1[r]);
  WAIT_BAR(0);
  DMA_K(3,0);DMA_V(1,SLOTB);
  ROT();
  kload8(kf,kp0+sl_cur);
  WAIT_BAR(2);
  s16x4 vlo[8],vhi[8]; u32x4 pw0,pw1,pw2,pw3;
  #define PKW(P,B) cvtpk_s(P[B],P[B+1])
  #define PAF(k) __builtin_bit_cast(bf16x8,pw##k)
  #define VFR(i) (bf16x8){vlo[i][0],vlo[i][1],vlo[i][2],vlo[i][3],vhi[i][0],vhi[i][1],vhi[i][2],vhi[i][3]}
  #define PIN(x) asm volatile("":"+v"(x))
  #define MX3(a,b,c) __builtin_fmaxf(__builtin_fmaxf((a),(b)),(c))
  #define GAPA(MF,A0,A1,A2,A3,W0,W1,PW) do{ MF; sacc+=A0; sacc+=A1; sacc+=A2; sacc+=A3; PIN(sacc); W0; W1; PIN(PW); SBAR(); }while(0)
  #define EX(v) __builtin_amdgcn_exp2f(v)
  #define GAPB(MF,X,B) do{ MF; X[B]=EX(X[B]); X[B+1]=EX(X[B+1]); X[B+2]=EX(X[B+2]); X[B+3]=EX(X[B+3]); PIN(X); SBAR(); }while(0)
  #define VRD(i) do{ vlo[i]=vtr(vp_+(((i)>>2)*4096+((i)&3)*1024)); vhi[i]=vtr(vp_+(((i)>>2)*4096+((i)&3)*1024+512)); }while(0)
  #define KRD(G,j) do{ if(G){ kload2(kf,kp0+sl_next,j); SBAR(); } }while(0)
  #define STEP(C0,C1,P0,P1,t,GK,GV,GL) do{ SBAR(); \
    const lds_cptr vp_=vp0+sl_prev; \
    VRD(0); SBAR(); float sacc=(P0[0]+P0[1]); \
    GAPA(C0=__builtin_amdgcn_mfma_f32_32x32x16_bf16(kf[0],qr[0],zero16,0,0,0), P0[2],P0[3],P0[4],P0[5],     pw0[0]=PKW(P0,0), pw0[1]=PKW(P0,2), pw0); \
    VRD(4); SBAR(); GAPA(C1=__builtin_amdgcn_mfma_f32_32x32x16_bf16(kf[1],qr[0],zero16,0,0,0), P0[6],P0[7],P0[8],P0[9],     pw0[2]=PKW(P0,4), pw0[3]=PKW(P0,6), pw0); \
    VRD(1); SBAR(); GAPA(C0=__builtin_amdgcn_mfma_f32_32x32x16_bf16(kf[2],qr[1],C0,0,0,0),   P0[10],P0[11],P0[12],P0[13], pw1[0]=PKW(P0,8), pw1[1]=PKW(P0,10), pw1); \
    VRD(5); SBAR(); GAPA(C1=__builtin_amdgcn_mfma_f32_32x32x16_bf16(kf[3],qr[1],C1,0,0,0),   P0[14],P0[15],P1[0],P1[1],   pw1[2]=PKW(P0,12),pw1[3]=PKW(P0,14), pw1); \
    VRD(2); SBAR(); GAPA(C0=__builtin_amdgcn_mfma_f32_32x32x16_bf16(kf[4],qr[2],C0,0,0,0),   P1[2],P1[3],P1[4],P1[5],     pw2[0]=PKW(P1,0), pw2[1]=PKW(P1,2), pw2); \
    VRD(6); SBAR(); GAPA(C1=__builtin_amdgcn_mfma_f32_32x32x16_bf16(kf[5],qr[2],C1,0,0,0),   P1[6],P1[7],P1[8],P1[9],     pw2[2]=PKW(P1,4), pw2[3]=PKW(P1,6), pw2); \
    VRD(3); SBAR(); GAPA(C0=__builtin_amdgcn_mfma_f32_32x32x16_bf16(kf[6],qr[3],C0,0,0,0),   P1[10],P1[11],P1[12],P1[13], pw3[0]=PKW(P1,8), pw3[1]=PKW(P1,10), pw3); \
    VRD(7); SBAR(); GAPA(C1=__builtin_amdgcn_mfma_f32_32x32x16_bf16(kf[7],qr[3],C1,0,0,0),   P1[14],P1[15],0.f,0.f,       pw3[2]=PKW(P1,12),pw3[3]=PKW(P1,14), pw3); \
    l_reg+=sacc; \
    if(GK){DMA_K((t)+3,sl_cur);} if(GV){DMA_V((t)+1,sl_next);} \
    BIAS(C0,C1,t); CMASK(C0,C1,t); \
    { float a=MX3(C0[0],C0[1],C1[0]),b=MX3(C0[2],C0[3],C1[1]); a=MX3(a,C1[2],C1[3]); \
      _Pragma("unroll") for(int r=4;r<16;r+=4){a=MX3(a,C0[r],C0[r+1]);b=MX3(b,C0[r+2],C0[r+3]);a=MX3(a,C1[r],C1[r+1]);b=MX3(b,C1[r+2],C1[r+3]);} \
      float rm=__builtin_fmaxf(a,b); { auto rr=__builtin_amdgcn_permlane32_swap(__float_as_uint(rm),__float_as_uint(rm),false,false); rm=__builtin_fmaxf(__uint_as_float(rr[0]),__uint_as_float(rr[1])); } \
      resc=false; \
      if(__builtin_expect(__any(rm>(float)THRL),0)){ const float dl=__builtin_fmaxf(rm,0.f); \
        _Pragma("unroll") for(int r=0;r<16;++r){C0[r]-=dl;C1[r]-=dl;} \
        nm-=dl; \
        const float f=__builtin_amdgcn_exp2f(-dl); l_reg*=f; if(hi==0)wsf[r32]=f; resc=true; } } \
    SBAR(); \
    GAPB(o[0]=__builtin_amdgcn_mfma_f32_32x32x16_bf16(PAF(0),VFR(0),o[0],0,0,0), C0,0); \
    GAPB(o[1]=__builtin_amdgcn_mfma_f32_32x32x16_bf16(PAF(0),VFR(4),o[1],0,0,0), C0,4); \
    KRD(GL,0); GAPB(o[0]=__builtin_amdgcn_mfma_f32_32x32x16_bf16(PAF(1),VFR(1),o[0],0,0,0), C0,8); \
    KRD(GL,1); GAPB(o[1]=__builtin_amdgcn_mfma_f32_32x32x16_bf16(PAF(1),VFR(5),o[1],0,0,0), C0,12); \
    KRD(GL,2); GAPB(o[0]=__builtin_amdgcn_mfma_f32_32x32x16_bf16(PAF(2),VFR(2),o[0],0,0,0), C1,0); \
    KRD(GL,3); GAPB(o[1]=__builtin_amdgcn_mfma_f32_32x32x16_bf16(PAF(2),VFR(6),o[1],0,0,0), C1,4); \
    GAPB(o[0]=__builtin_amdgcn_mfma_f32_32x32x16_bf16(PAF(3),VFR(3),o[0],0,0,0), C1,8); \
    GAPB(o[1]=__builtin_amdgcn_mfma_f32_32x32x16_bf16(PAF(3),VFR(7),o[1],0,0,0), C1,12); \
    }while(0)
  int t=1;
  #undef CMASK
  #define CMASK(P0,P1,t) do{}while(0)
  for(;t+5<NT;t+=2){
    STEP(pB0,pB1,pA0,pA1,t,true,true,true);     WAIT_BAR(2); RESC(); ROT();
    STEP(pA0,pA1,pB0,pB1,t+1,true,true,true);   WAIT_BAR(2); RESC(); ROT();
  }
  #undef CMASK
  #define CMASK(P0,P1,t) do{int jb_=(t)-(NT-4); if(jb_>=0)cmask(P0,P1,jb_,qrel,hi);}while(0)
  #define ENDW(tt) do{ if((tt)+3<NT){WAIT_BAR(2);} else if((tt)+2<NT){WAIT_BAR(1);} else {WAIT_BAR(0);} }while(0)
  for(;t+1<NT;t+=2){
    STEP(pB0,pB1,pA0,pA1,t,(t+3<NT),(t+1<NT),(t+1<NT));       ENDW(t);   RESC(); ROT();
    STEP(pA0,pA1,pB0,pB1,t+1,(t+4<NT),(t+2<NT),(t+2<NT));     ENDW(t+1); RESC(); ROT();
  }
  STEP(pB0,pB1,pA0,pA1,NT-1,false,false,false); RESC();
  { float sacc=pB0[0]+pB0[1]; _Pragma("unroll") for(int r=2;r<16;++r)sacc+=pB0[r]; _Pragma("unroll") for(int r=0;r<16;++r)sacc+=pB1[r]; l_reg+=sacc;
    pw0=(u32x4){PKW(pB0,0),PKW(pB0,2),PKW(pB0,4),PKW(pB0,6)};pw1=(u32x4){PKW(pB0,8),PKW(pB0,10),PKW(pB0,12),PKW(pB0,14)};pw2=(u32x4){PKW(pB1,0),PKW(pB1,2),PKW(pB1,4),PKW(pB1,6)};pw3=(u32x4){PKW(pB1,8),PKW(pB1,10),PKW(pB1,12),PKW(pB1,14)};
    SBAR(); pv(o,vb0+sl_cur,PAF(0),PAF(1),PAF(2),PAF(3)); }
  #undef PKW
  #undef PAF
  #undef VFR
  #undef PIN
  #undef MX3
  #undef GAPA
  #undef GAPB
  #undef EX
  #undef VRD
  #undef KRD
  #undef STEP
  #undef ENDW
  {auto rr=__builtin_amdgcn_permlane32_swap(__float_as_uint(l_reg),__float_as_uint(l_reg),false,false);l_reg=__uint_as_float(rr[0])+__uint_as_float(rr[1]);}
  if(hi==0)wsf[32+r32]=l_reg;asm volatile("s_waitcnt lgkmcnt(0)":::"memory");
  float rli[16];
  #pragma unroll
  for(int r=0;r<16;++r)rli[r]=__builtin_amdgcn_rcpf(wsf[32+crow(r,hi)]);
  bf16*Ow=O+(rowbase+q0+wid*QBLK)*OP+h*D;
  { bf16*stg=(bf16*)(shm+LDS_OST)+wid*2048;
    #pragma unroll
    for(int r=0;r<16;++r){const int orow=crow(r,hi);
      #pragma unroll
      for(int d0=0;d0<2;++d0)stg[orow*64+d0*32+r32]=__float2bfloat16(o[d0][r]*rli[r]);}
    asm volatile("s_waitcnt lgkmcnt(0)":::"memory");
    #pragma unroll
    for(int i=0;i<4;++i){const int row=i*8+(lane>>3),ch=lane&7; const u32x4 v=*(const u32x4*)(stg+row*64+ch*8); ATTN_STORE16(Ow+(long)row*OP+ch*8,v);} }
  asm volatile("s_waitcnt lgkmcnt(0)\n\ts_barrier":::"memory");
  #undef BIAS
  #undef DMA_K
  #undef DMA_V
  #undef CMASK
  #undef START
  #undef RESC
  #undef ROT
}
constexpr int ATTN_LDS_BYTES=LDS_BYTES;
struct AttnTensors { const bf16* Q; const bf16* K; const bf16* V; bf16* O; const float* CL; };
struct AttnUnit { int bh; int qb; };
struct StaticOrder {
  int vcu;
  __device__ __forceinline__ explicit StaticOrder(int grid,int block):vcu((block%8)*(grid/8)+block/8){}
  __device__ __forceinline__ bool next(int i,AttnUnit&u)const{ if(i>=2)return false; const int s=vcu&3; u.bh=vcu>>2; u.qb=(i==0)?7-s:s; return true; }
  __device__ __forceinline__ void a_ready(const AttnUnit&)const{}
  __device__ __forceinline__ void done(const AttnUnit&)const{}
};
template<class Sched,int THRL=8> __device__ __forceinline__ void attn_phase(char*lds,const AttnTensors&T,const Sched&S){
  AttnUnit u;
  for(int i=0;S.next(i,u);++i){ S.a_ready(u); attn_unit<THRL>(u.bh/NHEAD,u.bh%NHEAD,u.qb,T.Q,T.K,T.V,T.O,T.CL,lds); S.done(u); }
}
#undef SBAR
#undef WAIT_BAR
}

#define LAS __attribute__((address_space(3)))
typedef unsigned short bf16;
typedef unsigned v4u __attribute__((ext_vector_type(4)));
typedef unsigned v2u __attribute__((ext_vector_type(2)));
typedef float f32x4 __attribute__((ext_vector_type(4)));
constexpr int NWAVES = 8, NTHR = 512;
constexpr int BATCH = 8, SEQ = 2048, M = BATCH * SEQ, D = 1024, AW = 512, NH = 8, HD = 64, SW = 512, NG = 32, GS = 16, NP = 64, DFF = 2816, NUP = 2 * DFF, INC = 2056;
constexpr float EPS = 1e-6f;
constexpr size_t MiB = 1u << 20;
constexpr size_t WS_WIN = 1 * MiB, WS_WGLU = 5 * MiB, WS_WOUT = 6 * MiB, WS_WUP = 8 * MiB, WS_WDN = 19 * MiB;
constexpr size_t WS_TAB = 25 * MiB;
constexpr size_t TB_LOGF = 0, TB_CUM = 512 * 1024, TB_LB = 1024 * 1024, TB_BB = TB_LB + 16384, TB_BBP = 1536 * 1024, TB_CP = 1792 * 1024;
constexpr size_t WS_SS = 28 * MiB;
constexpr size_t WS_XB = 32 * MiB;
constexpr size_t WS_Q = 64 * MiB, WS_K = 80 * MiB, WS_V = 96 * MiB, WS_U = 112 * MiB, WS_YG = 128 * MiB, WS_MIX = 144 * MiB;
constexpr size_t WS_ACT = 152 * MiB, WS_HALO = 240 * MiB, WS_END = 248 * MiB;
constexpr size_t TB_SSQ2 = 2048 * 1024, TB_RSTD1 = 1408 * 1024;
constexpr int LDS_BYTES = 147456, RING_BYTES = 131072;

__device__ __forceinline__ float bf2f(unsigned v) { return __uint_as_float(v << 16); }
__device__ __forceinline__ unsigned f2bf(float f) { unsigned u = __float_as_uint(f); return (u + 0x7fffu + ((u >> 16) & 1u)) >> 16; }
__device__ __forceinline__ unsigned pk2(float lo, float hi) { return f2bf(lo) | (f2bf(hi) << 16); }
__device__ __forceinline__ float wave_sum(float v) {
#pragma unroll
    for (int o = 1; o < 64; o <<= 1) v += __shfl_xor(v, o);
    return v;
}
__device__ __forceinline__ void unpack8(const v4u w, float* f) {
    f[0] = bf2f(w.x & 0xffffu); f[1] = bf2f(w.x >> 16); f[2] = bf2f(w.y & 0xffffu); f[3] = bf2f(w.y >> 16);
    f[4] = bf2f(w.z & 0xffffu); f[5] = bf2f(w.z >> 16); f[6] = bf2f(w.w & 0xffffu); f[7] = bf2f(w.w >> 16);
}
__device__ __forceinline__ v4u pack8(const float* f) { v4u w; w.x = pk2(f[0], f[1]); w.y = pk2(f[2], f[3]); w.z = pk2(f[4], f[5]); w.w = pk2(f[6], f[7]); return w; }

namespace pg8 {
struct EpiPlain {
    static constexpr bool PERM = true, AFTER_DRAIN = false;
    bf16_t* O; int ldc; int split_cols; size_t split_stride;
    __device__ __forceinline__ void operator()(const f32x4 (&acc)[2][2][4][2], const Unit& u, int wr, int wc, int fr, int fq) const {
        const int row0 = u.pm * BM + wr * 64 + fr; int colt = u.pn * BM; bf16_t* base = O;
        if (split_cols) { const int t = colt / split_cols; base += (size_t)t * split_stride; colt -= t * split_cols; }
        const int col0 = colt + wc * 32 + 8 * fq;
#pragma unroll
        for (int ai = 0; ai < 2; ++ai)
#pragma unroll
            for (int m = 0; m < 4; ++m) { bf16_t* rowp = base + (size_t)(row0 + ai * HALF + m * 16) * ldc + col0;
#pragma unroll
                for (int bj = 0; bj < 2; ++bj) { const f32x4 v0 = acc[ai][bj][m][0], v1 = acc[ai][bj][m][1];
                    u32x4 w; w.x = cvt_pk_bf16(v0[0], v0[1]); w.y = cvt_pk_bf16(v0[2], v0[3]); w.z = cvt_pk_bf16(v1[0], v1[1]); w.w = cvt_pk_bf16(v1[2], v1[3]);
                    *(u32x4*)(rowp + bj * HALF) = w; } }
    }
};
struct EpiGlu {
    static constexpr bool PERM = true, AFTER_DRAIN = false;
    const bf16_t* YG; const float* bias; bf16_t* O; int ldo; int ocol0;
    __device__ __forceinline__ void operator()(const f32x4 (&acc)[2][2][4][2], const Unit& u, int wr, int wc, int fr, int fq) const {
        const int row0 = u.pm * BM + wr * 64 + fr; const int col0 = u.pn * BM + wc * 32 + 8 * fq;
#pragma unroll
        for (int ai = 0; ai < 2; ++ai)
#pragma unroll
            for (int m = 0; m < 4; ++m) { const int row = row0 + ai * HALF + m * 16;
#pragma unroll
                for (int bj = 0; bj < 2; ++bj) { const int col = col0 + bj * HALF;
                    const f32x4 b0 = *(const f32x4*)(bias + col), b1 = *(const f32x4*)(bias + col + 4);
                    const f32x4 v0 = acc[ai][bj][m][0] + b0, v1 = acc[ai][bj][m][1] + b1;
                    const u32x4 yw = *(const u32x4*)(YG + (size_t)row * 512 + col);
                    float y[8]; y[0] = __uint_as_float(yw.x << 16); y[1] = __uint_as_float(yw.x & 0xffff0000u); y[2] = __uint_as_float(yw.y << 16); y[3] = __uint_as_float(yw.y & 0xffff0000u);
                    y[4] = __uint_as_float(yw.z << 16); y[5] = __uint_as_float(yw.z & 0xffff0000u); y[6] = __uint_as_float(yw.w << 16); y[7] = __uint_as_float(yw.w & 0xffff0000u);
                    float o[8];
#pragma unroll
                    for (int i = 0; i < 4; ++i) { o[i] = y[i] / (1.f + __expf(-v0[i])); o[4 + i] = y[4 + i] / (1.f + __expf(-v1[i])); }
                    u32x4 w; w.x = cvt_pk_bf16(o[0], o[1]); w.y = cvt_pk_bf16(o[2], o[3]); w.z = cvt_pk_bf16(o[4], o[5]); w.w = cvt_pk_bf16(o[6], o[7]);
                    *(u32x4*)(O + (size_t)row * ldo + ocol0 + col) = w; } }
    }
};
struct EpiRes {
    static constexpr bool PERM = true, AFTER_DRAIN = false;
    const float* base; float* out; int ldc;
    __device__ __forceinline__ void operator()(const f32x4 (&acc)[2][2][4][2], const Unit& u, int wr, int wc, int fr, int fq) const {
        const int row0 = u.pm * BM + wr * 64 + fr; const int col0 = u.pn * BM + wc * 32 + 8 * fq;
#pragma unroll
        for (int ai = 0; ai < 2; ++ai)
#pragma unroll
            for (int m = 0; m < 4; ++m) { const size_t off = (size_t)(row0 + ai * HALF + m * 16) * ldc + col0;
#pragma unroll
                for (int bj = 0; bj < 2; ++bj) {
                    const f32x4 x0 = *(const f32x4*)(base + off + bj * HALF), x1 = *(const f32x4*)(base + off + bj * HALF + 4);
                    *(f32x4*)(out + off + bj * HALF) = x0 + acc[ai][bj][m][0]; *(f32x4*)(out + off + bj * HALF + 4) = x1 + acc[ai][bj][m][1]; } }
    }
};

struct EpiResB {
    static constexpr bool PERM = true, AFTER_DRAIN = false;
    const bf16_t* XB; float* out; int ldc;
    __device__ __forceinline__ void operator()(const f32x4 (&acc)[2][2][4][2], const Unit& u, int wr, int wc, int fr, int fq) const {
        const int row0 = u.pm * BM + wr * 64 + fr; const int col0 = u.pn * BM + wc * 32 + 8 * fq;
        u32x4 wres[2][4][2];
#pragma unroll
        for (int ai = 0; ai < 2; ++ai)
#pragma unroll
            for (int m = 0; m < 4; ++m)
#pragma unroll
                for (int bj = 0; bj < 2; ++bj) wres[ai][m][bj] = *(const u32x4*)(XB + (size_t)(row0 + ai * HALF + m * 16) * ldc + col0 + bj * HALF);
#pragma unroll
        for (int ai = 0; ai < 2; ++ai)
#pragma unroll
            for (int m = 0; m < 4; ++m) { const size_t off = (size_t)(row0 + ai * HALF + m * 16) * ldc + col0;
#pragma unroll
                for (int bj = 0; bj < 2; ++bj) { const u32x4 w = wres[ai][m][bj];
                    const f32x4 x0 = (f32x4){__uint_as_float(w.x << 16), __uint_as_float(w.x & 0xffff0000u), __uint_as_float(w.y << 16), __uint_as_float(w.y & 0xffff0000u)};
                    const f32x4 x1 = (f32x4){__uint_as_float(w.z << 16), __uint_as_float(w.z & 0xffff0000u), __uint_as_float(w.w << 16), __uint_as_float(w.w & 0xffff0000u)};
                    *(f32x4*)(out + off + bj * HALF) = x0 + acc[ai][bj][m][0]; *(f32x4*)(out + off + bj * HALF + 4) = x1 + acc[ai][bj][m][1]; } }
    }
};
struct EpiX1 {
    static constexpr bool PERM = true, AFTER_DRAIN = false;
    const float* base; float* out; bf16_t* XB; float* SSQ; int ldc;
    __device__ __forceinline__ void operator()(const f32x4 (&acc)[2][2][4][2], const Unit& u, int wr, int wc, int fr, int fq) const {
        const int row0 = u.pm * BM + wr * 64 + fr; const int col0 = u.pn * BM + wc * 32 + 8 * fq;
        u32x4 xres[2][4][2];
#pragma unroll
        for (int ai = 0; ai < 2; ++ai)
#pragma unroll
            for (int m = 0; m < 4; ++m)
#pragma unroll
                for (int bj = 0; bj < 2; ++bj) xres[ai][m][bj] = *(const u32x4*)(XB + (size_t)(row0 + ai * HALF + m * 16) * ldc + col0 + bj * HALF);
#pragma unroll
        for (int ai = 0; ai < 2; ++ai)
#pragma unroll
            for (int m = 0; m < 4; ++m) { const int row = row0 + ai * HALF + m * 16; const size_t off = (size_t)row * ldc + col0; float q = 0.f;
#pragma unroll
                for (int bj = 0; bj < 2; ++bj) { const u32x4 xw = xres[ai][m][bj];
                    const f32x4 x0 = (f32x4){__uint_as_float(xw.x << 16), __uint_as_float(xw.x & 0xffff0000u), __uint_as_float(xw.y << 16), __uint_as_float(xw.y & 0xffff0000u)} + acc[ai][bj][m][0];
                    const f32x4 x1 = (f32x4){__uint_as_float(xw.z << 16), __uint_as_float(xw.z & 0xffff0000u), __uint_as_float(xw.w << 16), __uint_as_float(xw.w & 0xffff0000u)} + acc[ai][bj][m][1];
                    q += (x0[0] * x0[0] + x0[1] * x0[1]) + (x0[2] * x0[2] + x0[3] * x0[3]) + (x1[0] * x1[0] + x1[1] * x1[1]) + (x1[2] * x1[2] + x1[3] * x1[3]);
                    u32x4 w; w.x = cvt_pk_bf16(x0[0], x0[1]); w.y = cvt_pk_bf16(x0[2], x0[3]); w.z = cvt_pk_bf16(x1[0], x1[1]); w.w = cvt_pk_bf16(x1[2], x1[3]);
                    *(u32x4*)(XB + off + bj * HALF) = w; }
                q += __shfl_xor(q, 16); q += __shfl_xor(q, 32);
                if (fq == 0) SSQ[(size_t)row * 16 + u.pn * 4 + wc] = q; }
    }
};
__device__ __forceinline__ float row_up1(float prev, float cur) { float t; asm volatile("s_nop 1\n\tv_mov_b32_dpp %0, %1 row_ror:1 row_mask:0xf bank_mask:0xf\n\tv_mov_b32_dpp %0, %2 row_shr:1 row_mask:0xf bank_mask:0xf" : "=&v"(t) : "v"(prev), "v"(cur)); return t; }
__device__ __forceinline__ float row_up2(float prev, float cur) { float t; asm volatile("s_nop 1\n\tv_mov_b32_dpp %0, %1 row_ror:2 row_mask:0xf bank_mask:0xf\n\tv_mov_b32_dpp %0, %2 row_shr:2 row_mask:0xf bank_mask:0xf" : "=&v"(t) : "v"(prev), "v"(cur)); return t; }

struct EpiIn {
    static constexpr bool PERM = true, AFTER_DRAIN = false;
    const float* rstd1; const float* gq; const float* gk; bf16_t* O; size_t stride; float c2;
    __device__ __forceinline__ void operator()(const f32x4 (&acc)[2][2][4][2], const Unit& u, int wr, int wc, int fr, int fq) const {
        const int row0 = u.pm * BM + wr * 64 + fr; const int t = u.pn >> 1; bf16_t* base = O + (size_t)t * stride + ((u.pn & 1) * 4 + wc) * 64 + 8 * fq;
        f32x4 gv[2][2];
        if (t < 2) { const float* gp = t ? gk : gq; const float sc = t ? 1.f : c2;
#pragma unroll
            for (int bj = 0; bj < 2; ++bj)
#pragma unroll
                for (int n = 0; n < 2; ++n) gv[bj][n] = *(const f32x4*)(gp + 32 * bj + 8 * fq + 4 * n) * sc; }
        float rsA[2][4];
#pragma unroll
        for (int ai = 0; ai < 2; ++ai)
#pragma unroll
            for (int m = 0; m < 4; ++m) rsA[ai][m] = rstd1[row0 + ai * HALF + m * 16];
#pragma unroll
        for (int ai = 0; ai < 2; ++ai)
#pragma unroll
            for (int m = 0; m < 4; ++m) { const int row = row0 + ai * HALF + m * 16; float rs = rsA[ai][m];
                f32x4 v[2][2];
#pragma unroll
                for (int bj = 0; bj < 2; ++bj)
#pragma unroll
                    for (int n = 0; n < 2; ++n) v[bj][n] = acc[ai][bj][m][n] * rs;
                if (t < 2) { float q = 0.f;
#pragma unroll
                    for (int bj = 0; bj < 2; ++bj)
#pragma unroll
                        for (int n = 0; n < 2; ++n) q += (v[bj][n][0] * v[bj][n][0] + v[bj][n][1] * v[bj][n][1]) + (v[bj][n][2] * v[bj][n][2] + v[bj][n][3] * v[bj][n][3]);
                    q += __shfl_xor(q, 16); q += __shfl_xor(q, 32);
                    const float hr = __builtin_amdgcn_rsqf(q * (1.f / 64.f) + 1e-6f);
#pragma unroll
                    for (int bj = 0; bj < 2; ++bj)
#pragma unroll
                        for (int n = 0; n < 2; ++n) v[bj][n] = v[bj][n] * gv[bj][n] * hr; }
#pragma unroll
                for (int bj = 0; bj < 2; ++bj) { u32x4 w; w.x = cvt_pk_bf16(v[bj][0][0], v[bj][0][1]); w.y = cvt_pk_bf16(v[bj][0][2], v[bj][0][3]); w.z = cvt_pk_bf16(v[bj][1][0], v[bj][1][1]); w.w = cvt_pk_bf16(v[bj][1][2], v[bj][1][3]);
                    *(u32x4*)(base + (size_t)row * 512 + 32 * bj) = w; } }
    }
};
struct EpiUpConv {
    static constexpr bool PERM = true, AFTER_DRAIN = false;
    const float* SSQ; const float* cw; const float* cb; bf16_t* ACT; float* HALO; __attribute__((address_space(3))) float* XCH;
    __device__ __forceinline__ void operator()(f32x4 (&acc)[2][2][4][2], const Unit& u, int wr, int wc, int fr, int fq) const {
        const int row0 = u.pm * BM + wr * 64 + fr; const int tcol = wc * 32 + 8 * fq;
        const int ac0 = u.pn * HALF + tcol;
        f32x4 prm[2][8];
#define LOAD_PRM(n) do { prm[n][0] = *(const f32x4*)(cb + ac0 + 4 * (n)); prm[n][1] = *(const f32x4*)(cb + 2816 + ac0 + 4 * (n)); \
            _Pragma("unroll") for (int j = 0; j < 3; ++j) { prm[n][2 + 2 * j] = *(const f32x4*)(cw + j * 5632 + ac0 + 4 * (n)); prm[n][3 + 2 * j] = *(const f32x4*)(cw + j * 5632 + 2816 + ac0 + 4 * (n)); } } while (0)
        LOAD_PRM(0);
#pragma unroll
        for (int ai = 0; ai < 2; ++ai)
#pragma unroll
            for (int m = 0; m < 4; ++m) { const f32x4 a0 = *(const f32x4*)(SSQ + (size_t)(row0 + ai * HALF + m * 16) * 16 + 4 * fq);
                float tot = (a0[0] + a0[1]) + (a0[2] + a0[3]); tot += __shfl_xor(tot, 16); tot += __shfl_xor(tot, 32);
                const float rstd = __builtin_amdgcn_rsqf(tot * (1.f / 1024.f) + 1e-6f);
#pragma unroll
                for (int bj = 0; bj < 2; ++bj) { acc[ai][bj][m][0] *= rstd; acc[ai][bj][m][1] *= rstd; }
                __builtin_amdgcn_sched_barrier(0); }
        if (fr >= 14) {
#pragma unroll
            for (int ai = 0; ai < 2; ++ai)
#pragma unroll
                for (int bj = 0; bj < 2; ++bj)
#pragma unroll
                    for (int n = 0; n < 2; ++n) { XCH[((ai * 2 + wr) * 2 + (fr - 14)) * 256 + bj * HALF + tcol + 4 * n + 0] = acc[ai][bj][3][n][0]; XCH[((ai * 2 + wr) * 2 + (fr - 14)) * 256 + bj * HALF + tcol + 4 * n + 1] = acc[ai][bj][3][n][1];
                        XCH[((ai * 2 + wr) * 2 + (fr - 14)) * 256 + bj * HALF + tcol + 4 * n + 2] = acc[ai][bj][3][n][2]; XCH[((ai * 2 + wr) * 2 + (fr - 14)) * 256 + bj * HALF + tcol + 4 * n + 3] = acc[ai][bj][3][n][3]; }
            if (wr == 1) {
#pragma unroll
                for (int bj = 0; bj < 2; ++bj)
#pragma unroll
                    for (int n = 0; n < 2; ++n) *(f32x4*)(HALO + ((size_t)u.pm * 4 + (fr - 14)) * 5632 + u.pn * BM + bj * HALF + tcol + 4 * n) = acc[1][bj][3][n];
            }
        }
        if (fr < 2 && wr == 0) {
#pragma unroll
            for (int bj = 0; bj < 2; ++bj)
#pragma unroll
                for (int n = 0; n < 2; ++n) *(f32x4*)(HALO + ((size_t)u.pm * 4 + 2 + fr) * 5632 + u.pn * BM + bj * HALF + tcol + 4 * n) = acc[0][bj][0][n];
        }
        asm volatile("s_waitcnt lgkmcnt(0)" ::: "memory"); __builtin_amdgcn_s_barrier(); asm volatile("" ::: "memory");
        LOAD_PRM(1);
#undef LOAD_PRM
#pragma unroll
        for (int n = 0; n < 2; ++n) {
            const f32x4 cbg = prm[n][0], cbv = prm[n][1], w0g = prm[n][2], w0v = prm[n][3], w1g = prm[n][4], w1v = prm[n][5], w2g = prm[n][6], w2v = prm[n][7];
#pragma unroll
            for (int ai = 0; ai < 2; ++ai)
#pragma unroll
                for (int m = 3; m >= 0; --m) {
                    f32x4 pg, pv;
                    if (m > 0) { pg = acc[ai][0][m - 1][n]; pv = acc[ai][1][m - 1][n]; }
                    else { const int blk = (wr == 1) ? ai * 2 : 1; const bool have = (wr == 1) || (ai == 1);
                        pg = (f32x4){0.f, 0.f, 0.f, 0.f}; pv = pg;
                        if (have && fr >= 14) { pg = *(const __attribute__((address_space(3))) f32x4*)(XCH + (blk * 2 + (fr - 14)) * 256 + tcol + 4 * n); pv = *(const __attribute__((address_space(3))) f32x4*)(XCH + (blk * 2 + (fr - 14)) * 256 + HALF + tcol + 4 * n); } }
                    const f32x4 cg = acc[ai][0][m][n], cv = acc[ai][1][m][n]; f32x4 o;
#pragma unroll
                    for (int i = 0; i < 4; ++i) {
                        const float g1 = row_up1(pg[i], cg[i]), g2 = row_up2(pg[i], cg[i]), v1 = row_up1(pv[i], cv[i]), v2 = row_up2(pv[i], cv[i]);
                        const float hg = cbg[i] + w0g[i] * g2 + w1g[i] * g1 + w2g[i] * cg[i], hv = cbv[i] + w0v[i] * v2 + w1v[i] * v1 + w2v[i] * cv[i];
                        float oi = hg * __builtin_amdgcn_rcpf(1.f + __expf(-hg)) * hv; asm volatile("" : "+v"(oi)); o[i] = oi; }
                    acc[ai][0][m][n] = o; __builtin_amdgcn_sched_barrier(0); }
        }
#pragma unroll
        for (int ai = 0; ai < 2; ++ai)
#pragma unroll
            for (int m = 0; m < 4; ++m) { const f32x4 v0 = acc[ai][0][m][0], v1 = acc[ai][0][m][1];
                u32x4 w; w.x = cvt_pk_bf16(v0[0], v0[1]); w.y = cvt_pk_bf16(v0[2], v0[3]); w.z = cvt_pk_bf16(v1[0], v1[1]); w.w = cvt_pk_bf16(v1[2], v1[3]);
                *(u32x4*)(ACT + (size_t)(row0 + ai * HALF + m * 16) * 2816 + ac0) = w; }
    }
};
}

struct Args { const float* in[24]; float* out; unsigned char* ws; int ph_lo, ph_hi; };

__device__ __forceinline__ float log_sigmoid(float z) { return fminf(z, 0.f) - log1pf(expf(-fabsf(z))); }
typedef short s16x8p __attribute__((ext_vector_type(8)));
constexpr int WF_LO_OFF = 32768;
__device__ __forceinline__ void p0_prologue(const Args& a, LAS unsigned char* lds, int vcu, int gw, int NGW, int tid, int wave, int lane) {
    unsigned char* ws = a.ws;
    {
        const float* x = a.in[0]; const float* gm = a.in[1]; const float* win = a.in[2]; const float* bfv = a.in[3];
        float* logf = (float*)(ws + WS_TAB + TB_LOGF); float* rstd1 = (float*)(ws + WS_TAB + TB_RSTD1); bf16* XB = (bf16*)(ws + WS_XB);
        for (int i = tid; i < 32768; i += NTHR) ((LAS unsigned*)lds)[i >> 1 << 1 | (i & 1)] = 0u;
        __syncthreads();
        for (int k = tid; k < D; k += NTHR) { const float g = gm[k]; const f32x4 w0 = *(const f32x4*)(win + (size_t)k * INC + 1536), w1 = *(const f32x4*)(win + (size_t)k * INC + 1540);
            const float w[8] = {w0[0] * g, w0[1] * g, w0[2] * g, w0[3] * g, w1[0] * g, w1[1] * g, w1[2] * g, w1[3] * g};
            const int ks = k >> 5, q = (k >> 3) & 3, i = k & 7;
#pragma unroll
            for (int h = 0; h < 8; ++h) { const unsigned hb = f2bf(w[h]); const float lo = w[h] - bf2f(hb); const int off = ((ks * 4 + q) * 16 + h) * 16 + i * 2;
                *(LAS bf16*)(lds + off) = (bf16)hb; *(LAS bf16*)(lds + WF_LO_OFF + off) = (bf16)f2bf(lo); } }
        __syncthreads();
        const int m = lane & 15, q = lane >> 4, half = wave & 1;
        LAS float* XR = (LAS float*)(lds + 65536);
        for (int blk = vcu * 4 + (wave >> 1); blk < M / 16; blk += (NGW / 8) * 4) {
            const size_t row = (size_t)blk * 16 + m; const float* xr = x + row * D + 512 * half + 8 * q;
            f32x4 acc = (f32x4){0.f, 0.f, 0.f, 0.f}; float ssq = 0.f;
#pragma unroll
            for (int ks = 0; ks < 16; ++ks) {
                const f32x4 x0 = *(const f32x4*)(xr + 32 * ks), x1 = *(const f32x4*)(xr + 32 * ks + 4);
                const float xv[8] = {x0[0], x0[1], x0[2], x0[3], x1[0], x1[1], x1[2], x1[3]};
                unsigned hb[8]; float lo[8];
#pragma unroll
                for (int i = 0; i < 8; ++i) { hb[i] = f2bf(xv[i]); lo[i] = xv[i] - bf2f(hb[i]); ssq += xv[i] * xv[i]; }
                v4u hw; hw.x = hb[0] | (hb[1] << 16); hw.y = hb[2] | (hb[3] << 16); hw.z = hb[4] | (hb[5] << 16); hw.w = hb[6] | (hb[7] << 16);
                const v4u lw = pack8(lo);
                *(v4u*)(XB + row * D + 512 * half + 32 * ks + 8 * q) = hw;
                const int kst = 16 * half + ks;
                const s16x8p bh = *(const LAS s16x8p*)(lds + ((kst * 4 + q) * 16 + m) * 16), bl = *(const LAS s16x8p*)(lds + WF_LO_OFF + ((kst * 4 + q) * 16 + m) * 16);
                const s16x8p ah = __builtin_bit_cast(s16x8p, hw), al = __builtin_bit_cast(s16x8p, lw);
                acc = __builtin_amdgcn_mfma_f32_16x16x32_bf16(ah, bh, acc, 0, 0, 0);
                acc = __builtin_amdgcn_mfma_f32_16x16x32_bf16(ah, bl, acc, 0, 0, 0);
                acc = __builtin_amdgcn_mfma_f32_16x16x32_bf16(al, bh, acc, 0, 0, 0);
            }
            ssq += __shfl_xor(ssq, 16); ssq += __shfl_xor(ssq, 32);
            __syncthreads();
            if (half) { LAS float* p = XR + ((wave >> 1) * 64 + lane) * 5; p[0] = acc[0]; p[1] = acc[1]; p[2] = acc[2]; p[3] = acc[3]; p[4] = ssq; }
            __syncthreads();
            if (!half) { const LAS float* p = XR + ((wave >> 1) * 64 + lane) * 5; acc[0] += p[0]; acc[1] += p[1]; acc[2] += p[2]; acc[3] += p[3]; ssq += p[4];
                const float rstd = 1.f / sqrtf(ssq * (1.f / D) + EPS);
                if (q == 0) rstd1[row] = rstd;
#pragma unroll
                for (int j = 0; j < 4; ++j) { const float rt = __shfl(rstd, 4 * q + j); if (m < 8) logf[((size_t)blk * 16 + 4 * q + j) * 8 + m] = log_sigmoid(acc[j] * rt + bfv[m]); } }
        }
        __syncthreads();
    }
    {
        constexpr int I_IN = 32 * 32, I_GLU = 8 * 16, I_OUT = 16 * 32, I_UP = 88 * 32, I_DN = 16 * 88, NITEMS = I_IN + I_GLU + I_OUT + I_UP + I_DN;
        struct WItem { const float* src; const float* g; bf16* dst; int ldn; int frag; };
        auto decode = [&](int it, WItem& w) {
            int r = it;
            if (r < I_IN) { const int nb = r / 32, kb = r % 32, dn = 64 * nb + lane, tl = dn >> 8, c = dn & 255;
                int sn = tl * 256 + 64 * ((c >> 5) & 3) + 32 * (c >> 7) + (c & 31); if (sn >= 1536) sn += 8;
                w.src = a.in[2] + (size_t)(32 * kb) * INC + sn; w.ldn = INC; w.g = a.in[1] + 32 * kb; w.dst = (bf16*)(ws + WS_WIN) + (size_t)dn * D + 32 * kb; w.frag = 0; return; } r -= I_IN;
            if (r < I_GLU) { const int nb = r / 16, kb = r % 16, dn = 64 * nb + lane;
                w.src = a.in[14] + (size_t)(32 * kb) * SW + dn; w.ldn = SW; w.g = nullptr; w.dst = (bf16*)(ws + WS_WGLU) + ((size_t)(kb * 32 + (dn >> 4)) * 64 + (dn & 15)) * 8; w.frag = 1; return; } r -= I_GLU;
            if (r < I_OUT) { const int nb = r / 32, kb = r % 32, dn = 64 * nb + lane, k0 = 32 * kb;
                w.src = a.in[18] + (size_t)k0 * D + dn; w.ldn = D; w.g = (k0 < AW) ? a.in[16] + k0 : a.in[17] + (k0 - AW); w.dst = (bf16*)(ws + WS_WOUT) + (size_t)dn * D + k0; w.frag = 0; return; } r -= I_OUT;
            if (r < I_UP) { const int nb = r / 32, kb = r % 32, dn = 64 * nb + lane, tl = dn >> 8, cc = dn & 255, sn = cc < 128 ? 128 * tl + cc : DFF + 128 * tl + cc - 128;
                w.src = a.in[20] + (size_t)(32 * kb) * NUP + sn; w.ldn = NUP; w.g = a.in[19] + 32 * kb; w.dst = (bf16*)(ws + WS_WUP) + (size_t)dn * D + 32 * kb; w.frag = 0; return; } r -= I_UP;
            { const int nb = r / 88, kb = r % 88, dn = 64 * nb + lane;
                w.src = a.in[23] + (size_t)(32 * kb) * D + dn; w.ldn = D; w.g = nullptr; w.dst = (bf16*)(ws + WS_WDN) + (size_t)dn * DFF + 32 * kb; w.frag = 0; }
        };
        for (int it = gw; it < NITEMS; it += 2 * NGW) {
            const bool two = it + NGW < NITEMS;
            WItem w0, w1; decode(it, w0); decode(two ? it + NGW : it, w1);
            float v0[32], v1[32];
#pragma unroll
            for (int i = 0; i < 32; ++i) v0[i] = w0.src[(size_t)i * w0.ldn];
            if (two) {
#pragma unroll
                for (int i = 0; i < 32; ++i) v1[i] = w1.src[(size_t)i * w1.ldn]; }
            if (w0.g) {
#pragma unroll
                for (int i = 0; i < 32; ++i) v0[i] *= w0.g[i]; }
            if (two && w1.g) {
#pragma unroll
                for (int i = 0; i < 32; ++i) v1[i] *= w1.g[i]; }
#pragma unroll
            for (int j = 0; j < 4; ++j) *(v4u*)(w0.dst + (w0.frag ? j * 128 : 8 * j)) = pack8(v0 + 8 * j);
            if (two) {
#pragma unroll
                for (int j = 0; j < 4; ++j) *(v4u*)(w1.dst + (w1.frag ? j * 128 : 8 * j)) = pack8(v1 + 8 * j); }
        }
    }
    {
        const float* lre = a.in[6]; const float* lim = a.in[7]; const float* lst = a.in[8]; const float* bre = a.in[9]; const float* bim = a.in[10]; const float* cre = a.in[11]; const float* cim = a.in[12];
        float* LB = (float*)(ws + WS_TAB + TB_LB); bf16* BBP = (bf16*)(ws + WS_TAB + TB_BBP); unsigned* CP = (unsigned*)(ws + WS_TAB + TB_CP);
        for (int j = gw * 64 + lane; j < NG * NP * GS; j += NGW * 64) {
            const int i = j >> 4, h = j & 15, g = i / NP, p = i % NP, n = p & 31, slot = p >> 5;
            const float lr = lre[i], li = lim[i], lsv = lst[g], br = bre[j], bi = bim[j], cr = cre[(size_t)(g * GS + h) * NP + p], ci = cim[(size_t)(g * GS + h) * NP + p];
            const float step = expf(lsv), er = expf(lr * step), ar = er * cosf(li * step), ai = er * sinf(li * step);
            const float nr = ar - 1.f, ni = ai, den = lr * lr + li * li;
            const float fr = (nr * lr + ni * li) / den, fi = (ni * lr - nr * li) / den;
            if (h == 0) { LB[2 * i] = ar; LB[2 * i + 1] = ai; }
            BBP[((size_t)(g * 4 + slot) * 32 + n) * 16 + h] = (bf16)f2bf(fr * br - fi * bi); BBP[((size_t)(g * 4 + 2 + slot) * 32 + n) * 16 + h] = (bf16)f2bf(fr * bi + fi * br);
            CP[(size_t)(g * GS + h) * 64 + p] = pk2(cr, -ci);
        }
    }
}

__device__ __forceinline__ void cumsum_bh(const Args& a, int bh, int lane) {
    const float* logf = (const float*)(a.ws + WS_TAB + TB_LOGF); float* cum = (float*)(a.ws + WS_TAB + TB_CUM);
    const int b = bh / NH, h = bh % NH; float loc[32]; float t = 0.f;
#pragma unroll
    for (int i = 0; i < 32; ++i) { t += logf[((size_t)b * SEQ + 32 * lane + i) * 8 + h]; loc[i] = t; }
    float incl = t;
#pragma unroll
    for (int o = 1; o < 64; o <<= 1) { const float nn = __shfl_up(incl, o); if (lane >= o) incl += nn; }
    const float excl = incl - t;
#pragma unroll
    for (int i = 0; i < 32; ++i) cum[(size_t)bh * SEQ + 32 * lane + i] = (loc[i] + excl) * 1.4426950408889634f;
}

__device__ __forceinline__ float gelu_tanh(float x) { const float u = 0.7978845608028654f * (x + 0.044715f * x * x * x); const float e = __expf(2.f * u); return x * (1.f - __builtin_amdgcn_rcpf(e + 1.f)); }
typedef short s16x8 __attribute__((ext_vector_type(8)));
typedef float v2f __attribute__((ext_vector_type(2)));
typedef float f32x16v __attribute__((ext_vector_type(16)));
#define CFMA(xr, xi, lr, li, br, bi) do { const float nr_ = fmaf(lr, xr, fmaf(-(li), xi, br)), ni_ = fmaf(lr, xi, fmaf(li, xr, bi)); xr = nr_; xi = ni_; } while (0)
#define CSQR(r, i) do { const float nr_ = r * r - i * i, ni_ = 2.f * r * i; r = nr_; i = ni_; } while (0)
__device__ __forceinline__ void ssm_a_unit(const Args& a, int unit, int wave, int lane) {
    unsigned char* ws = a.ws;
    const int b = unit >> 5, c = unit & 31; const size_t t0 = (size_t)b * SEQ + 64 * c;
    const int n = lane & 31, hi = lane >> 5, sig = 16 * ((n >> 2) & 1) + 4 * (n >> 3) + (n & 3);
    const bf16* U = (const bf16*)(ws + WS_U); const float* LB = (const float*)(ws + WS_TAB + TB_LB); const bf16* BBP = (const bf16*)(ws + WS_TAB + TB_BBP); float* SS = (float*)(ws + WS_SS);
    const f32x16v zero = f32x16v{};
#pragma unroll 1
    for (int gi = 0; gi < 4; ++gi) {
        const int g = wave * 4 + gi;
        float lr[2], li[2], l16r[2], l16i[2];
#pragma unroll
        for (int sl = 0; sl < 2; ++sl) { lr[sl] = LB[2 * (g * NP + n + 32 * sl)]; li[sl] = LB[2 * (g * NP + n + 32 * sl) + 1]; l16r[sl] = lr[sl]; l16i[sl] = li[sl];
#pragma unroll
            for (int q = 0; q < 4; ++q) CSQR(l16r[sl], l16i[sl]); }
        s16x8 bfr[4];
#pragma unroll
        for (int nb = 0; nb < 4; ++nb) bfr[nb] = *(const s16x8*)(BBP + ((size_t)(g * 4 + nb) * 32 + n) * 16 + 8 * hi);
        float tr[2] = {0.f, 0.f}, ti[2] = {0.f, 0.f};
#pragma unroll
        for (int sb = 0; sb < 2; ++sb) {
            const s16x8 afr = *(const s16x8*)(U + (t0 + 32 * sb + sig) * SW + 16 * g + 8 * hi);
            f32x16v d[4];
#pragma unroll
            for (int nb = 0; nb < 4; ++nb) d[nb] = __builtin_amdgcn_mfma_f32_32x32x16_bf16(afr, bfr[nb], zero, 0, 0, 0);
#pragma unroll
            for (int sl = 0; sl < 2; ++sl) { float sr = 0.f, si = 0.f;
#pragma unroll
                for (int r = 0; r < 16; ++r) CFMA(sr, si, lr[sl], li[sl], d[sl][r], d[2 + sl][r]);
                if (sb == 0) { float qr = l16r[sl], qi = l16i[sl]; CSQR(qr, qi); tr[sl] = qr * sr - qi * si; ti[sl] = qr * si + qi * sr; }
                else { tr[sl] += sr; ti[sl] += si; } }
        }
#pragma unroll
        for (int sl = 0; sl < 2; ++sl) {
            float vr = tr[sl], vi = ti[sl];
            if (hi == 0) { const float nr = l16r[sl] * vr - l16i[sl] * vi, ni = l16r[sl] * vi + l16i[sl] * vr; vr = nr; vi = ni; }
            vr += __shfl_xor(vr, 32); vi += __shfl_xor(vi, 32);
            if (hi == 0) { float* o = SS + ((((size_t)b * 32 + c) * NG + g) * NP + n + 32 * sl) * 2; o[0] = vr; o[1] = vi; }
        }
    }
}
constexpr int XT_PITCH = 68, XT_BYTES = 32 * XT_PITCH * 4, YT_OFF = 8 * XT_BYTES, YT_PITCH = 1040, RED_OFF = YT_OFF + 64 * YT_PITCH;
static_assert(RED_OFF + 2048 <= LDS_BYTES, "ssm LDS");
__device__ __forceinline__ void ssm_b_unit(const Args& a, LAS unsigned char* lds, int unit, int wave, int lane) {
    unsigned char* ws = a.ws;
    const int b = unit >> 5, c = unit & 31; const size_t t0 = (size_t)b * SEQ + 64 * c;
    const int n = lane & 31, hi = lane >> 5, fr = lane & 15, fq = lane >> 4, sig = 16 * ((n >> 2) & 1) + 4 * (n >> 3) + (n & 3);
    const bf16* U = (const bf16*)(ws + WS_U); const float* LB = (const float*)(ws + WS_TAB + TB_LB); const bf16* BBP = (const bf16*)(ws + WS_TAB + TB_BBP);
    const bf16* CP = (const bf16*)(ws + WS_TAB + TB_CP); const float* SS = (const float*)(ws + WS_SS); const float* dsk = a.in[13];
    LAS unsigned* XT = (LAS unsigned*)(lds + wave * XT_BYTES);
    LAS unsigned char* YT = lds + YT_OFF; LAS float* RED = (LAS float*)(lds + RED_OFF);
    const f32x16v zero = f32x16v{};
    float xcrA[4][2], xciA[4][2];
    {
        float l128r[4][2], l128i[4][2], wr_[4][2], wi_[4][2];
#pragma unroll
        for (int gi = 0; gi < 4; ++gi)
#pragma unroll
            for (int sl = 0; sl < 2; ++sl) { const int g = wave * 4 + gi; const v2f lb = *(const v2f*)(LB + 2 * (g * NP + n + 32 * sl));
                float r = lb.x, i = lb.y;
#pragma unroll
                for (int q = 0; q < 4; ++q) CSQR(r, i);
                CSQR(r, i); CSQR(r, i);
                wr_[gi][sl] = hi ? r : 1.f; wi_[gi][sl] = hi ? i : 0.f; CSQR(r, i); l128r[gi][sl] = r; l128i[gi][sl] = i; xcrA[gi][sl] = 0.f; xciA[gi][sl] = 0.f; }
        const float* sp0 = SS + ((((size_t)b * 32) * NG + wave * 4) * NP + n) * 2;
#pragma unroll 2
        for (int k = hi; k < c; k += 2) {
#pragma unroll
            for (int gi = 0; gi < 4; ++gi)
#pragma unroll
                for (int sl = 0; sl < 2; ++sl) { const v2f sv = *(const v2f*)(sp0 + (size_t)(c - 1 - k) * NG * NP * 2 + (gi * NP + 32 * sl) * 2);
                    xcrA[gi][sl] += wr_[gi][sl] * sv.x - wi_[gi][sl] * sv.y; xciA[gi][sl] += wr_[gi][sl] * sv.y + wi_[gi][sl] * sv.x;
                    const float nwr = wr_[gi][sl] * l128r[gi][sl] - wi_[gi][sl] * l128i[gi][sl], nwi = wr_[gi][sl] * l128i[gi][sl] + wi_[gi][sl] * l128r[gi][sl]; wr_[gi][sl] = nwr; wi_[gi][sl] = nwi; } }
#pragma unroll
        for (int gi = 0; gi < 4; ++gi)
#pragma unroll
            for (int sl = 0; sl < 2; ++sl) { xcrA[gi][sl] += __shfl_xor(xcrA[gi][sl], 32); xciA[gi][sl] += __shfl_xor(xciA[gi][sl], 32); }
    }
#pragma unroll 1
    for (int gp = 0; gp < 2; ++gp)
#pragma unroll
    for (int gi2 = 0; gi2 < 2; ++gi2) {
        const int gi = 2 * gp + gi2, g = wave * 4 + gi;
        float lr[2], li[2], l16r[2], l16i[2], xcr[2], xci[2];
#pragma unroll
        for (int sl = 0; sl < 2; ++sl) { const v2f lb = *(const v2f*)(LB + 2 * (g * NP + n + 32 * sl)); lr[sl] = lb.x; li[sl] = lb.y; l16r[sl] = lb.x; l16i[sl] = lb.y;
#pragma unroll
            for (int q = 0; q < 4; ++q) CSQR(l16r[sl], l16i[sl]);
            xcr[sl] = gp ? xcrA[2 + gi2][sl] : xcrA[gi2][sl]; xci[sl] = gp ? xciA[2 + gi2][sl] : xciA[gi2][sl]; }
        s16x8 bfr[4], cfr[4];
#pragma unroll
        for (int nb = 0; nb < 4; ++nb) bfr[nb] = *(const s16x8*)(BBP + ((size_t)(g * 4 + nb) * 32 + n) * 16 + 8 * hi);
#pragma unroll
        for (int kk = 0; kk < 4; ++kk) cfr[kk] = *(const s16x8*)(CP + (size_t)(g * GS + fr) * 128 + 32 * kk + 8 * fq);
        const f32x4 dk = *(const f32x4*)(dsk + g * GS + 4 * fq);
#pragma unroll
        for (int sb = 0; sb < 2; ++sb) {
            const s16x8 afr = *(const s16x8*)(U + (t0 + 32 * sb + sig) * SW + 16 * g + 8 * hi);
            f32x16v d[4];
#pragma unroll
            for (int nb = 0; nb < 4; ++nb) d[nb] = __builtin_amdgcn_mfma_f32_32x32x16_bf16(afr, bfr[nb], zero, 0, 0, 0);
#pragma unroll
            for (int sl = 0; sl < 2; ++sl) {
                float sr = 0.f, si = 0.f;
#pragma unroll
                for (int r = 0; r < 16; ++r) CFMA(sr, si, lr[sl], li[sl], d[sl][r], d[2 + sl][r]);
                const float orr = __shfl_xor(sr, 32), oii = __shfl_xor(si, 32);
                const float ser = hi ? orr : sr, sei = hi ? oii : si, sor = hi ? sr : orr, soi = hi ? si : oii;
                float xnr = xcr[sl], xni = xci[sl]; CFMA(xnr, xni, l16r[sl], l16i[sl], ser, sei);
                float xr = hi ? xnr : xcr[sl], xi = hi ? xni : xci[sl];
                float x2r = xnr, x2i = xni; CFMA(x2r, x2i, l16r[sl], l16i[sl], sor, soi); xcr[sl] = x2r; xci[sl] = x2i;
#pragma unroll
                for (int r = 0; r < 16; ++r) { CFMA(xr, xi, lr[sl], li[sl], d[sl][r], d[2 + sl][r]); XT[(16 * hi + r) * XT_PITCH + n + 32 * sl] = pg8::cvt_pk_bf16(xr, xi); }
            }
#pragma unroll
            for (int mb = 0; mb < 2; ++mb) {
                f32x4 acc = (f32x4){0.f, 0.f, 0.f, 0.f};
#pragma unroll
                for (int kk = 0; kk < 4; ++kk) { const s16x8 xf = *(const LAS s16x8*)(XT + (16 * mb + fr) * XT_PITCH + 16 * kk + 4 * fq); acc = __builtin_amdgcn_mfma_f32_16x16x32_bf16(cfr[kk], xf, acc, 0, 0, 0); }
                const int s = 32 * sb + 16 * mb + fr;
                const v2u uw = *(const v2u*)(U + (t0 + s) * SW + 16 * g + 4 * fq);
                const float y0 = gelu_tanh(acc[0] + dk[0] * bf2f(uw.x & 0xffffu)), y1 = gelu_tanh(acc[1] + dk[1] * bf2f(uw.x >> 16)), y2 = gelu_tanh(acc[2] + dk[2] * bf2f(uw.y & 0xffffu)), y3 = gelu_tanh(acc[3] + dk[3] * bf2f(uw.y >> 16));
                v2u yw; yw.x = pg8::cvt_pk_bf16(y0, y1); yw.y = pg8::cvt_pk_bf16(y2, y3);
                *(LAS v2u*)(YT + s * YT_PITCH + (16 * g + 4 * fq) * 2) = yw;
            }
        }
    }
    __syncthreads();
    const bf16* WG = (const bf16*)(ws + WS_WGLU); const float* bg = a.in[15]; bf16* MIX = (bf16*)(ws + WS_MIX);
    f32x4 acc[4][4];
#pragma unroll
    for (int mb = 0; mb < 4; ++mb)
#pragma unroll
        for (int nb = 0; nb < 4; ++nb) acc[mb][nb] = (f32x4){0.f, 0.f, 0.f, 0.f};
    s16x8 wq[4][4];
    const bf16* wpf = WG + ((size_t)(4 * wave) * 64 + lane) * 8;
#pragma unroll
    for (int st = 0; st < 3; ++st) {
#pragma unroll
        for (int nb = 0; nb < 4; ++nb) wq[st][nb] = *(const s16x8*)(wpf + nb * 512);
        wpf += 32 * 512; }
#pragma unroll 1
    for (int kk4 = 0; kk4 < 16; kk4 += 4) {
        asm volatile("" : "+v"(wpf));
#pragma unroll
        for (int j = 0; j < 4; ++j) {
            const int kk = kk4 + j;
            s16x8 wf[4], yf[4];
#pragma unroll
            for (int nb = 0; nb < 4; ++nb) wf[nb] = wq[j][nb];
            if (kk + 3 < 16) {
#pragma unroll
                for (int nb = 0; nb < 4; ++nb) wq[(j + 3) & 3][nb] = *(const s16x8*)(wpf + nb * 512);
                wpf += 32 * 512; }
#pragma unroll
            for (int mb = 0; mb < 4; ++mb) yf[mb] = *(const LAS s16x8*)(YT + (16 * mb + fr) * YT_PITCH + (32 * kk + 8 * fq) * 2);
#pragma unroll
            for (int mb = 0; mb < 4; ++mb)
#pragma unroll
                for (int nb = 0; nb < 4; ++nb) acc[mb][nb] = __builtin_amdgcn_mfma_f32_16x16x32_bf16(wf[nb], yf[mb], acc[mb][nb], 0, 0, 0);
        }
    }
#pragma unroll
    for (int mb = 0; mb < 4; ++mb) { float q = 0.f;
#pragma unroll
        for (int nb = 0; nb < 4; ++nb) { const int n0 = 64 * wave + 16 * nb + 4 * fq; const f32x4 bv = *(const f32x4*)(bg + n0);
            const v2u yw = *(const LAS v2u*)(YT + (16 * mb + fr) * YT_PITCH + n0 * 2);
            const float y[4] = {bf2f(yw.x & 0xffffu), bf2f(yw.x >> 16), bf2f(yw.y & 0xffffu), bf2f(yw.y >> 16)};
#pragma unroll
            for (int j = 0; j < 4; ++j) { const float o = y[j] * __builtin_amdgcn_rcpf(1.f + __expf(-(acc[mb][nb][j] + bv[j]))); acc[mb][nb][j] = o; q += o * o; } }
        q += __shfl_xor(q, 16); q += __shfl_xor(q, 32);
        if (fq == 0) RED[wave * 64 + 16 * mb + fr] = q; }
    __syncthreads();
#pragma unroll
    for (int mb = 0; mb < 4; ++mb) { const int s = 16 * mb + fr; float tot = 0.f;
#pragma unroll
        for (int w = 0; w < 8; ++w) tot += RED[w * 64 + s];
        const float rstd = 1.f / sqrtf(tot * (1.f / SW) + EPS);
#pragma unroll
        for (int nb = 0; nb < 4; ++nb) { v2u ow; ow.x = pg8::cvt_pk_bf16(acc[mb][nb][0] * rstd, acc[mb][nb][1] * rstd); ow.y = pg8::cvt_pk_bf16(acc[mb][nb][2] * rstd, acc[mb][nb][3] * rstd);
            *(v2u*)(MIX + (t0 + s) * D + AW + 64 * wave + 16 * nb + 4 * fq) = ow; } }
    { v4u w[8];
#pragma unroll
      for (int r = 0; r < 8; ++r) w[r] = *(const v4u*)(MIX + (t0 + wave * 8 + r) * D + 8 * lane);
#pragma unroll
      for (int r = 0; r < 8; ++r) { float f[8]; unpack8(w[r], f); float q = 0.f;
#pragma unroll
          for (int i = 0; i < 8; ++i) q += f[i] * f[i];
          const float rstd = 1.f / sqrtf(wave_sum(q) * (1.f / AW) + EPS);
#pragma unroll
          for (int i = 0; i < 8; ++i) f[i] *= rstd;
          *(v4u*)(MIX + (t0 + wave * 8 + r) * D + 8 * lane) = pack8(f); } }
    __syncthreads();
}

__device__ __forceinline__ void p_fixup(const Args& a, int pm, int tid) {
    const float* HALO = (const float*)(a.ws + WS_HALO); bf16* ACT = (bf16*)(a.ws + WS_ACT); const float* cw = a.in[21]; const float* cb = a.in[22];
    if ((pm & 7) == 0) return;
    const float* hp = HALO + (size_t)(pm - 1) * 4 * 5632; const float* hc = HALO + (size_t)pm * 4 * 5632;
    v2u res[3];
#pragma unroll
    for (int k = 0; k < 3; ++k) {
        const int it = tid + k * NTHR, itc = it < 2 * (DFF / 4) ? it : 0, r = itc / (DFF / 4), ac = (itc % (DFF / 4)) * 4, cg = (ac >> 7) * 256 + (ac & 127), cv = cg + 128;
        const f32x4 g0 = *(const f32x4*)((r ? hp + 5632 : hp) + cg), g1 = *(const f32x4*)((r ? hc + 2 * 5632 : hp + 5632) + cg), g2 = *(const f32x4*)((r ? hc + 3 * 5632 : hc + 2 * 5632) + cg);
        const f32x4 v0 = *(const f32x4*)((r ? hp + 5632 : hp) + cv), v1 = *(const f32x4*)((r ? hc + 2 * 5632 : hp + 5632) + cv), v2 = *(const f32x4*)((r ? hc + 3 * 5632 : hc + 2 * 5632) + cv);
        const f32x4 hg = *(const f32x4*)(cb + ac) + *(const f32x4*)(cw + ac) * g0 + *(const f32x4*)(cw + NUP + ac) * g1 + *(const f32x4*)(cw + 2 * NUP + ac) * g2;
        const f32x4 hv = *(const f32x4*)(cb + DFF + ac) + *(const f32x4*)(cw + DFF + ac) * v0 + *(const f32x4*)(cw + NUP + DFF + ac) * v1 + *(const f32x4*)(cw + 2 * NUP + DFF + ac) * v2;
        float o[4];
#pragma unroll
        for (int i = 0; i < 4; ++i) o[i] = hg[i] * __builtin_amdgcn_rcpf(1.f + __expf(-hg[i])) * hv[i];
        res[k].x = pk2(o[0], o[1]); res[k].y = pk2(o[2], o[3]);
    }
#pragma unroll
    for (int k = 0; k < 3; ++k) { const int it = tid + k * NTHR; if (it < 2 * (DFF / 4)) { const int r = it / (DFF / 4), ac = (it % (DFF / 4)) * 4; *(v2u*)(ACT + (size_t)(pm * 256 + r) * DFF + ac) = res[k]; } }
}

#define XB_TMO      128
#define XB_XCNT(j)  (256  + 64 * (j))
#define XB_XSUB(j)  (1280 + 64 * (j))
#define XB_XGEN(j)  (2304 + 64 * (j))
#define XB_TOP      3328
#define XB_TOPGEN   3392
#define XCD_BAR_WORDS 3456
#define XB_SPIN_CAP (1u << 18)

__device__ __forceinline__ unsigned xb_ld(unsigned* p)              { return __hip_atomic_load(p, __ATOMIC_RELAXED, __HIP_MEMORY_SCOPE_AGENT); }
__device__ __forceinline__ unsigned xb_add(unsigned* p, unsigned v) { return __hip_atomic_fetch_add(p, v, __ATOMIC_RELAXED, __HIP_MEMORY_SCOPE_AGENT); }
__device__ __forceinline__ unsigned xb_xcc_id() { return (unsigned)__builtin_amdgcn_s_getreg((3 << 11) | 20) & 0xFu; }
#define XB_SPIN(cond, bar) do { unsigned _sp = 0; while (cond) { __builtin_amdgcn_s_sleep(1); \
    if ((++_sp & 255u) == 0u) { if (xb_ld(&(bar)[XB_TMO])) break; if (_sp > XB_SPIN_CAP) { atomicAdd(&(bar)[XB_TMO], 1u); break; } } } } while (0)

struct XcdBarrier {
    unsigned* bar; unsigned x;
    volatile LAS unsigned* st;
};

__device__ __forceinline__ XcdBarrier xcd_barrier_post(unsigned* bar, volatile LAS unsigned* st) {
    XcdBarrier b; b.bar = bar; b.x = xb_xcc_id(); b.st = st;
    if (threadIdx.x == 0) (void)xb_add(&bar[XB_XCNT(b.x)], 1u);
    return b;
}
__device__ __forceinline__ void xcd_barrier_complete(unsigned* bar, unsigned x, unsigned& nloc, unsigned& nx) {
    const unsigned G = gridDim.x * gridDim.y * gridDim.z;
    unsigned sum, cnt, mine, sp = 0u;
    for (;;) {
        sum = 0u; cnt = 0u; mine = 0u;
#pragma unroll
        for (unsigned j = 0; j < 16; ++j) { const unsigned c = xb_ld(&bar[XB_XCNT(j)]); sum += c; cnt += (c > 0u) ? 1u : 0u; mine = (j == x) ? c : mine; }
        if (sum == G) break;
        __builtin_amdgcn_s_sleep(1);
        if ((++sp & 255u) == 0u) { if (xb_ld(&bar[XB_TMO])) break; if (sp > XB_SPIN_CAP) { atomicAdd(&bar[XB_TMO], 1u); break; } }
    }
    nloc = mine > 0u ? mine : 1u; nx = cnt > 0u ? cnt : 1u;
}

__device__ __forceinline__ void xcd_barrier(const XcdBarrier& b) {
    asm volatile("s_waitcnt vmcnt(0)" ::: "memory");
    __syncthreads();
    if (threadIdx.x == 0) {
        unsigned* bar = b.bar;
        __builtin_amdgcn_s_waitcnt(0);
        unsigned nloc = b.st[0], nx = b.st[1];
        if (nloc == 0u) { xcd_barrier_complete(bar, b.x, nloc, nx); b.st[0] = nloc; b.st[1] = nx; }
        const unsigned old = xb_add(&bar[XB_XSUB(b.x)], 1u);
        const unsigned gen = old / nloc;
        if (old + 1u == (gen + 1u) * nloc) {
            __builtin_amdgcn_fence(__ATOMIC_RELEASE, "agent");
            asm volatile("s_waitcnt vmcnt(0)" ::: "memory");
            const unsigned og = xb_add(&bar[XB_TOP], 1u);
            const unsigned tg = og / nx;
            if (og + 1u == (tg + 1u) * nx) xb_add(&bar[XB_TOPGEN], 1u);
            else XB_SPIN(xb_ld(&bar[XB_TOPGEN]) == tg, bar);
            __builtin_amdgcn_fence(__ATOMIC_ACQUIRE, "agent");
            xb_add(&bar[XB_XGEN(b.x)], 1u);
            asm volatile("s_waitcnt vmcnt(0)" ::: "memory");
        } else {
            XB_SPIN(xb_ld(&bar[XB_XGEN(b.x)]) == gen, bar);
            __builtin_amdgcn_fence(__ATOMIC_ACQUIRE, "agent");
            asm volatile("s_waitcnt vmcnt(0)" ::: "memory");
        }
    }
    __syncthreads();
}

__global__ void __launch_bounds__(NTHR, 2) fwd_kernel(Args args) {
    extern __shared__ __attribute__((aligned(16))) unsigned char lds_raw[];
    LAS unsigned char* lds = (LAS unsigned char*)lds_raw;
    cg::grid_group grid = cg::this_grid();
    int tid = threadIdx.x, lane = tid & 63; const int wave = __builtin_amdgcn_readfirstlane(tid >> 6);
    const int G = gridDim.x, bx = blockIdx.x, vcu = (G % 8 == 0) ? (bx % 8) * (G / 8) + bx / 8 : bx;
    const int gw = vcu * NWAVES + wave, NGW = G * NWAVES, NT = G * NTHR; int gtid = vcu * NTHR + tid;
    unsigned char* ws = args.ws;
    const int lo = args.ph_lo, hi = args.ph_hi;
    volatile LAS unsigned* MISC = (volatile LAS unsigned*)(lds + LDS_BYTES - 128);
    if (tid < 32) MISC[tid] = 0u;
    __syncthreads();
    XcdBarrier bar; bar.bar = (unsigned*)ws + 4096; bar.x = 0; bar.st = nullptr;
    if (hi - lo > 1) {
        if (bx == 0) for (int i = tid; i < XCD_BAR_WORDS; i += NTHR) ((unsigned*)ws)[4096 + i] = 0u;
        grid.sync();
        bar = xcd_barrier_post((unsigned*)ws + 4096, MISC + 8); }
#define IN(k) (lo <= (k) && (k) < hi)
#define REFRESH() do { int t_ = threadIdx.x; asm volatile("" : "+v"(t_)); tid = t_; lane = tid & 63; gtid = vcu * NTHR + tid; } while (0)
#define SYNC(k) do { if (IN(k) && IN((k) + 1)) xcd_barrier(bar); REFRESH(); } while (0)
    if (IN(0)) { p0_prologue(args, lds, vcu, gw, NGW, tid, wave, lane); } SYNC(0);
    if (IN(1)) {
        if (bx < BATCH * NH && wave == 0) cumsum_bh(args, bx, lane);
        pg8::Gemm g{(const pg8::bf16_t*)(ws + WS_XB), (const pg8::bf16_t*)(ws + WS_WIN), M, 2048, D}; pg8::StaticOrder S; S.init(M, 2048, G, bx);
        pg8::EpiIn E{(const float*)(ws + WS_TAB + TB_RSTD1), args.in[4], args.in[5], (pg8::bf16_t*)(ws + WS_Q), (size_t)M * AW, attn_body::C2};
        pg8::gemm_phase<pg8::EpiIn, pg8::StaticOrder, true, true>(lds, g, S, E);
    } SYNC(1);
    if (IN(2)) {
        { const attn_body::AttnTensors AT{(const attn_body::bf16*)(ws + WS_Q), (const attn_body::bf16*)(ws + WS_K), (const attn_body::bf16*)(ws + WS_V), (attn_body::bf16*)(ws + WS_MIX), (const float*)(ws + WS_TAB + TB_CUM)};
          const attn_body::StaticOrder AS(G, bx); attn_body::attn_phase<attn_body::StaticOrder, 64>((char*)lds_raw, AT, AS); }
        for (int u = bx; u < BATCH * 32; u += G) ssm_a_unit(args, u, wave, lane);
    } SYNC(2);
    if (IN(3)) {
        for (int u = bx; u < BATCH * 32; u += G) ssm_b_unit(args, lds, u, wave, lane);
    } SYNC(3);
    if (IN(4)) {
        pg8::Gemm g{(const pg8::bf16_t*)(ws + WS_MIX), (const pg8::bf16_t*)(ws + WS_WOUT), M, D, D}; pg8::StaticOrder S; S.init(M, D, G, bx);
        pg8::EpiX1 E{args.in[0], args.out, (pg8::bf16_t*)(ws + WS_XB), (float*)(ws + WS_TAB + TB_SSQ2), D};
        pg8::gemm_phase<pg8::EpiX1, pg8::StaticOrder, true, true>(lds, g, S, E);
    } SYNC(4);
    if (IN(5)) {
        pg8::Gemm g{(const pg8::bf16_t*)(ws + WS_XB), (const pg8::bf16_t*)(ws + WS_WUP), M, NUP, D}; pg8::StaticOrder S; S.init(M, NUP, G, bx);
        pg8::EpiUpConv E{(const float*)(ws + WS_TAB + TB_SSQ2), args.in[21], args.in[22], (pg8::bf16_t*)(ws + WS_ACT), (float*)(ws + WS_HALO), (LAS float*)(lds + RING_BYTES)};
        pg8::gemm_phase<pg8::EpiUpConv, pg8::StaticOrder, true, true>(lds, g, S, E);
    } SYNC(5);
    if (IN(6)) {
        pg8::Gemm g{(const pg8::bf16_t*)(ws + WS_ACT), (const pg8::bf16_t*)(ws + WS_WDN), M, D, DFF}; pg8::StaticOrder S; S.init(M, D, G, bx);
        { pg8::Unit u0; for (int i = 0; S.next(i, u0); ++i) p_fixup(args, u0.pm, tid); asm volatile("s_waitcnt vmcnt(0)" ::: "memory"); __syncthreads(); }
        pg8::EpiResB E{(const pg8::bf16_t*)(ws + WS_XB), args.out, D};
        pg8::gemm_phase<pg8::EpiResB, pg8::StaticOrder, true, true>(lds, g, S, E);
    }
#undef IN
#undef SYNC
}

constexpr int N_PHASES = 7;
#ifndef MK_MULTI
#define MK_MULTI 0
#endif
extern "C" void kernel_launch(void* const* d_in, const int* in_sizes, int n_in, void* d_out, int out_size, void* d_ws, size_t ws_size, hipStream_t stream) {
    static int grid = 0;
    if (grid == 0) {
        if (n_in != 24 || out_size != M * D || ws_size < WS_END) { fprintf(stderr, "kernel_launch: unexpected sizes n_in %d out %d ws %zu\n", n_in, out_size, ws_size); grid = -1; return; }
        int dev = 0, cus = 0, per_cu = 0;
        hipGetDevice(&dev); hipDeviceGetAttribute(&cus, hipDeviceAttributeMultiprocessorCount, dev);
        hipFuncSetAttribute((const void*)fwd_kernel, hipFuncAttributeMaxDynamicSharedMemorySize, LDS_BYTES);
        hipOccupancyMaxActiveBlocksPerMultiprocessor(&per_cu, (const void*)fwd_kernel, NTHR, LDS_BYTES);
        (void)hipGetLastError();
        if (per_cu < 1) { fprintf(stderr, "kernel_launch: occupancy query says %d blocks per CU\n", per_cu); per_cu = 1; }
        grid = cus * 1;
        fprintf(stderr, "kernel_launch: cus %d per_cu %d grid %d\n", cus, per_cu, grid);
    }
    if (grid < 0) return;
    Args a{};
    for (int i = 0; i < 24; ++i) a.in[i] = (const float*)d_in[i];
    a.out = (float*)d_out; a.ws = (unsigned char*)d_ws;
#if MK_MULTI
    for (int p = 0; p < N_PHASES; ++p) { a.ph_lo = p; a.ph_hi = p + 1; hipLaunchKernelGGL(fwd_kernel, dim3(grid), dim3(NTHR), LDS_BYTES, stream, a); }
#else
    a.ph_lo = 0; a.ph_hi = N_PHASES;
    void* kargs[] = {&a};
    hipError_t e = hipLaunchCooperativeKernel((const void*)fwd_kernel, dim3(grid), dim3(NTHR), kargs, LDS_BYTES, stream);
    if (e != hipSuccess) fprintf(stderr, "cooperative launch failed: %s (grid %d)\n", hipGetErrorString(e), grid);
#endif
}
```

```cpp
#include <hip/hip_runtime.h>
#include <hip/hip_cooperative_groups.h>
#include <cstdio>
#include <cstdint>
namespace cg = cooperative_groups;
namespace pg8 {
#define PG8_LAS __attribute__((address_space(3)))
typedef unsigned short bf16_t;
typedef short bf16x8 __attribute__((ext_vector_type(8)));
typedef float f32x4 __attribute__((ext_vector_type(4)));
typedef unsigned u32x4 __attribute__((ext_vector_type(4)));
constexpr int BM = 256, BK = 64, HALF = 128, HTB = HALF * BK * 2  , STAGE_BYTES = 8 * HTB, NXCD = 8, WGM = 8;

__host__ __device__ __forceinline__ int lds_byte(int r, int c) { const int st = (r >> 4) * 2 + (c >> 5), rr = r & 15, cc = c & 31, ob = rr * 64 + cc * 2; return st * 1024 + (ob ^ (((ob >> 9) & 1) << 5)); }
__host__ __device__ __forceinline__ void stage_rc(int b, int& R, int& C) { const int st = b / 1024, sb = b % 1024, swz = sb ^ (((sb >> 9) & 1) << 5); R = (st >> 1) * 16 + swz / 64; C = (st & 1) * 32 + (swz % 64) / 2; }
__host__ __device__ __forceinline__ int perm32(int rho) { const int n = rho >> 4, i = rho & 15; return 8 * (i >> 2) + 4 * n + (i & 3); }

struct Unit { int pm, pn; };
struct Gemm { const bf16_t* A; const bf16_t* Bt; int M, N, K; };

struct StaticOrder {
    int nM, nN, nwg, G, c;
    __host__ __device__ void init(int M, int N, int G_, int c_) { nM = M / BM; nN = N / BM; nwg = nM * nN; G = G_; c = c_; }
    __host__ __device__ bool next(int i, Unit& u) const {
        const long L = (long)i * G + c; if (L >= nwg) return false;
        int wgid = (int)L; { const int q = nwg / NXCD, r = nwg % NXCD, xcd = wgid % NXCD, off = wgid / NXCD; wgid = (xcd < r ? xcd * (q + 1) : r * (q + 1) + (xcd - r) * q) + off; }
        const int nig = WGM * nN, gid = wgid / nig, fm = gid * WGM, gsz = (nM - fm) < WGM ? (nM - fm) : WGM;
        u.pm = fm + ((wgid % nig) % gsz); u.pn = (wgid % nig) / gsz; return true;
    }
    __device__ __forceinline__ void a_ready(const Unit&) const {}
    __device__ __forceinline__ void done(const Unit&) const {}
};

__device__ __forceinline__ unsigned cvt_pk_bf16(float lo, float hi) { unsigned r; asm volatile("v_cvt_pk_bf16_f32 %0, %1, %2" : "=v"(r) : "v"(lo), "v"(hi)); return r; }
typedef float f32x2 __attribute__((ext_vector_type(2)));
__device__ __forceinline__ f32x2 gelu_pk(f32x2 v) {
    const f32x2 av = __builtin_elementwise_abs(v), d = av * 0.2316418882f + 1.0f;
    f32x2 t; t.x = __builtin_amdgcn_rcpf(d.x); t.y = __builtin_amdgcn_rcpf(d.y);
    f32x2 q = t * 0.5307027145f + (-0.7265760135f); q = q * t + 0.7107068705f; q = q * t + (-0.142248368f); q = q * t + 0.127414796f; q = q * t;
    const f32x2 s = (v * v) * (-0.72134752044f);
    f32x2 e; e.x = __builtin_amdgcn_exp2f(s.x); e.y = __builtin_amdgcn_exp2f(s.y);
    const f32x2 m = v * (q * e), r = v - m;
    f32x2 o; o.x = v.x < 0.f ? m.x : r.x; o.y = v.y < 0.f ? m.y : r.y; return o;
}

template <int ACT  > struct EpiBf16 {
    static constexpr bool PERM = true, AFTER_DRAIN = false; static_assert(ACT == 0 || ACT == 1, "EpiBf16: ACT is 0 (none) or 1 (gelu_pk)");
    bf16_t* O; int ldc; const float* bias; int split_cols; size_t split_stride; float scale0;
    __device__ __forceinline__ void operator()(const f32x4 (&acc)[2][2][4][2], const Unit& u, int wr, int wc, int fr, int fq) const {
        const int row0 = u.pm * BM + wr * 64 + fr; int colt = u.pn * BM; bf16_t* base = O;
        float sc = 1.f; if (split_cols) { const int t = colt / split_cols; base += (size_t)t * split_stride; colt -= t * split_cols; if (t == 0) sc = scale0; }
        const int col0 = colt + wc * 32 + 8 * fq, bcol0 = u.pn * BM + wc * 32 + 8 * fq;
        f32x4 bv[2][2];
#pragma unroll
        for (int bj = 0; bj < 2; ++bj)
#pragma unroll
            for (int n = 0; n < 2; ++n) bv[bj][n] = bias ? *(const f32x4*)(bias + bcol0 + bj * HALF + 4 * n) : (f32x4){0.f, 0.f, 0.f, 0.f};
#pragma unroll
        for (int ai = 0; ai < 2; ++ai)
#pragma unroll
            for (int m = 0; m < 4; ++m) { bf16_t* rowp = base + (size_t)(row0 + ai * HALF + m * 16) * ldc + col0;
#pragma unroll
                for (int bj = 0; bj < 2; ++bj) { f32x4 v0 = acc[ai][bj][m][0] + bv[bj][0], v1 = acc[ai][bj][m][1] + bv[bj][1];
                    if (ACT == 1) { f32x2 a = gelu_pk((f32x2){v0[0], v0[1]}), b = gelu_pk((f32x2){v0[2], v0[3]}), c = gelu_pk((f32x2){v1[0], v1[1]}), d = gelu_pk((f32x2){v1[2], v1[3]});
                        v0 = (f32x4){a.x, a.y, b.x, b.y}; v1 = (f32x4){c.x, c.y, d.x, d.y}; }
                    v0 = v0 * sc; v1 = v1 * sc; u32x4 w; w.x = cvt_pk_bf16(v0[0], v0[1]); w.y = cvt_pk_bf16(v0[2], v0[3]); w.z = cvt_pk_bf16(v1[0], v1[1]); w.w = cvt_pk_bf16(v1[2], v1[3]);
                    *(u32x4*)(rowp + bj * HALF) = w; } }
    }
};

struct PanelStats {
    unsigned* xbuf;
    unsigned* cnt;
    unsigned* tmo;
    int ntn; float eps;
    unsigned code;
    __device__ __forceinline__ bool run(const f32x4 (&v)[2][2][4][2], const Unit& u, int wr, int wc, int fr, int fq, PG8_LAS unsigned char* lds, int wid, int lane) const {
        typedef float f32x2v __attribute__((ext_vector_type(2)));
        PG8_LAS f32x2v* P = (PG8_LAS f32x2v*)lds;
        PG8_LAS f32x2v* S = (PG8_LAS f32x2v*)(lds + 8192);
        PG8_LAS unsigned* flag = (PG8_LAS unsigned*)(lds + 8192 + 2048);
#pragma unroll
        for (int ai = 0; ai < 2; ++ai)
#pragma unroll
            for (int m = 0; m < 4; ++m) {
                float s = 0.f;
#pragma unroll
                for (int bj = 0; bj < 2; ++bj)
#pragma unroll
                    for (int n = 0; n < 2; ++n) { const f32x4 x = v[ai][bj][m][n]; s += (x[0] + x[1]) + (x[2] + x[3]); }
                s += __shfl_xor(s, 16); s += __shfl_xor(s, 32);
                const float mw = s * (1.0f / 64.0f); float q = 0.f;
#pragma unroll
                for (int bj = 0; bj < 2; ++bj)
#pragma unroll
                    for (int n = 0; n < 2; ++n) { const f32x4 d = v[ai][bj][m][n] - mw; q += (d[0] * d[0] + d[1] * d[1]) + (d[2] * d[2] + d[3] * d[3]); }
                q += __shfl_xor(q, 16); q += __shfl_xor(q, 32);
                if (fq == 0) P[(ai * HALF + wr * 64 + m * 16 + fr) * 4 + wc] = (f32x2v){mw, q};
            }
        asm volatile("s_waitcnt lgkmcnt(0)" ::: "memory"); __builtin_amdgcn_s_barrier(); asm volatile("" ::: "memory");
#if defined(BROKEN_EXCHANGE_NO_WAIT)
#warning BROKEN CONTROL BUILD: the row-statistics exchange does not wait; results are wrong by design
        if (blockIdx.x >= 64) { const long long t0_ = clock64(); while (clock64() - t0_ < 60000) __builtin_amdgcn_s_sleep(8); }
#endif
        const int row = wid * 32 + (lane & 31);
        if (lane < 32) {
            const f32x2v a = P[row * 4 + 0], b = P[row * 4 + 1], c = P[row * 4 + 2], d = P[row * 4 + 3];
            const float mt = (a.x + b.x + c.x + d.x) * 0.25f;
            const float da = a.x - mt, db = b.x - mt, dc = c.x - mt, dd = d.x - mt;
            const float m2 = (a.y + b.y) + (c.y + d.y) + 64.0f * ((da * da + db * db) + (dc * dc + dd * dd));
            unsigned long long* slot = (unsigned long long*)xbuf + ((size_t)(u.pm * BM + row) * 4 + u.pn);
            __hip_atomic_store(slot, ((unsigned long long)__float_as_uint(m2) << 32) | __float_as_uint(mt), __ATOMIC_RELAXED, __HIP_MEMORY_SCOPE_AGENT);
        }
        asm volatile("s_waitcnt vmcnt(0)" ::: "memory");
        if (lane == 0) __hip_atomic_fetch_add(cnt + 64 * u.pm, 1u, __ATOMIC_RELAXED, __HIP_MEMORY_SCOPE_AGENT);
        if (wid == 0) {
            bool dead = false; const unsigned long long t0 = __builtin_amdgcn_s_memrealtime(); const unsigned want = 8u * (unsigned)ntn;
            for (;;) {
#if defined(BROKEN_EXCHANGE_NO_WAIT)
                break;
#endif
                if ((unsigned)__builtin_amdgcn_readfirstlane(__hip_atomic_load(cnt + 64 * u.pm, __ATOMIC_RELAXED, __HIP_MEMORY_SCOPE_AGENT)) >= want) break;
                if (__builtin_amdgcn_s_memrealtime() - t0 > 2000000ull) {
                    if (lane == 0) { unsigned expect = 0u; __hip_atomic_compare_exchange_strong(tmo + 1, &expect, code | (unsigned)(u.pm & 0xff), __ATOMIC_RELAXED, __ATOMIC_RELAXED, __HIP_MEMORY_SCOPE_AGENT);
                                     __hip_atomic_store(tmo, 1u, __ATOMIC_RELAXED, __HIP_MEMORY_SCOPE_AGENT); }
                    dead = true; break; }
                __builtin_amdgcn_s_sleep(2);
            }
            __builtin_amdgcn_fence(__ATOMIC_ACQUIRE, "agent");
            if (lane == 0) flag[0] = dead ? 1u : 0u;
        }
        asm volatile("s_waitcnt vmcnt(0) lgkmcnt(0)" ::: "memory"); __builtin_amdgcn_s_barrier(); asm volatile("" ::: "memory");
        const bool bad = flag[0] != 0u;
        if (lane < 32) {
            const unsigned long long* slot = (const unsigned long long*)xbuf + (size_t)(u.pm * BM + row) * 4; float mt[4], m2[4]; float ms = 0.f;
#pragma unroll
            for (int t = 0; t < 4; ++t) { if (t < ntn) { const unsigned long long w = __hip_atomic_load(slot + t, __ATOMIC_RELAXED, __HIP_MEMORY_SCOPE_AGENT); mt[t] = __uint_as_float((unsigned)w); m2[t] = __uint_as_float((unsigned)(w >> 32)); } else { mt[t] = 0.f; m2[t] = 0.f; } ms += mt[t]; }
            const float mean = ms / (float)ntn; float q = 0.f;
#pragma unroll
            for (int t = 0; t < 4; ++t) if (t < ntn) { const float dm = mt[t] - mean; q += m2[t] + 256.0f * dm * dm; }
            S[row] = (f32x2v){mean, 1.0f / sqrtf(q / (256.0f * (float)ntn) + eps)};
        }
        asm volatile("s_waitcnt lgkmcnt(0)" ::: "memory"); __builtin_amdgcn_s_barrier(); asm volatile("" ::: "memory");
        return bad;
    }
};
struct EpiLnRes {
    static constexpr bool PERM = false, AFTER_DRAIN = true;
    const float* base; float* out; int ldc; const float* bias; PanelStats st; unsigned poison;
    __device__ __forceinline__ void fused(f32x4 (&acc)[2][2][4][2], const Unit& u, int wr, int wc, int fr, int fq, PG8_LAS unsigned char* lds, int wid, int lane) const {
        typedef float f32x2v __attribute__((ext_vector_type(2)));
        const PG8_LAS f32x2v* S = (const PG8_LAS f32x2v*)(lds + 8192);
        const int col0 = u.pn * BM + wc * 32 + 4 * fq;
#pragma unroll
        for (int bj = 0; bj < 2; ++bj)
#pragma unroll
            for (int n = 0; n < 2; ++n) { const f32x4 bv = bias ? *(const f32x4*)(bias + col0 + bj * HALF + n * 16) : (f32x4){0.f, 0.f, 0.f, 0.f};
#pragma unroll
                for (int ai = 0; ai < 2; ++ai)
#pragma unroll
                    for (int m = 0; m < 4; ++m) acc[ai][bj][m][n] += bv; }
        f32x4 pre[4][2][2];
#pragma unroll
        for (int m = 0; m < 4; ++m) { const size_t off = (size_t)(u.pm * BM + wr * 64 + m * 16 + fr) * ldc + col0;
#pragma unroll
            for (int bj = 0; bj < 2; ++bj)
#pragma unroll
                for (int n = 0; n < 2; ++n) pre[m][bj][n] = *(const f32x4*)(base + off + bj * HALF + n * 16); }
        const bool bad = st.run(acc, u, wr, wc, fr, fq, lds, wid, lane) || poison != 0u;
        const float qnan = __builtin_nanf("");
#pragma unroll
        for (int ai = 0; ai < 2; ++ai)
#pragma unroll
            for (int m = 0; m < 4; ++m) { const int r = ai * HALF + wr * 64 + m * 16 + fr; const f32x2v sr = S[r]; const size_t off = (size_t)(u.pm * BM + r) * ldc + col0;
#pragma unroll
                for (int bj = 0; bj < 2; ++bj)
#pragma unroll
                    for (int n = 0; n < 2; ++n) { const f32x4 bs = ai == 0 ? pre[m][bj][n] : *(const f32x4*)(base + off + bj * HALF + n * 16); f32x4 o = bs + (acc[ai][bj][m][n] - sr.x) * sr.y;
                        if (bad) o = (f32x4){qnan, qnan, qnan, qnan}; *(f32x4*)(out + off + bj * HALF + n * 16) = o; }
                if (m & 1) asm volatile("" ::: "memory"); }
    }
};
struct EpiLnResLn {
    static constexpr bool PERM = false, AFTER_DRAIN = true;
    const float* base; float* out; bf16_t* xn; int ldc; const float* bias; PanelStats st1, st2; unsigned poison;
    __device__ __forceinline__ void fused(f32x4 (&acc)[2][2][4][2], const Unit& u, int wr, int wc, int fr, int fq, PG8_LAS unsigned char* lds, int wid, int lane) const {
        typedef float f32x2v __attribute__((ext_vector_type(2))); typedef unsigned u32x2v __attribute__((ext_vector_type(2)));
        const PG8_LAS f32x2v* S = (const PG8_LAS f32x2v*)(lds + 8192);
        const int col0 = u.pn * BM + wc * 32 + 4 * fq;
#pragma unroll
        for (int bj = 0; bj < 2; ++bj)
#pragma unroll
            for (int n = 0; n < 2; ++n) { const f32x4 bv = bias ? *(const f32x4*)(bias + col0 + bj * HALF + n * 16) : (f32x4){0.f, 0.f, 0.f, 0.f};
#pragma unroll
                for (int ai = 0; ai < 2; ++ai)
#pragma unroll
                    for (int m = 0; m < 4; ++m) acc[ai][bj][m][n] += bv; }
        bool bad = st1.run(acc, u, wr, wc, fr, fq, lds, wid, lane) || poison != 0u;
        const float qnan = __builtin_nanf("");
#pragma unroll
        for (int ai = 0; ai < 2; ++ai)
#pragma unroll
            for (int m = 0; m < 4; ++m) { const int r = ai * HALF + wr * 64 + m * 16 + fr; const f32x2v sr = S[r]; const size_t off = (size_t)(u.pm * BM + r) * ldc + col0;
#pragma unroll
                for (int bj = 0; bj < 2; ++bj)
#pragma unroll
                    for (int n = 0; n < 2; ++n) { const f32x4 bs = *(const f32x4*)(base + off + bj * HALF + n * 16); acc[ai][bj][m][n] = bs + (acc[ai][bj][m][n] - sr.x) * sr.y; }
                asm volatile("" : "+v"(acc[ai][0][m][0]), "+v"(acc[ai][0][m][1]), "+v"(acc[ai][1][m][0]), "+v"(acc[ai][1][m][1]));
                if (m & 1) asm volatile("" ::: "memory"); }
        const bool bad1 = bad;
        bad = st2.run(acc, u, wr, wc, fr, fq, lds, wid, lane) || bad;
#pragma unroll
        for (int ai = 0; ai < 2; ++ai)
#pragma unroll
            for (int m = 0; m < 4; ++m) { const int r = ai * HALF + wr * 64 + m * 16 + fr; const f32x2v sr = S[r]; const size_t off = (size_t)(u.pm * BM + r) * ldc + col0;
#pragma unroll
                for (int bj = 0; bj < 2; ++bj)
#pragma unroll
                    for (int n = 0; n < 2; ++n) { const f32x4 x1 = acc[ai][bj][m][n]; *(f32x4*)(out + off + bj * HALF + n * 16) = bad1 ? (f32x4){qnan, qnan, qnan, qnan} : x1;
                        const f32x4 o = (x1 - sr.x) * sr.y; u32x2v w; w.x = cvt_pk_bf16(o[0], o[1]); w.y = cvt_pk_bf16(o[2], o[3]);
                        if (bad) { w.x = 0x7fc07fc0u; w.y = 0x7fc07fc0u; } *(u32x2v*)(xn + off + bj * HALF + n * 16) = w; }
                asm volatile("" ::: "memory"); }
    }
};

template <class Epi, class Sched, bool ALIGN_EPI = false, bool SP2 = false>
__device__ __forceinline__ void gemm_phase(PG8_LAS unsigned char* lds, const Gemm g, const Sched& S, const Epi& E) {
    int tid_ = threadIdx.x; asm volatile("" : "+v"(tid_));
    const int tid = tid_, wid = __builtin_amdgcn_readfirstlane(tid >> 6), lane = tid & 63, wr = wid >> 2, wc = wid & 3, fr = lane & 15, fq = lane >> 4;
    const int K = g.K, nt = K / BK;
    unsigned voffA[2], voffB[2];
#pragma unroll
    for (int i = 0; i < 2; ++i) { int R, C; stage_rc(tid * 16 + i * 8192, R, C); const int Rb = Epi::PERM ? ((R & ~31) + perm32(R & 31)) : R;
        voffA[i] = (unsigned)(R * K + C) * 2u; voffB[i] = (unsigned)(Rb * K + C) * 2u; }
    const size_t kstep = (size_t)(BK * 2);
    const size_t hstep = (size_t)HALF * K * 2;
    const size_t tstep = 2 * hstep;
    const unsigned ldsw = (unsigned)wid * 1024u;
    const int aoff = lds_byte(wr * 64 + fr, fq * 8), boff = lds_byte(wc * 32 + fr, fq * 8);
#define PG8_SA(b, h) (((b) * 2 + (h)) * HTB)
#define PG8_SB(b, h) ((4 + (b) * 2 + (h)) * HTB)
#define PG8_STAGE(bufoff, gbase, voff) do { _Pragma("unroll") for (int _i = 0; _i < 2; ++_i) \
        __builtin_amdgcn_global_load_lds((const unsigned*)((const char*)(gbase) + (voff)[_i]), (PG8_LAS unsigned*)(lds + (bufoff) + ldsw + _i * 8192), 16, 0, 0); } while (0)
#define PG8_LDA(dst, b, h) do { _Pragma("unroll") for (int m = 0; m < 4; ++m) _Pragma("unroll") for (int k = 0; k < 2; ++k) dst[m][k] = *(const PG8_LAS bf16x8*)(lds + PG8_SA(b, h) + aoff + m * 2048 + k * 1024); } while (0)
#define PG8_LDB(dst, b, h) do { _Pragma("unroll") for (int n = 0; n < 2; ++n) _Pragma("unroll") for (int k = 0; k < 2; ++k) dst[n][k] = *(const PG8_LAS bf16x8*)(lds + PG8_SB(b, h) + boff + n * 2048 + k * 1024); } while (0)
#define PG8_MMA(ai, bj, At, Bt) do { __builtin_amdgcn_s_setprio(1); _Pragma("unroll") for (int m = 0; m < 4; ++m) _Pragma("unroll") for (int n = 0; n < 2; ++n) _Pragma("unroll") for (int k = 0; k < 2; ++k) \
        acc[ai][bj][m][n] = __builtin_amdgcn_mfma_f32_16x16x32_bf16(Bt[n][k], At[m][k], acc[ai][bj][m][n], 0, 0, 0); __builtin_amdgcn_s_setprio(0); } while (0)
#define PG8_WAIT_V(n) asm volatile("s_waitcnt vmcnt(" #n ")" ::: "memory")
#define PG8_WAIT_L(n) asm volatile("s_waitcnt lgkmcnt(" #n ")" ::: "memory")
#define PG8_BAR __builtin_amdgcn_s_barrier()
#define PG8_SCHED __builtin_amdgcn_sched_barrier(0)
    Unit cur, nxt; int ui = 0;
    if (!S.next(0, cur)) return;
    f32x4 acc[2][2][4][2];
#pragma unroll
    for (int a = 0; a < 2; ++a)
#pragma unroll
        for (int b = 0; b < 2; ++b)
#pragma unroll
            for (int m = 0; m < 4; ++m)
#pragma unroll
                for (int n = 0; n < 2; ++n) acc[a][b][m][n] = (f32x4){0.f, 0.f, 0.f, 0.f};
    bf16x8 At[4][2], B0[2][2], B1[2][2];
    const char* cA = (const char*)g.A + (size_t)cur.pm * tstep; const char* cB = (const char*)g.Bt + (size_t)cur.pn * tstep;
    S.a_ready(cur);
    if constexpr (SP2) {
        PG8_STAGE(PG8_SB(0, 0), cB, voffB); PG8_STAGE(PG8_SB(0, 1), cB + hstep, voffB); PG8_STAGE(PG8_SA(0, 0), cA, voffA); PG8_STAGE(PG8_SA(0, 1), cA + hstep, voffA);
        if (wr == 1) PG8_BAR;
        PG8_WAIT_V(2); PG8_BAR;
        PG8_STAGE(PG8_SB(1, 0), cB + kstep, voffB); PG8_STAGE(PG8_SA(1, 0), cA + kstep, voffA); PG8_STAGE(PG8_SB(1, 1), cB + hstep + kstep, voffB);
        PG8_WAIT_V(6); PG8_BAR;
    } else {
        PG8_STAGE(PG8_SB(0, 0), cB, voffB); PG8_STAGE(PG8_SA(0, 0), cA, voffA); PG8_STAGE(PG8_SB(0, 1), cB + hstep, voffB); PG8_STAGE(PG8_SA(0, 1), cA + hstep, voffA);
        if (wr == 1) PG8_BAR;
        PG8_WAIT_V(4); PG8_BAR;
        PG8_STAGE(PG8_SB(1, 0), cB + kstep, voffB); PG8_STAGE(PG8_SA(1, 0), cA + kstep, voffA); PG8_STAGE(PG8_SB(1, 1), cB + hstep + kstep, voffB);
        PG8_WAIT_V(6); PG8_BAR;
    }
    for (;;) {
        const bool has_next = S.next(ui + 1, nxt);
        const char* nA = has_next ? (const char*)g.A + (size_t)nxt.pm * tstep : cA; const char* nB = has_next ? (const char*)g.Bt + (size_t)nxt.pn * tstep : cB;
        for (int t = 0; t < nt; t += 2) {
            const bool last = (t == nt - 2);
            const char* a1 = cA + (size_t)(t + 1) * kstep;
            const char* a2 = last ? nA : cA + (size_t)(t + 2) * kstep; const char* b2 = last ? nB : cB + (size_t)(t + 2) * kstep;
            const char* a3 = a2 + kstep; const char* b3 = b2 + kstep;
            if (last && has_next) S.a_ready(nxt);
            if constexpr (SP2) {
            PG8_LDB(B0, 0, 0); PG8_LDB(B1, 0, 1); PG8_SCHED; PG8_LDA(At, 0, 0); PG8_STAGE(PG8_SA(1, 1), a1 + hstep, voffA);
            PG8_WAIT_V(8); PG8_WAIT_L(0); PG8_BAR; PG8_MMA(0, 0, At, B0); PG8_MMA(0, 1, At, B1); PG8_BAR; PG8_SCHED;
            PG8_LDA(At, 0, 1); PG8_STAGE(PG8_SB(0, 0), b2, voffB); PG8_STAGE(PG8_SB(0, 1), b2 + hstep, voffB); PG8_STAGE(PG8_SA(0, 0), a2, voffA);
            PG8_WAIT_V(8); PG8_WAIT_L(0); PG8_BAR; PG8_MMA(1, 0, At, B0); PG8_MMA(1, 1, At, B1); PG8_BAR; PG8_SCHED;
            PG8_LDB(B0, 1, 0); PG8_LDB(B1, 1, 1); PG8_SCHED; PG8_LDA(At, 1, 0); PG8_STAGE(PG8_SA(0, 1), a2 + hstep, voffA);
            PG8_WAIT_V(8); PG8_WAIT_L(0); PG8_BAR; PG8_MMA(0, 0, At, B0); PG8_MMA(0, 1, At, B1); PG8_BAR; PG8_SCHED;
            PG8_LDA(At, 1, 1); PG8_STAGE(PG8_SB(1, 0), b3, voffB); PG8_STAGE(PG8_SB(1, 1), b3 + hstep, voffB); PG8_STAGE(PG8_SA(1, 0), a3, voffA);
            PG8_WAIT_V(8); PG8_WAIT_L(0); PG8_BAR; PG8_MMA(1, 0, At, B0); PG8_MMA(1, 1, At, B1); PG8_BAR; PG8_SCHED;
            } else {
            PG8_LDB(B0, 0, 0); PG8_SCHED; PG8_LDA(At, 0, 0); PG8_STAGE(PG8_SA(1, 1), a1 + hstep, voffA);
            PG8_WAIT_L(8); PG8_BAR; PG8_WAIT_L(0); PG8_MMA(0, 0, At, B0); PG8_BAR; PG8_SCHED;
            PG8_LDB(B1, 0, 1); PG8_STAGE(PG8_SB(0, 0), b2, voffB);
            PG8_BAR; PG8_WAIT_L(0); PG8_MMA(0, 1, At, B1); PG8_BAR;
            PG8_LDA(At, 0, 1); PG8_STAGE(PG8_SA(0, 0), a2, voffA);
            PG8_BAR; PG8_WAIT_L(0); PG8_MMA(1, 0, At, B0); PG8_BAR; PG8_SCHED;
            PG8_STAGE(PG8_SB(0, 1), b2 + hstep, voffB);
            PG8_WAIT_V(6); PG8_BAR; PG8_MMA(1, 1, At, B1); PG8_BAR;
            PG8_LDB(B0, 1, 0); PG8_SCHED; PG8_LDA(At, 1, 0); PG8_STAGE(PG8_SA(0, 1), a2 + hstep, voffA);
            PG8_WAIT_L(8); PG8_BAR; PG8_WAIT_L(0); PG8_MMA(0, 0, At, B0); PG8_BAR; PG8_SCHED;
            PG8_LDB(B1, 1, 1); PG8_STAGE(PG8_SB(1, 0), b3, voffB);
            PG8_BAR; PG8_WAIT_L(0); PG8_MMA(0, 1, At, B1); PG8_BAR;
            PG8_LDA(At, 1, 1); PG8_STAGE(PG8_SA(1, 0), a3, voffA);
            PG8_BAR; PG8_WAIT_L(0); PG8_MMA(1, 0, At, B0); PG8_BAR; PG8_SCHED;
            PG8_STAGE(PG8_SB(1, 1), b3 + hstep, voffB);
            PG8_WAIT_V(6); PG8_BAR; PG8_MMA(1, 1, At, B1); PG8_BAR;
            }
        }
        if constexpr (ALIGN_EPI) { if (wr == 0) PG8_BAR; }
        if constexpr (!Epi::AFTER_DRAIN) { E(acc, cur, wr, wc, fr, fq); S.done(cur); }
        if (!has_next) break;
#pragma unroll
        for (int a = 0; a < 2; ++a)
#pragma unroll
            for (int b = 0; b < 2; ++b)
#pragma unroll
                for (int m = 0; m < 4; ++m)
#pragma unroll
                    for (int n = 0; n < 2; ++n) acc[a][b][m][n] = (f32x4){0.f, 0.f, 0.f, 0.f};
        cur = nxt; cA = nA; cB = nB; ++ui;
        if constexpr (ALIGN_EPI) { if (wr == 1) PG8_BAR; }
    }
    PG8_WAIT_V(0);
    if constexpr (!ALIGN_EPI) { if (wr == 0) PG8_BAR; }
    PG8_BAR;
    if constexpr (Epi::AFTER_DRAIN) { E.fused(acc, cur, wr, wc, fr, fq, lds, wid, lane); S.done(cur); }
#undef PG8_SA
#undef PG8_SB
#undef PG8_STAGE
#undef PG8_LDA
#undef PG8_LDB
#undef PG8_MMA
#undef PG8_WAIT_V
#undef PG8_WAIT_L
#undef PG8_BAR
#undef PG8_SCHED
}
}
#include <hip/hip_bf16.h>
#include <cmath>
namespace attn_body {
using bf16=__hip_bfloat16;
using bf16x8=__attribute__((ext_vector_type(8)))short;
using s16x4=__attribute__((ext_vector_type(4)))short;
using f32x16=__attribute__((ext_vector_type(16)))float;
using u32x4=__attribute__((ext_vector_type(4)))unsigned;
constexpr int BATCH=8,NHEAD=8,SEQ=2048,D=64,DM=NHEAD*D,OP=1024,CLS_OFF=86016;
constexpr int NW=8,QBLK=32,QB=QBLK*NW,KVBLK=64,NQB=SEQ/QB;
constexpr int ATTN_PITCH=DM, ATTN_UNIT_ROWS=QB;
__device__ __forceinline__ int crow(int r,int hi){return (r&3)+8*(r>>2)+4*hi;}
#define SBAR() __builtin_amdgcn_sched_barrier(0)
__device__ __forceinline__ void cmask(f32x16&p0,f32x16&p1,int jb,int qrel,int hi){
  const float NEG=-INFINITY; int kb=64*jb+4*hi;
  #pragma unroll
  for(int r=0;r<16;++r){int kv=kb+(r&3)+8*(r>>2); if(kv>qrel)p0[r]=NEG; if(kv+32>qrel)p1[r]=NEG;}
}

constexpr int NSLOT=3, SLOTB=8192;
constexpr int LDS_K=0, LDS_V=NSLOT*SLOTB, LDS_WS=2*NSLOT*SLOTB, LDS_OST=LDS_WS+NW*64*4, LDS_BYTES=LDS_OST+NW*4096;
constexpr float C2=0.125f*1.4426950408889634f;
__device__ __forceinline__ void glds16(const void*gsrc,unsigned lds_dst){unsigned keep;
  asm volatile("s_mov_b32 %0, m0\n\ts_mov_b32 m0, %2\n\ts_nop 0\n\tglobal_load_lds_dwordx4 %1, off\n\ts_mov_b32 m0, %0":"=&s"(keep):"v"(gsrc),"s"(lds_dst):"memory");}
__device__ __forceinline__ float max3f(float a,float b,float c){float r;asm("v_max3_f32 %0, %1, %2, %3":"=v"(r):"v"(a),"v"(b),"v"(c));return r;}
__device__ __forceinline__ float max2f(float a,float b){float r;asm("v_max_f32_e32 %0, %1, %2":"=v"(r):"v"(a),"v"(b));return r;}
__device__ __forceinline__ float fadd_s(float a,float b){float r;asm("v_add_f32_e32 %0, %1, %2":"=v"(r):"v"(a),"v"(b));return r;}
__device__ __forceinline__ float fsub_s(float a,float b){float r;asm("v_sub_f32_e32 %0, %1, %2":"=v"(r):"v"(a),"v"(b));return r;}
typedef float f32x4_t __attribute__((ext_vector_type(4))); typedef float f32x2_t __attribute__((ext_vector_type(2))); typedef __bf16 bf16x2_t __attribute__((ext_vector_type(2)));
__device__ __forceinline__ unsigned cvtpk_s(float lo,float hi){f32x2_t v={lo,hi};bf16x2_t b=__builtin_convertvector(v,bf16x2_t);return __builtin_bit_cast(unsigned,b);}
#define WAIT_BAR(N) asm volatile("s_waitcnt vmcnt(" #N ") lgkmcnt(0)\n\ts_barrier":::"memory")

__device__ __forceinline__ void qkt(f32x16&p0,f32x16&p1,const char*Kslot,const bf16x8*qr,int r32,int hi){ const f32x16 negm=f32x16{};
  const char*kb=Kslot+hi*1024+r32*16;
  #pragma unroll
  for(int d0=0;d0<4;++d0){
    const bf16x8 b0=*reinterpret_cast<const bf16x8*>(kb+d0*2048);
    const bf16x8 b1=*reinterpret_cast<const bf16x8*>(kb+d0*2048+512);
    if(d0==0){p0=__builtin_amdgcn_mfma_f32_32x32x16_bf16(b0,qr[0],negm,0,0,0);p1=__builtin_amdgcn_mfma_f32_32x32x16_bf16(b1,qr[0],negm,0,0,0);}
    else{p0=__builtin_amdgcn_mfma_f32_32x32x16_bf16(b0,qr[d0],p0,0,0,0);p1=__builtin_amdgcn_mfma_f32_32x32x16_bf16(b1,qr[d0],p1,0,0,0);}}
}
typedef __attribute__((address_space(3))) const char* lds_cptr;
typedef short v4i16_t __attribute__((ext_vector_type(4)));
__device__ __forceinline__ void kload8(bf16x8*kf,lds_cptr kp){
  kf[0]=*(const __attribute__((address_space(3))) bf16x8*)(kp);      kf[1]=*(const __attribute__((address_space(3))) bf16x8*)(kp+512);
  kf[2]=*(const __attribute__((address_space(3))) bf16x8*)(kp+2048); kf[3]=*(const __attribute__((address_space(3))) bf16x8*)(kp+2560);
  kf[4]=*(const __attribute__((address_space(3))) bf16x8*)(kp+4096); kf[5]=*(const __attribute__((address_space(3))) bf16x8*)(kp+4608);
  kf[6]=*(const __attribute__((address_space(3))) bf16x8*)(kp+6144); kf[7]=*(const __attribute__((address_space(3))) bf16x8*)(kp+6656);
}
__device__ __forceinline__ void kload2(bf16x8*kf,lds_cptr kp,int j){ kf[2*j]=*(const __attribute__((address_space(3))) bf16x8*)(kp+j*2048); kf[2*j+1]=*(const __attribute__((address_space(3))) bf16x8*)(kp+j*2048+512); }
__device__ __forceinline__ s16x4 vtr(lds_cptr p){ return __builtin_bit_cast(s16x4,__builtin_amdgcn_ds_read_tr16_b64_v4i16((__attribute__((address_space(3))) v4i16_t*)p)); }
__device__ __forceinline__ float rowmax(const f32x16&p0,const f32x16&p1){
  float a=max3f(p0[0],p0[1],p1[0]),b=max3f(p0[2],p0[3],p1[1]);a=max3f(a,p1[2],p1[3]);
  #pragma unroll
  for(int r=4;r<16;r+=4){a=max3f(a,p0[r],p0[r+1]);b=max3f(b,p0[r+2],p0[r+3]);a=max3f(a,p1[r],p1[r+1]);b=max3f(b,p1[r+2],p1[r+3]);}
  const float m=max2f(a,b);
  auto rr=__builtin_amdgcn_permlane32_swap(__float_as_uint(m),__float_as_uint(m),false,false);
  return max2f(__uint_as_float(rr[0]),__uint_as_float(rr[1]));
}
__device__ __forceinline__ void pv(f32x16*o,int vb,bf16x8 pa0,bf16x8 pa1,bf16x8 pa2,bf16x8 pa3){
  #pragma unroll
  for(int d0=0;d0<2;++d0){s16x4 lo[4],hi[4];
    #pragma unroll
    for(int ks=0;ks<4;++ks){
      asm volatile("ds_read_b64_tr_b16 %0,%1 offset:%c2":"=&v"(lo[ks]):"v"(vb),"i"(d0*4096+ks*1024):"memory");
      asm volatile("ds_read_b64_tr_b16 %0,%1 offset:%c2":"=&v"(hi[ks]):"v"(vb),"i"(d0*4096+ks*1024+512):"memory");}
    asm volatile("s_waitcnt lgkmcnt(0)":::"memory");SBAR();
    #define PK(k) (bf16x8){lo[k][0],lo[k][1],lo[k][2],lo[k][3],hi[k][0],hi[k][1],hi[k][2],hi[k][3]}
    o[d0]=__builtin_amdgcn_mfma_f32_32x32x16_bf16(pa0,PK(0),o[d0],0,0,0);
    o[d0]=__builtin_amdgcn_mfma_f32_32x32x16_bf16(pa1,PK(1),o[d0],0,0,0);
    o[d0]=__builtin_amdgcn_mfma_f32_32x32x16_bf16(pa2,PK(2),o[d0],0,0,0);
    o[d0]=__builtin_amdgcn_mfma_f32_32x32x16_bf16(pa3,PK(3),o[d0],0,0,0);
    #undef PK
  }
}

#ifndef ATTN_STORE16
#define ATTN_STORE16(p,v) (*(u32x4*)(p)=(v))
#endif
template<int THRL> __device__ __forceinline__ void attn_unit(int b,int h,int qb,const bf16*Q,const bf16*__restrict__ K,const bf16*__restrict__ V,bf16*O,const float*__restrict__ CL,char*shm){
  const int tid=threadIdx.x,lane=tid&63,r32=lane&31,hi=lane>>5; const int wid=__builtin_amdgcn_readfirstlane(tid>>6);
  const long rowbase=(long)b*SEQ; const int q0=qb*QB;
  const bf16*Qw=Q+(rowbase+q0+wid*QBLK)*DM+h*D;
  const bf16*Kh=K+rowbase*DM+h*D,*Vh=V+rowbase*DM+h*D;
  const unsigned lds0=(unsigned)(uintptr_t)shm;
  float*wsf=(float*)(shm+LDS_WS)+wid*64;
  const bf16*ksrc=Kh+(long)lane*DM+wid*8;
  const bf16*vsrc=Vh+(long)(16*(wid&3)+(lane>>2))*DM+(wid>>2)*32+(lane&3)*8;
  const unsigned kdst=lds0+LDS_K+wid*1024, vdst=lds0+LDS_V+wid*1024;
  #define DMA_K(t,slot) glds16(ksrc+(long)(t)*KVBLK*DM,(unsigned)__builtin_amdgcn_readfirstlane(kdst+(slot)))
  #define DMA_V(t,slot) glds16(vsrc+(long)(t)*KVBLK*DM,(unsigned)__builtin_amdgcn_readfirstlane(vdst+(slot)))
  const int vb0=(int)(lds0+LDS_V)+((lane>>4)&1)*32+(lane&3)*8+(4*hi+((lane&15)>>2))*64;
  const char*Kbase=shm+LDS_K; bf16x8 kf[8];
  const lds_cptr shm3=(lds_cptr)shm; const lds_cptr kp0=shm3+LDS_K+hi*1024+r32*16; const lds_cptr vp0=shm3+LDS_V+((lane>>4)&1)*32+(lane&3)*8+(4*hi+((lane&15)>>2))*64;
  const int NT=(q0+QB)/KVBLK;
  __attribute__((address_space(3))) float*cls=(__attribute__((address_space(3))) float*)((__attribute__((address_space(3))) char*)shm+CLS_OFF);
  const float*CLh=CL+(long)(b*NHEAD+h)*SEQ;
  const float clq=CLh[q0+wid*QBLK+r32];
  glds16(CLh+wid*256+lane*4,(unsigned)__builtin_amdgcn_readfirstlane(lds0+CLS_OFF+wid*1024));
  #define BIAS(P0,P1,t) do{ const __attribute__((address_space(3))) float*cb_=cls+64*(t)+4*hi; _Pragma("unroll") for(int g_=0;g_<4;++g_){ \
      const f32x4_t b0_=*(const __attribute__((address_space(3))) f32x4_t*)(cb_+8*g_), b1_=*(const __attribute__((address_space(3))) f32x4_t*)(cb_+32+8*g_); \
      _Pragma("unroll") for(int j_=0;j_<4;++j_){ P0[4*g_+j_]+=(nm-b0_[j_]); P1[4*g_+j_]+=(nm-b1_[j_]); } } }while(0)
  DMA_K(0,0);DMA_V(0,0);DMA_K(1,SLOTB);
  bf16x8 qr[4];
  #pragma unroll
  for(int d0=0;d0<4;++d0)qr[d0]=*reinterpret_cast<const bf16x8*>(&Qw[(long)r32*DM+d0*16+hi*8]);
  float l_reg=0.f;f32x16 o[2];o[0]=f32x16{};o[1]=f32x16{};float nm=clq; const f32x16 zero16=f32x16{};
  const int qrel=wid*QBLK+r32;
  #define CMASK(P0,P1,t) do{int jb_=(t)-(NT-4); if(jb_>=0)cmask(P0,P1,jb_,qrel,hi);}while(0)
  bool resc=false;
  #define START(P0,P1) do{ const float rm=rowmax(P0,P1); resc=false; \
    { const float dl=rm; \
      _Pragma("unroll") for(int r=0;r<16;++r){P0[r]=fsub_s(P0[r],dl);P1[r]=fsub_s(P1[r],dl);} \
      nm=fsub_s(nm,dl); } \
    _Pragma("unroll") for(int r=0;r<16;++r)P0[r]=__builtin_amdgcn_exp2f(P0[r]); }while(0)
  #define RESC() do{ if(resc){ asm volatile("s_waitcnt lgkmcnt(0)":::"memory"); \
      _Pragma("unroll") for(int d_=0;d_<2;++d_) _Pragma("unroll") for(int r=0;r<16;++r)o[d_][r]*=wsf[crow(r,hi)]; } }while(0)
  f32x16 pA0,pA1,pB0,pB1;
  int sl_prev=0,sl_cur=0,sl_next=SLOTB;
  #define ROT() do{sl_prev=sl_cur;sl_cur=sl_next;sl_next=(sl_next==(NSLOT-1)*SLOTB)?0:sl_next+SLOTB;}while(0)
  DMA_K(2,2*SLOTB);
  WAIT_BAR(3);
  qkt(pA0,pA1,Kbase,qr,r32,hi);asm volatile("s_nop 15\n\ts_nop 7":"+v"(pA0),"+v"(pA1));BIAS(pA0,pA1,0);CMASK(pA0,pA1,0);
  START(pA0,pA1);
  _Pragma("unroll") for(int r=0;r<16;++r)pA1[r]=__builtin_amdgcn_exp2f(pA1[r]);
  WAIT_BAR(0);
  DMA_K(3,0);DMA_V(1,SLOTB);
  ROT();
  kload8(kf,kp0+sl_cur);
  WAIT_BAR(2);
  s16x4 vlo[8],vhi[8]; u32x4 pw0,pw1,pw2,pw3;
  #define PKW(P,B) cvtpk_s(P[B],P[B+1])
  #define PAF(k) __builtin_bit_cast(bf16x8,pw##k)
  #define VFR(i) (bf16x8){vlo[i][0],vlo[i][1],vlo[i][2],vlo[i][3],vhi[i][0],vhi[i][1],vhi[i][2],vhi[i][3]}
  #define PIN(x) asm volatile("":"+v"(x))
  #define MX3(a,b,c) __builtin_fmaxf(__builtin_fmaxf((a),(b)),(c))
  #define GAPA(MF,A0,A1,A2,A3,W0,W1,PW) do{ MF; sacc+=A0; sacc+=A1; sacc+=A2; sacc+=A3; PIN(sacc); W0; W1; PIN(PW); SBAR(); }while(0)
  #define EX(v) __builtin_amdgcn_exp2f(v)
  #define GAPB(MF,X,B) do{ MF; X[B]=EX(X[B]); X[B+1]=EX(X[B+1]); X[B+2]=EX(X[B+2]); X[B+3]=EX(X[B+3]); PIN(X); SBAR(); }while(0)
  #define VRD(i) do{ vlo[i]=vtr(vp_+(((i)>>2)*4096+((i)&3)*1024)); vhi[i]=vtr(vp_+(((i)>>2)*4096+((i)&3)*1024+512)); }while(0)
  #define KRD(G,j) do{ if(G){ kload2(kf,kp0+sl_next,j); SBAR(); } }while(0)
  #define STEP(C0,C1,P0,P1,t,GK,GV,GL) do{ SBAR(); \
    const lds_cptr vp_=vp0+sl_prev; \
    VRD(0); SBAR(); float sacc=(P0[0]+P0[1]); \
    GAPA(C0=__builtin_amdgcn_mfma_f32_32x32x16_bf16(kf[0],qr[0],zero16,0,0,0), P0[2],P0[3],P0[4],P0[5],     pw0[0]=PKW(P0,0), pw0[1]=PKW(P0,2), pw0); \
    VRD(4); SBAR(); GAPA(C1=__builtin_amdgcn_mfma_f32_32x32x16_bf16(kf[1],qr[0],zero16,0,0,0), P0[6],P0[7],P0[8],P0[9],     pw0[2]=PKW(P0,4), pw0[3]=PKW(P0,6), pw0); \
    VRD(1); SBAR(); GAPA(C0=__builtin_amdgcn_mfma_f32_32x32x16_bf16(kf[2],qr[1],C0,0,0,0),   P0[10],P0[11],P0[12],P0[13], pw1[0]=PKW(P0,8), pw1[1]=PKW(P0,10), pw1); \
    VRD(5); SBAR(); GAPA(C1=__builtin_amdgcn_mfma_f32_32x32x16_bf16(kf[3],qr[1],C1,0,0,0),   P0[14],P0[15],P1[0],P1[1],   pw1[2]=PKW(P0,12),pw1[3]=PKW(P0,14), pw1); \
    VRD(2); SBAR(); GAPA(C0=__builtin_amdgcn_mfma_f32_32x32x16_bf16(kf[4],qr[2],C0,0,0,0),   P1[2],P1[3],P1[4],P1[5],     pw2[0]=PKW(P1,0), pw2[1]=PKW(P1,2), pw2); \
    VRD(6); SBAR(); GAPA(C1=__builtin_amdgcn_mfma_f32_32x32x16_bf16(kf[5],qr[2],C1,0,0,0),   P1[6],P1[7],P1[8],P1[9],     pw2[2]=PKW(P1,4), pw2[3]=PKW(P1,6), pw2); \
    VRD(3); SBAR(); GAPA(C0=__builtin_amdgcn_mfma_f32_32x32x16_bf16(kf[6],qr[3],C0,0,0,0),   P1[10],P1[11],P1[12],P1[13], pw3[0]=PKW(P1,8), pw3[1]=PKW(P1,10), pw3); \
    VRD(7); SBAR(); GAPA(C1=__builtin_amdgcn_mfma_f32_32x32x16_bf16(kf[7],qr[3],C1,0,0,0),   P1[14],P1[15],0.f,0.f,       pw3[2]=PKW(P1,12),pw3[3]=PKW(P1,14), pw3); \
    l_reg+=sacc; \
    if(GK){DMA_K((t)+3,sl_cur);} if(GV){DMA_V((t)+1,sl_next);} \
    BIAS(C0,C1,t); CMASK(C0,C1,t); \
    { float a=MX3(C0[0],C0[1],C1[0]),b=MX3(C0[2],C0[3],C1[1]); a=MX3(a,C1[2],C1[3]); \
      _Pragma("unroll") for(int r=4;r<16;r+=4){a=MX3(a,C0[r],C0[r+1]);b=MX3(b,C0[r+2],C0[r+3]);a=MX3(a,C1[r],C1[r+1]);b=MX3(b,C1[r+2],C1[r+3]);} \
      float rm=__builtin_fmaxf(a,b); { auto rr=__builtin_amdgcn_permlane32_swap(__float_as_uint(rm),__float_as_uint(rm),false,false); rm=__builtin_fmaxf(__uint_as_float(rr[0]),__uint_as_float(rr[1])); } \
      resc=false; \
      if(__builtin_expect(__any(rm>(float)THRL),0)){ const float dl=__builtin_fmaxf(rm,0.f); \
        _Pragma("unroll") for(int r=0;r<16;++r){C0[r]-=dl;C1[r]-=dl;} \
        nm-=dl; \
        const float f=__builtin_amdgcn_exp2f(-dl); l_reg*=f; if(hi==0)wsf[r32]=f; resc=true; } } \
    SBAR(); \
    GAPB(o[0]=__builtin_amdgcn_mfma_f32_32x32x16_bf16(PAF(0),VFR(0),o[0],0,0,0), C0,0); \
    GAPB(o[1]=__builtin_amdgcn_mfma_f32_32x32x16_bf16(PAF(0),VFR(4),o[1],0,0,0), C0,4); \
    KRD(GL,0); GAPB(o[0]=__builtin_amdgcn_mfma_f32_32x32x16_bf16(PAF(1),VFR(1),o[0],0,0,0), C0,8); \
    KRD(GL,1); GAPB(o[1]=__builtin_amdgcn_mfma_f32_32x32x16_bf16(PAF(1),VFR(5),o[1],0,0,0), C0,12); \
    KRD(GL,2); GAPB(o[0]=__builtin_amdgcn_mfma_f32_32x32x16_bf16(PAF(2),VFR(2),o[0],0,0,0), C1,0); \
    KRD(GL,3); GAPB(o[1]=__builtin_amdgcn_mfma_f32_32x32x16_bf16(PAF(2),VFR(6),o[1],0,0,0), C1,4); \
    GAPB(o[0]=__builtin_amdgcn_mfma_f32_32x32x16_bf16(PAF(3),VFR(3),o[0],0,0,0), C1,8); \
    GAPB(o[1]=__builtin_amdgcn_mfma_f32_32x32x16_bf16(PAF(3),VFR(7),o[1],0,0,0), C1,12); \
    }while(0)
  int t=1;
  #undef CMASK
  #define CMASK(P0,P1,t) do{}while(0)
  for(;t+5<NT;t+=2){
    STEP(pB0,pB1,pA0,pA1,t,true,true,true);     WAIT_BAR(2); RESC(); ROT();
    STEP(pA0,pA1,pB0,pB1,t+1,true,true,true);   WAIT_BAR(2); RESC(); ROT();
  }
  #undef CMASK
  #define CMASK(P0,P1,t) do{int jb_=(t)-(NT-4); if(jb_>=0)cmask(P0,P1,jb_,qrel,hi);}while(0)
  #define ENDW(tt) do{ if((tt)+3<NT){WAIT_BAR(2);} else if((tt)+2<NT){WAIT_BAR(1);} else {WAIT_BAR(0);} }while(0)
  for(;t+1<NT;t+=2){
    STEP(pB0,pB1,pA0,pA1,t,(t+3<NT),(t+1<NT),(t+1<NT));       ENDW(t);   RESC(); ROT();
    STEP(pA0,pA1,pB0,pB1,t+1,(t+4<NT),(t+2<NT),(t+2<NT));     ENDW(t+1); RESC(); ROT();
  }
  STEP(pB0,pB1,pA0,pA1,NT-1,false,false,false); RESC();
  { float sacc=pB0[0]+pB0[1]; _Pragma("unroll") for(int r=2;r<16;++r)sacc+=pB0[r]; _Pragma("unroll") for(int r=0;r<16;++r)sacc+=pB1[r]; l_reg+=sacc;
    pw0=(u32x4){PKW(pB0,0),PKW(pB0,2),PKW(pB0,4),PKW(pB0,6)};pw1=(u32x4){PKW(pB0,8),PKW(pB0,10),PKW(pB0,12),PKW(pB0,14)};pw2=(u32x4){PKW(pB1,0),PKW(pB1,2),PKW(pB1,4),PKW(pB1,6)};pw3=(u32x4){PKW(pB1,8),PKW(pB1,10),PKW(pB1,12),PKW(pB1,14)};
    SBAR(); pv(o,vb0+sl_cur,PAF(0),PAF(1),PAF(2),PAF(3)); }
  #undef PKW
  #undef PAF
  #undef VFR
  #undef PIN
  #undef MX3
  #undef GAPA
  #undef GAPB
  #undef EX
  #undef VRD
  #undef KRD
  #undef STEP
  #undef ENDW
  {auto rr=__builtin_amdgcn_permlane32_swap(__float_as_uint(l_reg),__float_as_uint(l_reg),false,false);l_reg=__uint_as_float(rr[0])+__uint_as_float(rr[1]);}
  if(hi==0)wsf[32+r32]=l_reg;asm volatile("s_waitcnt lgkmcnt(0)":::"memory");
  float rli[16];
  #pragma unroll
  for(int r=0;r<16;++r)rli[r]=__builtin_amdgcn_rcpf(wsf[32+crow(r,hi)]);
  bf16*Ow=O+(rowbase+q0+wid*QBLK)*OP+h*D;
  { bf16*stg=(bf16*)(shm+LDS_OST)+wid*2048;
    #pragma unroll
    for(int r=0;r<16;++r){const int orow=crow(r,hi);
      #pragma unroll
      for(int d0=0;d0<2;++d0)stg[orow*64+d0*32+r32]=__float2bfloat16(o[d0][r]*rli[r]);}
    asm volatile("s_waitcnt lgkmcnt(0)":::"memory");
    #pragma unroll
    for(int i=0;i<4;++i){const int row=i*8+(lane>>3),ch=lane&7; const u32x4 v=*(const u32x4*)(stg+row*64+ch*8); ATTN_STORE16(Ow+(long)row*OP+ch*8,v);} }
  asm volatile("s_waitcnt lgkmcnt(0)\n\ts_barrier":::"memory");
  #undef BIAS
  #undef DMA_K
  #undef DMA_V
  #undef CMASK
  #undef START
  #undef RESC
  #undef ROT
}
constexpr int ATTN_LDS_BYTES=LDS_BYTES;
struct AttnTensors { const bf16* Q; const bf16* K; const bf16* V; bf16* O; const float* CL; };
struct AttnUnit { int bh; int qb; };
struct StaticOrder {
  int vcu;
  __device__ __forceinline__ explicit StaticOrder(int grid,int block):vcu((block%8)*(grid/8)+block/8){}
  __device__ __forceinline__ bool next(int i,AttnUnit&u)const{ if(i>=2)return false; const int s=vcu&3; u.bh=vcu>>2; u.qb=(i==0)?7-s:s; return true; }
  __device__ __forceinline__ void a_ready(const AttnUnit&)const{}
  __device__ __forceinline__ void done(const AttnUnit&)const{}
};
template<class Sched,int THRL=8> __device__ __forceinline__ void attn_phase(char*lds,const AttnTensors&T,const Sched&S){
  AttnUnit u;
  for(int i=0;S.next(i,u);++i){ S.a_ready(u); attn_unit<THRL>(u.bh/NHEAD,u.bh%NHEAD,u.qb,T.Q,T.K,T.V,T.O,T.CL,lds); S.done(u); }
}
#undef SBAR
#undef WAIT_BAR
}

#define LAS __attribute__((address_space(3)))
typedef unsigned short bf16;
typedef unsigned v4u __attribute__((ext_vector_type(4)));
typedef unsigned v2u __attribute__((ext_vector_type(2)));
typedef float f32x4 __attribute__((ext_vector_type(4)));
constexpr int NWAVES = 8, NTHR = 512;
constexpr int BATCH = 8, SEQ = 2048, M = BATCH * SEQ, D = 1024, AW = 512, NH = 8, HD = 64, SW = 512, NG = 32, GS = 16, NP = 64, DFF = 2816, NUP = 2 * DFF, INC = 2056;
constexpr float EPS = 1e-6f;
constexpr size_t MiB = 1u << 20;
constexpr size_t WS_WIN = 1 * MiB, WS_WGLU = 5 * MiB, WS_WOUT = 6 * MiB, WS_WUP = 8 * MiB, WS_WDN = 19 * MiB;
constexpr size_t WS_TAB = 25 * MiB;
constexpr size_t TB_LOGF = 0, TB_CUM = 512 * 1024, TB_LB = 1024 * 1024, TB_BB = TB_LB + 16384, TB_BBP = 1536 * 1024, TB_CP = 1792 * 1024;
constexpr size_t WS_SS = 28 * MiB;
constexpr size_t WS_XB = 32 * MiB;
constexpr size_t WS_Q = 64 * MiB, WS_K = 80 * MiB, WS_V = 96 * MiB, WS_U = 112 * MiB, WS_YG = 128 * MiB, WS_MIX = 144 * MiB;
constexpr size_t WS_ACT = 152 * MiB, WS_HALO = 240 * MiB, WS_END = 248 * MiB;
constexpr size_t TB_SSQ2 = 2048 * 1024, TB_RSTD1 = 1408 * 1024;
constexpr int LDS_BYTES = 147456, RING_BYTES = 131072;

__device__ __forceinline__ float bf2f(unsigned v) { return __uint_as_float(v << 16); }
__device__ __forceinline__ unsigned f2bf(float f) { unsigned u = __float_as_uint(f); return (u + 0x7fffu + ((u >> 16) & 1u)) >> 16; }
__device__ __forceinline__ unsigned pk2(float lo, float hi) { return f2bf(lo) | (f2bf(hi) << 16); }
__device__ __forceinline__ float wave_sum(float v) {
#pragma unroll
    for (int o = 1; o < 64; o <<= 1) v += __shfl_xor(v, o);
    return v;
}
__device__ __forceinline__ void unpack8(const v4u w, float* f) {
    f[0] = bf2f(w.x & 0xffffu); f[1] = bf2f(w.x >> 16); f[2] = bf2f(w.y & 0xffffu); f[3] = bf2f(w.y >> 16);
    f[4] = bf2f(w.z & 0xffffu); f[5] = bf2f(w.z >> 16); f[6] = bf2f(w.w & 0xffffu); f[7] = bf2f(w.w >> 16);
}
__device__ __forceinline__ v4u pack8(const float* f) { v4u w; w.x = pk2(f[0], f[1]); w.y = pk2(f[2], f[3]); w.z = pk2(f[4], f[5]); w.w = pk2(f[6], f[7]); return w; }

namespace pg8 {
struct EpiPlain {
    static constexpr bool PERM = true, AFTER_DRAIN = false;
    bf16_t* O; int ldc; int split_cols; size_t split_stride;
    __device__ __forceinline__ void operator()(const f32x4 (&acc)[2][2][4][2], const Unit& u, int wr, int wc, int fr, int fq) const {
        const int row0 = u.pm * BM + wr * 64 + fr; int colt = u.pn * BM; bf16_t* base = O;
        if (split_cols) { const int t = colt / split_cols; base += (size_t)t * split_stride; colt -= t * split_cols; }
        const int col0 = colt + wc * 32 + 8 * fq;
#pragma unroll
        for (int ai = 0; ai < 2; ++ai)
#pragma unroll
            for (int m = 0; m < 4; ++m) { bf16_t* rowp = base + (size_t)(row0 + ai * HALF + m * 16) * ldc + col0;
#pragma unroll
                for (int bj = 0; bj < 2; ++bj) { const f32x4 v0 = acc[ai][bj][m][0], v1 = acc[ai][bj][m][1];
                    u32x4 w; w.x = cvt_pk_bf16(v0[0], v0[1]); w.y = cvt_pk_bf16(v0[2], v0[3]); w.z = cvt_pk_bf16(v1[0], v1[1]); w.w = cvt_pk_bf16(v1[2], v1[3]);
                    *(u32x4*)(rowp + bj * HALF) = w; } }
    }
};
struct EpiGlu {
    static constexpr bool PERM = true, AFTER_DRAIN = false;
    const bf16_t* YG; const float* bias; bf16_t* O; int ldo; int ocol0;
    __device__ __forceinline__ void operator()(const f32x4 (&acc)[2][2][4][2], const Unit& u, int wr, int wc, int fr, int fq) const {
        const int row0 = u.pm * BM + wr * 64 + fr; const int col0 = u.pn * BM + wc * 32 + 8 * fq;
#pragma unroll
        for (int ai = 0; ai < 2; ++ai)
#pragma unroll
            for (int m = 0; m < 4; ++m) { const int row = row0 + ai * HALF + m * 16;
#pragma unroll
                for (int bj = 0; bj < 2; ++bj) { const int col = col0 + bj * HALF;
                    const f32x4 b0 = *(const f32x4*)(bias + col), b1 = *(const f32x4*)(bias + col + 4);
                    const f32x4 v0 = acc[ai][bj][m][0] + b0, v1 = acc[ai][bj][m][1] + b1;
                    const u32x4 yw = *(const u32x4*)(YG + (size_t)row * 512 + col);
                    float y[8]; y[0] = __uint_as_float(yw.x << 16); y[1] = __uint_as_float(yw.x & 0xffff0000u); y[2] = __uint_as_float(yw.y << 16); y[3] = __uint_as_float(yw.y & 0xffff0000u);
                    y[4] = __uint_as_float(yw.z << 16); y[5] = __uint_as_float(yw.z & 0xffff0000u); y[6] = __uint_as_float(yw.w << 16); y[7] = __uint_as_float(yw.w & 0xffff0000u);
                    float o[8];
#pragma unroll
                    for (int i = 0; i < 4; ++i) { o[i] = y[i] / (1.f + __expf(-v0[i])); o[4 + i] = y[4 + i] / (1.f + __expf(-v1[i])); }
                    u32x4 w; w.x = cvt_pk_bf16(o[0], o[1]); w.y = cvt_pk_bf16(o[2], o[3]); w.z = cvt_pk_bf16(o[4], o[5]); w.w = cvt_pk_bf16(o[6], o[7]);
                    *(u32x4*)(O + (size_t)row * ldo + ocol0 + col) = w; } }
    }
};
struct EpiRes {
    static constexpr bool PERM = true, AFTER_DRAIN = false;
    const float* base; float* out; int ldc;
    __device__ __forceinline__ void operator()(const f32x4 (&acc)[2][2][4][2], const Unit& u, int wr, int wc, int fr, int fq) const {
        const int row0 = u.pm * BM + wr * 64 + fr; const int col0 = u.pn * BM + wc * 32 + 8 * fq;
#pragma unroll
        for (int ai = 0; ai < 2; ++ai)
#pragma unroll
            for (int m = 0; m < 4; ++m) { const size_t off = (size_t)(row0 + ai * HALF + m * 16) * ldc + col0;
#pragma unroll
                for (int bj = 0; bj < 2; ++bj) {
                    const f32x4 x0 = *(const f32x4*)(base + off + bj * HALF), x1 = *(const f32x4*)(base + off + bj * HALF + 4);
                    *(f32x4*)(out + off + bj * HALF) = x0 + acc[ai][bj][m][0]; *(f32x4*)(out + off + bj * HALF + 4) = x1 + acc[ai][bj][m][1]; } }
    }
};

struct EpiResB {
    static constexpr bool PERM = true, AFTER_DRAIN = false;
    const bf16_t* XB; float* out; int ldc;
    __device__ __forceinline__ void operator()(const f32x4 (&acc)[2][2][4][2], const Unit& u, int wr, int wc, int fr, int fq) const {
        const int row0 = u.pm * BM + wr * 64 + fr; const int col0 = u.pn * BM + wc * 32 + 8 * fq;
        u32x4 wres[2][4][2];
#pragma unroll
        for (int ai = 0; ai < 2; ++ai)
#pragma unroll
            for (int m = 0; m < 4; ++m)
#pragma unroll
                for (int bj = 0; bj < 2; ++bj) wres[ai][m][bj] = *(const u32x4*)(XB + (size_t)(row0 + ai * HALF + m * 16) * ldc + col0 + bj * HALF);
#pragma unroll
        for (int ai = 0; ai < 2; ++ai)
#pragma unroll
            for (int m = 0; m < 4; ++m) { const size_t off = (size_t)(row0 + ai * HALF + m * 16) * ldc + col0;
#pragma unroll
                for (int bj = 0; bj < 2; ++bj) { const u32x4 w = wres[ai][m][bj];
                    const f32x4 x0 = (f32x4){__uint_as_float(w.x << 16), __uint_as_float(w.x & 0xffff0000u), __uint_as_float(w.y << 16), __uint_as_float(w.y & 0xffff0000u)};
                    const f32x4 x1 = (f32x4){__uint_as_float(w.z << 16), __uint_as_float(w.z & 0xffff0000u), __uint_as_float(w.w << 16), __uint_as_float(w.w & 0xffff0000u)};
                    *(f32x4*)(out + off + bj * HALF) = x0 + acc[ai][bj][m][0]; *(f32x4*)(out + off + bj * HALF + 4) = x1 + acc[ai][bj][m][1]; } }
    }
};
struct EpiX1 {
    static constexpr bool PERM = true, AFTER_DRAIN = false;
    const float* base; float* out; bf16_t* XB; float* SSQ; int ldc;
    __device__ __forceinline__ void operator()(const f32x4 (&acc)[2][2][4][2], const Unit& u, int wr, int wc, int fr, int fq) const {
        const int row0 = u.pm * BM + wr * 64 + fr; const int col0 = u.pn * BM + wc * 32 + 8 * fq;
        u32x4 xres[2][4][2];
#pragma unroll
        for (int ai = 0; ai < 2; ++ai)
#pragma unroll
            for (int m = 0; m < 4; ++m)
#pragma unroll
                for (int bj = 0; bj < 2; ++bj) xres[ai][m][bj] = *(const u32x4*)(XB + (size_t)(row0 + ai * HALF + m * 16) * ldc + col0 + bj * HALF);
#pragma unroll
        for (int ai = 0; ai < 2; ++ai)
#pragma unroll
            for (int m = 0; m < 4; ++m) { const int row = row0 + ai * HALF + m * 16; const size_t off = (size_t)row * ldc + col0; float q = 0.f;
#pragma unroll
                for (int bj = 0; bj < 2; ++bj) { const u32x4 xw = xres[ai][m][bj];
                    const f32x4 x0 = (f32x4){__uint_as_float(xw.x << 16), __uint_as_float(xw.x & 0xffff0000u), __uint_as_float(xw.y << 16), __uint_as_float(xw.y & 0xffff0000u)} + acc[ai][bj][m][0];
                    const f32x4 x1 = (f32x4){__uint_as_float(xw.z << 16), __uint_as_float(xw.z & 0xffff0000u), __uint_as_float(xw.w << 16), __uint_as_float(xw.w & 0xffff0000u)} + acc[ai][bj][m][1];
                    q += (x0[0] * x0[0] + x0[1] * x0[1]) + (x0[2] * x0[2] + x0[3] * x0[3]) + (x1[0] * x1[0] + x1[1] * x1[1]) + (x1[2] * x1[2] + x1[3] * x1[3]);
                    u32x4 w; w.x = cvt_pk_bf16(x0[0], x0[1]); w.y = cvt_pk_bf16(x0[2], x0[3]); w.z = cvt_pk_bf16(x1[0], x1[1]); w.w = cvt_pk_bf16(x1[2], x1[3]);
                    *(u32x4*)(XB + off + bj * HALF) = w; }
                q += __shfl_xor(q, 16); q += __shfl_xor(q, 32);
                if (fq == 0) SSQ[(size_t)row * 16 + u.pn * 4 + wc] = q; }
    }
};
__device__ __forceinline__ float row_up1(float prev, float cur) { float t; asm volatile("s_nop 1\n\tv_mov_b32_dpp %0, %1 row_ror:1 row_mask:0xf bank_mask:0xf\n\tv_mov_b32_dpp %0, %2 row_shr:1 row_mask:0xf bank_mask:0xf" : "=&v"(t) : "v"(prev), "v"(cur)); return t; }
__device__ __forceinline__ float row_up2(float prev, float cur) { float t; asm volatile("s_nop 1\n\tv_mov_b32_dpp %0, %1 row_ror:2 row_mask:0xf bank_mask:0xf\n\tv_mov_b32_dpp %0, %2 row_shr:2 row_mask:0xf bank_mask:0xf" : "=&v"(t) : "v"(prev), "v"(cur)); return t; }

struct EpiIn {
    static constexpr bool PERM = true, AFTER_DRAIN = false;
    const float* rstd1; const float* gq; const float* gk; bf16_t* O; size_t stride; float c2;
    __device__ __forceinline__ void operator()(const f32x4 (&acc)[2][2][4][2], const Unit& u, int wr, int wc, int fr, int fq) const {
        const int row0 = u.pm * BM + wr * 64 + fr; const int t = u.pn >> 1; bf16_t* base = O + (size_t)t * stride + ((u.pn & 1) * 4 + wc) * 64 + 8 * fq;
        f32x4 gv[2][2];
        if (t < 2) { const float* gp = t ? gk : gq; const float sc = t ? 1.f : c2;
#pragma unroll
            for (int bj = 0; bj < 2; ++bj)
#pragma unroll
                for (int n = 0; n < 2; ++n) gv[bj][n] = *(const f32x4*)(gp + 32 * bj + 8 * fq + 4 * n) * sc; }
        float rsA[2][4];
#pragma unroll
        for (int ai = 0; ai < 2; ++ai)
#pragma unroll
            for (int m = 0; m < 4; ++m) rsA[ai][m] = rstd1[row0 + ai * HALF + m * 16];
#pragma unroll
        for (int ai = 0; ai < 2; ++ai)
#pragma unroll
            for (int m = 0; m < 4; ++m) { const int row = row0 + ai * HALF + m * 16; float rs = rsA[ai][m];
                f32x4 v[2][2];
#pragma unroll
                for (int bj = 0; bj < 2; ++bj)
#pragma unroll
                    for (int n = 0; n < 2; ++n) v[bj][n] = acc[ai][bj][m][n] * rs;
                if (t < 2) { float q = 0.f;
#pragma unroll
                    for (int bj = 0; bj < 2; ++bj)
#pragma unroll
                        for (int n = 0; n < 2; ++n) q += (v[bj][n][0] * v[bj][n][0] + v[bj][n][1] * v[bj][n][1]) + (v[bj][n][2] * v[bj][n][2] + v[bj][n][3] * v[bj][n][3]);
                    q += __shfl_xor(q, 16); q += __shfl_xor(q, 32);
                    const float hr = __builtin_amdgcn_rsqf(q * (1.f / 64.f) + 1e-6f);
#pragma unroll
                    for (int bj = 0; bj < 2; ++bj)
#pragma unroll
                        for (int n = 0; n < 2; ++n) v[bj][n] = v[bj][n] * gv[bj][n] * hr; }
#pragma unroll
                for (int bj = 0; bj < 2; ++bj) { u32x4 w; w.x = cvt_pk_bf16(v[bj][0][0], v[bj][0][1]); w.y = cvt_pk_bf16(v[bj][0][2], v[bj][0][3]); w.z = cvt_pk_bf16(v[bj][1][0], v[bj][1][1]); w.w = cvt_pk_bf16(v[bj][1][2], v[bj][1][3]);
                    *(u32x4*)(base + (size_t)row * 512 + 32 * bj) = w; } }
    }
};
struct EpiUpConv {
    static constexpr bool PERM = true, AFTER_DRAIN = false;
    const float* SSQ; const float* cw; const float* cb; bf16_t* ACT; float* HALO; __attribute__((address_space(3))) float* XCH;
    __device__ __forceinline__ void operator()(f32x4 (&acc)[2][2][4][2], const Unit& u, int wr, int wc, int fr, int fq) const {
        const int row0 = u.pm * BM + wr * 64 + fr; const int tcol = wc * 32 + 8 * fq;
        const int ac0 = u.pn * HALF + tcol;
        f32x4 prm[2][8];
#define LOAD_PRM(n) do { prm[n][0] = *(const f32x4*)(cb + ac0 + 4 * (n)); prm[n][1] = *(const f32x4*)(cb + 2816 + ac0 + 4 * (n)); \
            _Pragma("unroll") for (int j = 0; j < 3; ++j) { prm[n][2 + 2 * j] = *(const f32x4*)(cw + j * 5632 + ac0 + 4 * (n)); prm[n][3 + 2 * j] = *(const f32x4*)(cw + j * 5632 + 2816 + ac0 + 4 * (n)); } } while (0)
        LOAD_PRM(0);
#pragma unroll
        for (int ai = 0; ai < 2; ++ai)
#pragma unroll
            for (int m = 0; m < 4; ++m) { const f32x4 a0 = *(const f32x4*)(SSQ + (size_t)(row0 + ai * HALF + m * 16) * 16 + 4 * fq);
                float tot = (a0[0] + a0[1]) + (a0[2] + a0[3]); tot += __shfl_xor(tot, 16); tot += __shfl_xor(tot, 32);
                const float rstd = __builtin_amdgcn_rsqf(tot * (1.f / 1024.f) + 1e-6f);
#pragma unroll
                for (int bj = 0; bj < 2; ++bj) { acc[ai][bj][m][0] *= rstd; acc[ai][bj][m][1] *= rstd; }
                __builtin_amdgcn_sched_barrier(0); }
        if (fr >= 14) {
#pragma unroll
            for (int ai = 0; ai < 2; ++ai)
#pragma unroll
                for (int bj = 0; bj < 2; ++bj)
#pragma unroll
                    for (int n = 0; n < 2; ++n) { XCH[((ai * 2 + wr) * 2 + (fr - 14)) * 256 + bj * HALF + tcol + 4 * n + 0] = acc[ai][bj][3][n][0]; XCH[((ai * 2 + wr) * 2 + (fr - 14)) * 256 + bj * HALF + tcol + 4 * n + 1] = acc[ai][bj][3][n][1];
                        XCH[((ai * 2 + wr) * 2 + (fr - 14)) * 256 + bj * HALF + tcol + 4 * n + 2] = acc[ai][bj][3][n][2]; XCH[((ai * 2 + wr) * 2 + (fr - 14)) * 256 + bj * HALF + tcol + 4 * n + 3] = acc[ai][bj][3][n][3]; }
            if (wr == 1) {
#pragma unroll
                for (int bj = 0; bj < 2; ++bj)
#pragma unroll
                    for (int n = 0; n < 2; ++n) *(f32x4*)(HALO + ((size_t)u.pm * 4 + (fr - 14)) * 5632 + u.pn * BM + bj * HALF + tcol + 4 * n) = acc[1][bj][3][n];
            }
        }
        if (fr < 2 && wr == 0) {
#pragma unroll
            for (int bj = 0; bj < 2; ++bj)
#pragma unroll
                for (int n = 0; n < 2; ++n) *(f32x4*)(HALO + ((size_t)u.pm * 4 + 2 + fr) * 5632 + u.pn * BM + bj * HALF + tcol + 4 * n) = acc[0][bj][0][n];
        }
        asm volatile("s_waitcnt lgkmcnt(0)" ::: "memory"); __builtin_amdgcn_s_barrier(); asm volatile("" ::: "memory");
        LOAD_PRM(1);
#undef LOAD_PRM
#pragma unroll
        for (int n = 0; n < 2; ++n) {
            const f32x4 cbg = prm[n][0], cbv = prm[n][1], w0g = prm[n][2], w0v = prm[n][3], w1g = prm[n][4], w1v = prm[n][5], w2g = prm[n][6], w2v = prm[n][7];
#pragma unroll
            for (int ai = 0; ai < 2; ++ai)
#pragma unroll
                for (int m = 3; m >= 0; --m) {
                    f32x4 pg, pv;
                    if (m > 0) { pg = acc[ai][0][m - 1][n]; pv = acc[ai][1][m - 1][n]; }
                    else { const int blk = (wr == 1) ? ai * 2 : 1; const bool have = (wr == 1) || (ai == 1);
                        pg = (f32x4){0.f, 0.f, 0.f, 0.f}; pv = pg;
                        if (have && fr >= 14) { pg = *(const __attribute__((address_space(3))) f32x4*)(XCH + (blk * 2 + (fr - 14)) * 256 + tcol + 4 * n); pv = *(const __attribute__((address_space(3))) f32x4*)(XCH + (blk * 2 + (fr - 14)) * 256 + HALF + tcol + 4 * n); } }
                    const f32x4 cg = acc[ai][0][m][n], cv = acc[ai][1][m][n]; f32x4 o;
#pragma unroll
                    for (int i = 0; i < 4; ++i) {
                        const float g1 = row_up1(pg[i], cg[i]), g2 = row_up2(pg[i], cg[i]), v1 = row_up1(pv[i], cv[i]), v2 = row_up2(pv[i], cv[i]);
                        const float hg = cbg[i] + w0g[i] * g2 + w1g[i] * g1 + w2g[i] * cg[i], hv = cbv[i] + w0v[i] * v2 + w1v[i] * v1 + w2v[i] * cv[i];
                        float oi = hg * __builtin_amdgcn_rcpf(1.f + __expf(-hg)) * hv; asm volatile("" : "+v"(oi)); o[i] = oi; }
                    acc[ai][0][m][n] = o; __builtin_amdgcn_sched_barrier(0); }
        }
#pragma unroll
        for (int ai = 0; ai < 2; ++ai)
#pragma unroll
            for (int m = 0; m < 4; ++m) { const f32x4 v0 = acc[ai][0][m][0], v1 = acc[ai][0][m][1];
                u32x4 w; w.x = cvt_pk_bf16(v0[0], v0[1]); w.y = cvt_pk_bf16(v0[2], v0[3]); w.z = cvt_pk_bf16(v1[0], v1[1]); w.w = cvt_pk_bf16(v1[2], v1[3]);
                *(u32x4*)(ACT + (size_t)(row0 + ai * HALF + m * 16) * 2816 + ac0) = w; }
    }
};
}

struct Args { const float* in[24]; float* out; unsigned char* ws; int ph_lo, ph_hi; };

__device__ __forceinline__ float log_sigmoid(float z) { return fminf(z, 0.f) - log1pf(expf(-fabsf(z))); }
typedef short s16x8p __attribute__((ext_vector_type(8)));
constexpr int WF_LO_OFF = 32768;
__device__ __forceinline__ void p0_prologue(const Args& a, LAS unsigned char* lds, int vcu, int gw, int NGW, int tid, int wave, int lane) {
    unsigned char* ws = a.ws;
    {
        const float* x = a.in[0]; const float* gm = a.in[1]; const float* win = a.in[2]; const float* bfv = a.in[3];
        float* logf = (float*)(ws + WS_TAB + TB_LOGF); float* rstd1 = (float*)(ws + WS_TAB + TB_RSTD1); bf16* XB = (bf16*)(ws + WS_XB);
        for (int i = tid; i < 32768; i += NTHR) ((LAS unsigned*)lds)[i >> 1 << 1 | (i & 1)] = 0u;
        __syncthreads();
        for (int k = tid; k < D; k += NTHR) { const float g = gm[k]; const f32x4 w0 = *(const f32x4*)(win + (size_t)k * INC + 1536), w1 = *(const f32x4*)(win + (size_t)k * INC + 1540);
            const float w[8] = {w0[0] * g, w0[1] * g, w0[2] * g, w0[3] * g, w1[0] * g, w1[1] * g, w1[2] * g, w1[3] * g};
            const int ks = k >> 5, q = (k >> 3) & 3, i = k & 7;
#pragma unroll
            for (int h = 0; h < 8; ++h) { const unsigned hb = f2bf(w[h]); const float lo = w[h] - bf2f(hb); const int off = ((ks * 4 + q) * 16 + h) * 16 + i * 2;
                *(LAS bf16*)(lds + off) = (bf16)hb; *(LAS bf16*)(lds + WF_LO_OFF + off) = (bf16)f2bf(lo); } }
        __syncthreads();
        const int m = lane & 15, q = lane >> 4, half = wave & 1;
        LAS float* XR = (LAS float*)(lds + 65536);
        for (int blk = vcu * 4 + (wave >> 1); blk < M / 16; blk += (NGW / 8) * 4) {
            const size_t row = (size_t)blk * 16 + m; const float* xr = x + row * D + 512 * half + 8 * q;
            f32x4 acc = (f32x4){0.f, 0.f, 0.f, 0.f}; float ssq = 0.f;
#pragma unroll
            for (int ks = 0; ks < 16; ++ks) {
                const f32x4 x0 = __builtin_nontemporal_load((const f32x4*)(xr + 32 * ks)), x1 = __builtin_nontemporal_load((const f32x4*)(xr + 32 * ks + 4));
                const float xv[8] = {x0[0], x0[1], x0[2], x0[3], x1[0], x1[1], x1[2], x1[3]};
                unsigned hb[8]; float lo[8];
#pragma unroll
                for (int i = 0; i < 8; ++i) { hb[i] = f2bf(xv[i]); lo[i] = xv[i] - bf2f(hb[i]); ssq += xv[i] * xv[i]; }
                v4u hw; hw.x = hb[0] | (hb[1] << 16); hw.y = hb[2] | (hb[3] << 16); hw.z = hb[4] | (hb[5] << 16); hw.w = hb[6] | (hb[7] << 16);
                const v4u lw = pack8(lo);
                *(v4u*)(XB + row * D + 512 * half + 32 * ks + 8 * q) = hw;
                const int kst = 16 * half + ks;
                const s16x8p bh = *(const LAS s16x8p*)(lds + ((kst * 4 + q) * 16 + m) * 16), bl = *(const LAS s16x8p*)(lds + WF_LO_OFF + ((kst * 4 + q) * 16 + m) * 16);
                const s16x8p ah = __builtin_bit_cast(s16x8p, hw), al = __builtin_bit_cast(s16x8p, lw);
                acc = __builtin_amdgcn_mfma_f32_16x16x32_bf16(ah, bh, acc, 0, 0, 0);
                acc = __builtin_amdgcn_mfma_f32_16x16x32_bf16(ah, bl, acc, 0, 0, 0);
                acc = __builtin_amdgcn_mfma_f32_16x16x32_bf16(al, bh, acc, 0, 0, 0);
            }
            ssq += __shfl_xor(ssq, 16); ssq += __shfl_xor(ssq, 32);
            __syncthreads();
            if (half) { LAS float* p = XR + ((wave >> 1) * 64 + lane) * 5; p[0] = acc[0]; p[1] = acc[1]; p[2] = acc[2]; p[3] = acc[3]; p[4] = ssq; }
            __syncthreads();
            if (!half) { const LAS float* p = XR + ((wave >> 1) * 64 + lane) * 5; acc[0] += p[0]; acc[1] += p[1]; acc[2] += p[2]; acc[3] += p[3]; ssq += p[4];
                const float rstd = 1.f / sqrtf(ssq * (1.f / D) + EPS);
                if (q == 0) rstd1[row] = rstd;
#pragma unroll
                for (int j = 0; j < 4; ++j) { const float rt = __shfl(rstd, 4 * q + j); if (m < 8) logf[((size_t)blk * 16 + 4 * q + j) * 8 + m] = log_sigmoid(acc[j] * rt + bfv[m]); } }
        }
        __syncthreads();
    }
    {
        constexpr int I_IN = 32 * 32, I_GLU = 8 * 16, I_OUT = 16 * 32, I_UP = 88 * 32, I_DN = 16 * 88, NITEMS = I_IN + I_GLU + I_OUT + I_UP + I_DN;
        struct WItem { const float* src; const float* g; bf16* dst; int ldn; int frag; };
        auto decode = [&](int it, WItem& w) {
            int r = it;
            if (r < I_IN) { const int nb = r / 32, kb = r % 32, dn = 64 * nb + lane, tl = dn >> 8, c = dn & 255;
                int sn = tl * 256 + 64 * ((c >> 5) & 3) + 32 * (c >> 7) + (c & 31); if (sn >= 1536) sn += 8;
                w.src = a.in[2] + (size_t)(32 * kb) * INC + sn; w.ldn = INC; w.g = a.in[1] + 32 * kb; w.dst = (bf16*)(ws + WS_WIN) + (size_t)dn * D + 32 * kb; w.frag = 0; return; } r -= I_IN;
            if (r < I_GLU) { const int nb = r / 16, kb = r % 16, dn = 64 * nb + lane;
                w.src = a.in[14] + (size_t)(32 * kb) * SW + dn; w.ldn = SW; w.g = nullptr; w.dst = (bf16*)(ws + WS_WGLU) + ((size_t)(kb * 32 + (dn >> 4)) * 64 + (dn & 15)) * 8; w.frag = 1; return; } r -= I_GLU;
            if (r < I_OUT) { const int nb = r / 32, kb = r % 32, dn = 64 * nb + lane, k0 = 32 * kb;
                w.src = a.in[18] + (size_t)k0 * D + dn; w.ldn = D; w.g = (k0 < AW) ? a.in[16] + k0 : a.in[17] + (k0 - AW); w.dst = (bf16*)(ws + WS_WOUT) + (size_t)dn * D + k0; w.frag = 0; return; } r -= I_OUT;
            if (r < I_UP) { const int nb = r / 32, kb = r % 32, dn = 64 * nb + lane, tl = dn >> 8, cc = dn & 255, sn = cc < 128 ? 128 * tl + cc : DFF + 128 * tl + cc - 128;
                w.src = a.in[20] + (size_t)(32 * kb) * NUP + sn; w.ldn = NUP; w.g = a.in[19] + 32 * kb; w.dst = (bf16*)(ws + WS_WUP) + (size_t)dn * D + 32 * kb; w.frag = 0; return; } r -= I_UP;
            { const int nb = r / 88, kb = r % 88, dn = 64 * nb + lane;
                w.src = a.in[23] + (size_t)(32 * kb) * D + dn; w.ldn = D; w.g = nullptr; w.dst = (bf16*)(ws + WS_WDN) + (size_t)dn * DFF + 32 * kb; w.frag = 0; }
        };
        for (int it = gw; it < NITEMS; it += 2 * NGW) {
            const bool two = it + NGW < NITEMS;
            WItem w0, w1; decode(it, w0); decode(two ? it + NGW : it, w1);
            float v0[32], v1[32];
#pragma unroll
            for (int i = 0; i < 32; ++i) v0[i] = w0.src[(size_t)i * w0.ldn];
            if (two) {
#pragma unroll
                for (int i = 0; i < 32; ++i) v1[i] = w1.src[(size_t)i * w1.ldn]; }
            if (w0.g) {
#pragma unroll
                for (int i = 0; i < 32; ++i) v0[i] *= w0.g[i]; }
            if (two && w1.g) {
#pragma unroll
                for (int i = 0; i < 32; ++i) v1[i] *= w1.g[i]; }
#pragma unroll
            for (int j = 0; j < 4; ++j) *(v4u*)(w0.dst + (w0.frag ? j * 128 : 8 * j)) = pack8(v0 + 8 * j);
            if (two) {
#pragma unroll
                for (int j = 0; j < 4; ++j) *(v4u*)(w1.dst + (w1.frag ? j * 128 : 8 * j)) = pack8(v1 + 8 * j); }
        }
    }
    {
        const float* lre = a.in[6]; const float* lim = a.in[7]; const float* lst = a.in[8]; const float* bre = a.in[9]; const float* bim = a.in[10]; const float* cre = a.in[11]; const float* cim = a.in[12];
        float* LB = (float*)(ws + WS_TAB + TB_LB); bf16* BBP = (bf16*)(ws + WS_TAB + TB_BBP); unsigned* CP = (unsigned*)(ws + WS_TAB + TB_CP);
        for (int j = gw * 64 + lane; j < NG * NP * GS; j += NGW * 64) {
            const int i = j >> 4, h = j & 15, g = i / NP, p = i % NP, n = p & 31, slot = p >> 5;
            const float lr = lre[i], li = lim[i], lsv = lst[g], br = bre[j], bi = bim[j], cr = cre[(size_t)(g * GS + h) * NP + p], ci = cim[(size_t)(g * GS + h) * NP + p];
            const float step = expf(lsv), er = expf(lr * step), ar = er * cosf(li * step), ai = er * sinf(li * step);
            const float nr = ar - 1.f, ni = ai, den = lr * lr + li * li;
            const float fr = (nr * lr + ni * li) / den, fi = (ni * lr - nr * li) / den;
            if (h == 0) { LB[2 * i] = ar; LB[2 * i + 1] = ai; }
            BBP[((size_t)(g * 4 + slot) * 32 + n) * 16 + h] = (bf16)f2bf(fr * br - fi * bi); BBP[((size_t)(g * 4 + 2 + slot) * 32 + n) * 16 + h] = (bf16)f2bf(fr * bi + fi * br);
            CP[(size_t)(g * GS + h) * 64 + p] = pk2(cr, -ci);
        }
    }
}

__device__ __forceinline__ void cumsum_bh(const Args& a, int bh, int lane) {
    const float* logf = (const float*)(a.ws + WS_TAB + TB_LOGF); float* cum = (float*)(a.ws + WS_TAB + TB_CUM);
    const int b = bh / NH, h = bh % NH; float loc[32]; float t = 0.f;
#pragma unroll
    for (int i = 0; i < 32; ++i) { t += logf[((size_t)b * SEQ + 32 * lane + i) * 8 + h]; loc[i] = t; }
    float incl = t;
#pragma unroll
    for (int o = 1; o < 64; o <<= 1) { const float nn = __shfl_up(incl, o); if (lane >= o) incl += nn; }
    const float excl = incl - t;
#pragma unroll
    for (int i = 0; i < 32; ++i) cum[(size_t)bh * SEQ + 32 * lane + i] = (loc[i] + excl) * 1.4426950408889634f;
}

__device__ __forceinline__ float gelu_tanh(float x) { const float u = 0.7978845608028654f * (x + 0.044715f * x * x * x); const float e = __expf(2.f * u); return x * (1.f - __builtin_amdgcn_rcpf(e + 1.f)); }
typedef short s16x8 __attribute__((ext_vector_type(8)));
typedef float v2f __attribute__((ext_vector_type(2)));
typedef float f32x16v __attribute__((ext_vector_type(16)));
#define CFMA(xr, xi, lr, li, br, bi) do { const float nr_ = fmaf(lr, xr, fmaf(-(li), xi, br)), ni_ = fmaf(lr, xi, fmaf(li, xr, bi)); xr = nr_; xi = ni_; } while (0)
#define CSQR(r, i) do { const float nr_ = r * r - i * i, ni_ = 2.f * r * i; r = nr_; i = ni_; } while (0)
__device__ __forceinline__ void ssm_a_unit(const Args& a, int unit, int wave, int lane) {
    unsigned char* ws = a.ws;
    const int b = unit >> 5, c = unit & 31; const size_t t0 = (size_t)b * SEQ + 64 * c;
    const int n = lane & 31, hi = lane >> 5, sig = 16 * ((n >> 2) & 1) + 4 * (n >> 3) + (n & 3);
    const bf16* U = (const bf16*)(ws + WS_U); const float* LB = (const float*)(ws + WS_TAB + TB_LB); const bf16* BBP = (const bf16*)(ws + WS_TAB + TB_BBP); float* SS = (float*)(ws + WS_SS);
    const f32x16v zero = f32x16v{};
#pragma unroll 1
    for (int gi = 0; gi < 4; ++gi) {
        const int g = wave * 4 + gi;
        float lr[2], li[2], l16r[2], l16i[2];
#pragma unroll
        for (int sl = 0; sl < 2; ++sl) { lr[sl] = LB[2 * (g * NP + n + 32 * sl)]; li[sl] = LB[2 * (g * NP + n + 32 * sl) + 1]; l16r[sl] = lr[sl]; l16i[sl] = li[sl];
#pragma unroll
            for (int q = 0; q < 4; ++q) CSQR(l16r[sl], l16i[sl]); }
        s16x8 bfr[4];
#pragma unroll
        for (int nb = 0; nb < 4; ++nb) bfr[nb] = *(const s16x8*)(BBP + ((size_t)(g * 4 + nb) * 32 + n) * 16 + 8 * hi);
        float tr[2] = {0.f, 0.f}, ti[2] = {0.f, 0.f};
#pragma unroll
        for (int sb = 0; sb < 2; ++sb) {
            const s16x8 afr = *(const s16x8*)(U + (t0 + 32 * sb + sig) * SW + 16 * g + 8 * hi);
            f32x16v d[4];
#pragma unroll
            for (int nb = 0; nb < 4; ++nb) d[nb] = __builtin_amdgcn_mfma_f32_32x32x16_bf16(afr, bfr[nb], zero, 0, 0, 0);
#pragma unroll
            for (int sl = 0; sl < 2; ++sl) { float sr = 0.f, si = 0.f;
#pragma unroll
                for (int r = 0; r < 16; ++r) CFMA(sr, si, lr[sl], li[sl], d[sl][r], d[2 + sl][r]);
                if (sb == 0) { float qr = l16r[sl], qi = l16i[sl]; CSQR(qr, qi); tr[sl] = qr * sr - qi * si; ti[sl] = qr * si + qi * sr; }
                else { tr[sl] += sr; ti[sl] += si; } }
        }
#pragma unroll
        for (int sl = 0; sl < 2; ++sl) {
            float vr = tr[sl], vi = ti[sl];
            if (hi == 0) { const float nr = l16r[sl] * vr - l16i[sl] * vi, ni = l16r[sl] * vi + l16i[sl] * vr; vr = nr; vi = ni; }
            vr += __shfl_xor(vr, 32); vi += __shfl_xor(vi, 32);
            if (hi == 0) { float* o = SS + ((((size_t)b * 32 + c) * NG + g) * NP + n + 32 * sl) * 2; o[0] = vr; o[1] = vi; }
        }
    }
}
constexpr int XT_PITCH = 68, XT_BYTES = 32 * XT_PITCH * 4, YT_OFF = 8 * XT_BYTES, YT_PITCH = 1040, RED_OFF = YT_OFF + 64 * YT_PITCH;
static_assert(RED_OFF + 2048 <= LDS_BYTES, "ssm LDS");
__device__ __forceinline__ void ssm_b_unit(const Args& a, LAS unsigned char* lds, int unit, int wave, int lane) {
    unsigned char* ws = a.ws;
    const int b = unit >> 5, c = unit & 31; const size_t t0 = (size_t)b * SEQ + 64 * c;
    const int n = lane & 31, hi = lane >> 5, fr = lane & 15, fq = lane >> 4, sig = 16 * ((n >> 2) & 1) + 4 * (n >> 3) + (n & 3);
    const bf16* U = (const bf16*)(ws + WS_U); const float* LB = (const float*)(ws + WS_TAB + TB_LB); const bf16* BBP = (const bf16*)(ws + WS_TAB + TB_BBP);
    const bf16* CP = (const bf16*)(ws + WS_TAB + TB_CP); const float* SS = (const float*)(ws + WS_SS); const float* dsk = a.in[13];
    LAS unsigned* XT = (LAS unsigned*)(lds + wave * XT_BYTES);
    LAS unsigned char* YT = lds + YT_OFF; LAS float* RED = (LAS float*)(lds + RED_OFF);
    const f32x16v zero = f32x16v{};
    float xcrA[4][2], xciA[4][2];
    {
        float l128r[4][2], l128i[4][2], wr_[4][2], wi_[4][2];
#pragma unroll
        for (int gi = 0; gi < 4; ++gi)
#pragma unroll
            for (int sl = 0; sl < 2; ++sl) { const int g = wave * 4 + gi; const v2f lb = *(const v2f*)(LB + 2 * (g * NP + n + 32 * sl));
                float r = lb.x, i = lb.y;
#pragma unroll
                for (int q = 0; q < 4; ++q) CSQR(r, i);
                CSQR(r, i); CSQR(r, i);
                wr_[gi][sl] = hi ? r : 1.f; wi_[gi][sl] = hi ? i : 0.f; CSQR(r, i); l128r[gi][sl] = r; l128i[gi][sl] = i; xcrA[gi][sl] = 0.f; xciA[gi][sl] = 0.f; }
        const float* sp0 = SS + ((((size_t)b * 32) * NG + wave * 4) * NP + n) * 2;
#pragma unroll 2
        for (int k = hi; k < c; k += 2) {
#pragma unroll
            for (int gi = 0; gi < 4; ++gi)
#pragma unroll
                for (int sl = 0; sl < 2; ++sl) { const v2f sv = *(const v2f*)(sp0 + (size_t)(c - 1 - k) * NG * NP * 2 + (gi * NP + 32 * sl) * 2);
                    xcrA[gi][sl] += wr_[gi][sl] * sv.x - wi_[gi][sl] * sv.y; xciA[gi][sl] += wr_[gi][sl] * sv.y + wi_[gi][sl] * sv.x;
                    const float nwr = wr_[gi][sl] * l128r[gi][sl] - wi_[gi][sl] * l128i[gi][sl], nwi = wr_[gi][sl] * l128i[gi][sl] + wi_[gi][sl] * l128r[gi][sl]; wr_[gi][sl] = nwr; wi_[gi][sl] = nwi; } }
#pragma unroll
        for (int gi = 0; gi < 4; ++gi)
#pragma unroll
            for (int sl = 0; sl < 2; ++sl) { xcrA[gi][sl] += __shfl_xor(xcrA[gi][sl], 32); xciA[gi][sl] += __shfl_xor(xciA[gi][sl], 32); }
    }
#pragma unroll 1
    for (int gp = 0; gp < 2; ++gp)
#pragma unroll
    for (int gi2 = 0; gi2 < 2; ++gi2) {
        const int gi = 2 * gp + gi2, g = wave * 4 + gi;
        float lr[2], li[2], l16r[2], l16i[2], xcr[2], xci[2];
#pragma unroll
        for (int sl = 0; sl < 2; ++sl) { const v2f lb = *(const v2f*)(LB + 2 * (g * NP + n + 32 * sl)); lr[sl] = lb.x; li[sl] = lb.y; l16r[sl] = lb.x; l16i[sl] = lb.y;
#pragma unroll
            for (int q = 0; q < 4; ++q) CSQR(l16r[sl], l16i[sl]);
            xcr[sl] = gp ? xcrA[2 + gi2][sl] : xcrA[gi2][sl]; xci[sl] = gp ? xciA[2 + gi2][sl] : xciA[gi2][sl]; }
        s16x8 bfr[4], cfr[4];
#pragma unroll
        for (int nb = 0; nb < 4; ++nb) bfr[nb] = *(const s16x8*)(BBP + ((size_t)(g * 4 + nb) * 32 + n) * 16 + 8 * hi);
#pragma unroll
        for (int kk = 0; kk < 4; ++kk) cfr[kk] = *(const s16x8*)(CP + (size_t)(g * GS + fr) * 128 + 32 * kk + 8 * fq);
        const f32x4 dk = *(const f32x4*)(dsk + g * GS + 4 * fq);
#pragma unroll
        for (int sb = 0; sb < 2; ++sb) {
            const s16x8 afr = *(const s16x8*)(U + (t0 + 32 * sb + sig) * SW + 16 * g + 8 * hi);
            f32x16v d[4];
#pragma unroll
            for (int nb = 0; nb < 4; ++nb) d[nb] = __builtin_amdgcn_mfma_f32_32x32x16_bf16(afr, bfr[nb], zero, 0, 0, 0);
#pragma unroll
            for (int sl = 0; sl < 2; ++sl) {
                float sr = 0.f, si = 0.f;
#pragma unroll
                for (int r = 0; r < 16; ++r) CFMA(sr, si, lr[sl], li[sl], d[sl][r], d[2 + sl][r]);
                const float orr = __shfl_xor(sr, 32), oii = __shfl_xor(si, 32);
                const float ser = hi ? orr : sr, sei = hi ? oii : si, sor = hi ? sr : orr, soi = hi ? si : oii;
                float xnr = xcr[sl], xni = xci[sl]; CFMA(xnr, xni, l16r[sl], l16i[sl], ser, sei);
                float xr = hi ? xnr : xcr[sl], xi = hi ? xni : xci[sl];
                float x2r = xnr, x2i = xni; CFMA(x2r, x2i, l16r[sl], l16i[sl], sor, soi); xcr[sl] = x2r; xci[sl] = x2i;
#pragma unroll
                for (int r = 0; r < 16; ++r) { CFMA(xr, xi, lr[sl], li[sl], d[sl][r], d[2 + sl][r]); XT[(16 * hi + r) * XT_PITCH + n + 32 * sl] = pg8::cvt_pk_bf16(xr, xi); }
            }
#pragma unroll
            for (int mb = 0; mb < 2; ++mb) {
                f32x4 acc = (f32x4){0.f, 0.f, 0.f, 0.f};
#pragma unroll
                for (int kk = 0; kk < 4; ++kk) { const s16x8 xf = *(const LAS s16x8*)(XT + (16 * mb + fr) * XT_PITCH + 16 * kk + 4 * fq); acc = __builtin_amdgcn_mfma_f32_16x16x32_bf16(cfr[kk], xf, acc, 0, 0, 0); }
                const int s = 32 * sb + 16 * mb + fr;
                const v2u uw = *(const v2u*)(U + (t0 + s) * SW + 16 * g + 4 * fq);
                const float y0 = gelu_tanh(acc[0] + dk[0] * bf2f(uw.x & 0xffffu)), y1 = gelu_tanh(acc[1] + dk[1] * bf2f(uw.x >> 16)), y2 = gelu_tanh(acc[2] + dk[2] * bf2f(uw.y & 0xffffu)), y3 = gelu_tanh(acc[3] + dk[3] * bf2f(uw.y >> 16));
                v2u yw; yw.x = pg8::cvt_pk_bf16(y0, y1); yw.y = pg8::cvt_pk_bf16(y2, y3);
                *(LAS v2u*)(YT + s * YT_PITCH + (16 * g + 4 * fq) * 2) = yw;
            }
        }
    }
    __syncthreads();
    const bf16* WG = (const bf16*)(ws + WS_WGLU); const float* bg = a.in[15]; bf16* MIX = (bf16*)(ws + WS_MIX);
    f32x4 acc[4][4];
#pragma unroll
    for (int mb = 0; mb < 4; ++mb)
#pragma unroll
        for (int nb = 0; nb < 4; ++nb) acc[mb][nb] = (f32x4){0.f, 0.f, 0.f, 0.f};
    s16x8 wq[4][4];
    const bf16* wpf = WG + ((size_t)(4 * wave) * 64 + lane) * 8;
#pragma unroll
    for (int st = 0; st < 3; ++st) {
#pragma unroll
        for (int nb = 0; nb < 4; ++nb) wq[st][nb] = *(const s16x8*)(wpf + nb * 512);
        wpf += 32 * 512; }
#pragma unroll 1
    for (int kk4 = 0; kk4 < 16; kk4 += 4) {
        asm volatile("" : "+v"(wpf));
#pragma unroll
        for (int j = 0; j < 4; ++j) {
            const int kk = kk4 + j;
            s16x8 wf[4], yf[4];
#pragma unroll
            for (int nb = 0; nb < 4; ++nb) wf[nb] = wq[j][nb];
            if (kk + 3 < 16) {
#pragma unroll
                for (int nb = 0; nb < 4; ++nb) wq[(j + 3) & 3][nb] = *(const s16x8*)(wpf + nb * 512);
                wpf += 32 * 512; }
#pragma unroll
            for (int mb = 0; mb < 4; ++mb) yf[mb] = *(const LAS s16x8*)(YT + (16 * mb + fr) * YT_PITCH + (32 * kk + 8 * fq) * 2);
#pragma unroll
            for (int mb = 0; mb < 4; ++mb)
#pragma unroll
                for (int nb = 0; nb < 4; ++nb) acc[mb][nb] = __builtin_amdgcn_mfma_f32_16x16x32_bf16(wf[nb], yf[mb], acc[mb][nb], 0, 0, 0);
        }
    }
#pragma unroll
    for (int mb = 0; mb < 4; ++mb) { float q = 0.f;
#pragma unroll
        for (int nb = 0; nb < 4; ++nb) { const int n0 = 64 * wave + 16 * nb + 4 * fq; const f32x4 bv = *(const f32x4*)(bg + n0);
            const v2u yw = *(const LAS v2u*)(YT + (16 * mb + fr) * YT_PITCH + n0 * 2);
            const float y[4] = {bf2f(yw.x & 0xffffu), bf2f(yw.x >> 16), bf2f(yw.y & 0xffffu), bf2f(yw.y >> 16)};
#pragma unroll
            for (int j = 0; j < 4; ++j) { const float o = y[j] * __builtin_amdgcn_rcpf(1.f + __expf(-(acc[mb][nb][j] + bv[j]))); acc[mb][nb][j] = o; q += o * o; } }
        q += __shfl_xor(q, 16); q += __shfl_xor(q, 32);
        if (fq == 0) RED[wave * 64 + 16 * mb + fr] = q; }
    __syncthreads();
#pragma unroll
    for (int mb = 0; mb < 4; ++mb) { const int s = 16 * mb + fr; float tot = 0.f;
#pragma unroll
        for (int w = 0; w < 8; ++w) tot += RED[w * 64 + s];
        const float rstd = 1.f / sqrtf(tot * (1.f / SW) + EPS);
#pragma unroll
        for (int nb = 0; nb < 4; ++nb) { v2u ow; ow.x = pg8::cvt_pk_bf16(acc[mb][nb][0] * rstd, acc[mb][nb][1] * rstd); ow.y = pg8::cvt_pk_bf16(acc[mb][nb][2] * rstd, acc[mb][nb][3] * rstd);
            *(v2u*)(MIX + (t0 + s) * D + AW + 64 * wave + 16 * nb + 4 * fq) = ow; } }
    { v4u w[8];
#pragma unroll
      for (int r = 0; r < 8; ++r) w[r] = *(const v4u*)(MIX + (t0 + wave * 8 + r) * D + 8 * lane);
#pragma unroll
      for (int r = 0; r < 8; ++r) { float f[8]; unpack8(w[r], f); float q = 0.f;
#pragma unroll
          for (int i = 0; i < 8; ++i) q += f[i] * f[i];
          const float rstd = 1.f / sqrtf(wave_sum(q) * (1.f / AW) + EPS);
#pragma unroll
          for (int i = 0; i < 8; ++i) f[i] *= rstd;
          *(v4u*)(MIX + (t0 + wave * 8 + r) * D + 8 * lane) = pack8(f); } }
    __syncthreads();
}

__device__ __forceinline__ void p_fixup(const Args& a, int pm, int tid) {
    const float* HALO = (const float*)(a.ws + WS_HALO); bf16* ACT = (bf16*)(a.ws + WS_ACT); const float* cw = a.in[21]; const float* cb = a.in[22];
    if ((pm & 7) == 0) return;
    const float* hp = HALO + (size_t)(pm - 1) * 4 * 5632; const float* hc = HALO + (size_t)pm * 4 * 5632;
    v2u res[3];
#pragma unroll
    for (int k = 0; k < 3; ++k) {
        const int it = tid + k * NTHR, itc = it < 2 * (DFF / 4) ? it : 0, r = itc / (DFF / 4), ac = (itc % (DFF / 4)) * 4, cg = (ac >> 7) * 256 + (ac & 127), cv = cg + 128;
        const f32x4 g0 = *(const f32x4*)((r ? hp + 5632 : hp) + cg), g1 = *(const f32x4*)((r ? hc + 2 * 5632 : hp + 5632) + cg), g2 = *(const f32x4*)((r ? hc + 3 * 5632 : hc + 2 * 5632) + cg);
        const f32x4 v0 = *(const f32x4*)((r ? hp + 5632 : hp) + cv), v1 = *(const f32x4*)((r ? hc + 2 * 5632 : hp + 5632) + cv), v2 = *(const f32x4*)((r ? hc + 3 * 5632 : hc + 2 * 5632) + cv);
        const f32x4 hg = *(const f32x4*)(cb + ac) + *(const f32x4*)(cw + ac) * g0 + *(const f32x4*)(cw + NUP + ac) * g1 + *(const f32x4*)(cw + 2 * NUP + ac) * g2;
        const f32x4 hv = *(const f32x4*)(cb + DFF + ac) + *(const f32x4*)(cw + DFF + ac) * v0 + *(const f32x4*)(cw + NUP + DFF + ac) * v1 + *(const f32x4*)(cw + 2 * NUP + DFF + ac) * v2;
        float o[4];
#pragma unroll
        for (int i = 0; i < 4; ++i) o[i] = hg[i] * __builtin_amdgcn_rcpf(1.f + __expf(-hg[i])) * hv[i];
        res[k].x = pk2(o[0], o[1]); res[k].y = pk2(o[2], o[3]);
    }
#pragma unroll
    for (int k = 0; k < 3; ++k) { const int it = tid + k * NTHR; if (it < 2 * (DFF / 4)) { const int r = it / (DFF / 4), ac = (it % (DFF / 4)) * 4; *(v2u*)(ACT + (size_t)(pm * 256 + r) * DFF + ac) = res[k]; } }
}

#define XB_TMO      128
#define XB_XCNT(j)  (256  + 64 * (j))
#define XB_XSUB(j)  (1280 + 64 * (j))
#define XB_XGEN(j)  (2304 + 64 * (j))
#define XB_TOP      3328
#define XB_TOPGEN   3392
#define XCD_BAR_WORDS 3456
#define XB_SPIN_CAP (1u << 18)

__device__ __forceinline__ unsigned xb_ld(unsigned* p)              { return __hip_atomic_load(p, __ATOMIC_RELAXED, __HIP_MEMORY_SCOPE_AGENT); }
__device__ __forceinline__ unsigned xb_add(unsigned* p, unsigned v) { return __hip_atomic_fetch_add(p, v, __ATOMIC_RELAXED, __HIP_MEMORY_SCOPE_AGENT); }
__device__ __forceinline__ unsigned xb_xcc_id() { return (unsigned)__builtin_amdgcn_s_getreg((3 << 11) | 20) & 0xFu; }
#define XB_SPIN(cond, bar) do { unsigned _sp = 0; while (cond) { __builtin_amdgcn_s_sleep(1); \
    if ((++_sp & 255u) == 0u) { if (xb_ld(&(bar)[XB_TMO])) break; if (_sp > XB_SPIN_CAP) { atomicAdd(&(bar)[XB_TMO], 1u); break; } } } } while (0)

struct XcdBarrier {
    unsigned* bar; unsigned x;
    volatile LAS unsigned* st;
};

__device__ __forceinline__ XcdBarrier xcd_barrier_post(unsigned* bar, volatile LAS unsigned* st) {
    XcdBarrier b; b.bar = bar; b.x = xb_xcc_id(); b.st = st;
    if (threadIdx.x == 0) (void)xb_add(&bar[XB_XCNT(b.x)], 1u);
    return b;
}
__device__ __forceinline__ void xcd_barrier_complete(unsigned* bar, unsigned x, unsigned& nloc, unsigned& nx) {
    const unsigned G = gridDim.x * gridDim.y * gridDim.z;
    unsigned sum, cnt, mine, sp = 0u;
    for (;;) {
        sum = 0u; cnt = 0u; mine = 0u;
#pragma unroll
        for (unsigned j = 0; j < 16; ++j) { const unsigned c = xb_ld(&bar[XB_XCNT(j)]); sum += c; cnt += (c > 0u) ? 1u : 0u; mine = (j == x) ? c : mine; }
        if (sum == G) break;
        __builtin_amdgcn_s_sleep(1);
        if ((++sp & 255u) == 0u) { if (xb_ld(&bar[XB_TMO])) break; if (sp > XB_SPIN_CAP) { atomicAdd(&bar[XB_TMO], 1u); break; } }
    }
    nloc = mine > 0u ? mine : 1u; nx = cnt > 0u ? cnt : 1u;
}

__device__ __forceinline__ void xcd_barrier(const XcdBarrier& b) {
    asm volatile("s_waitcnt vmcnt(0)" ::: "memory");
    __syncthreads();
    if (threadIdx.x == 0) {
        unsigned* bar = b.bar;
        __builtin_amdgcn_s_waitcnt(0);
        unsigned nloc = b.st[0], nx = b.st[1];
        if (nloc == 0u) { xcd_barrier_complete(bar, b.x, nloc, nx); b.st[0] = nloc; b.st[1] = nx; }
        const unsigned old = xb_add(&bar[XB_XSUB(b.x)], 1u);
        const unsigned gen = old / nloc;
        if (old + 1u == (gen + 1u) * nloc) {
            __builtin_amdgcn_fence(__ATOMIC_RELEASE, "agent");
            asm volatile("s_waitcnt vmcnt(0)" ::: "memory");
            const unsigned og = xb_add(&bar[XB_TOP], 1u);
            const unsigned tg = og / nx;
            if (og + 1u == (tg + 1u) * nx) xb_add(&bar[XB_TOPGEN], 1u);
            else XB_SPIN(xb_ld(&bar[XB_TOPGEN]) == tg, bar);
            __builtin_amdgcn_fence(__ATOMIC_ACQUIRE, "agent");
            xb_add(&bar[XB_XGEN(b.x)], 1u);
            asm volatile("s_waitcnt vmcnt(0)" ::: "memory");
        } else {
            XB_SPIN(xb_ld(&bar[XB_XGEN(b.x)]) == gen, bar);
            __builtin_amdgcn_fence(__ATOMIC_ACQUIRE, "agent");
            asm volatile("s_waitcnt vmcnt(0)" ::: "memory");
        }
    }
    __syncthreads();
}

__global__ void __launch_bounds__(NTHR, 2) fwd_kernel(Args args) {
    extern __shared__ __attribute__((aligned(16))) unsigned char lds_raw[];
    LAS unsigned char* lds = (LAS unsigned char*)lds_raw;
    cg::grid_group grid = cg::this_grid();
    int tid = threadIdx.x, lane = tid & 63; const int wave = __builtin_amdgcn_readfirstlane(tid >> 6);
    const int G = gridDim.x, bx = blockIdx.x, vcu = (G % 8 == 0) ? (bx % 8) * (G / 8) + bx / 8 : bx;
    const int gw = vcu * NWAVES + wave, NGW = G * NWAVES, NT = G * NTHR; int gtid = vcu * NTHR + tid;
    unsigned char* ws = args.ws;
    const int lo = args.ph_lo, hi = args.ph_hi;
    volatile LAS unsigned* MISC = (volatile LAS unsigned*)(lds + LDS_BYTES - 128);
    if (tid < 32) MISC[tid] = 0u;
    __syncthreads();
    XcdBarrier bar; bar.bar = (unsigned*)ws + 4096; bar.x = 0; bar.st = nullptr;
    if (hi - lo > 1) {
        if (bx == 0) for (int i = tid; i < XCD_BAR_WORDS; i += NTHR) ((unsigned*)ws)[4096 + i] = 0u;
        grid.sync();
        bar = xcd_barrier_post((unsigned*)ws + 4096, MISC + 8); }
#define IN(k) (lo <= (k) && (k) < hi)
#define REFRESH() do { int t_ = threadIdx.x; asm volatile("" : "+v"(t_)); tid = t_; lane = tid & 63; gtid = vcu * NTHR + tid; } while (0)
#define SYNC(k) do { if (IN(k) && IN((k) + 1)) xcd_barrier(bar); REFRESH(); } while (0)
    if (IN(0)) { p0_prologue(args, lds, vcu, gw, NGW, tid, wave, lane); } SYNC(0);
    if (IN(1)) {
        if (bx < BATCH * NH && wave == 0) cumsum_bh(args, bx, lane);
        pg8::Gemm g{(const pg8::bf16_t*)(ws + WS_XB), (const pg8::bf16_t*)(ws + WS_WIN), M, 2048, D}; pg8::StaticOrder S; S.init(M, 2048, G, bx);
        pg8::EpiIn E{(const float*)(ws + WS_TAB + TB_RSTD1), args.in[4], args.in[5], (pg8::bf16_t*)(ws + WS_Q), (size_t)M * AW, attn_body::C2};
        pg8::gemm_phase<pg8::EpiIn, pg8::StaticOrder, true, true>(lds, g, S, E);
    } SYNC(1);
    if (IN(2)) {
        { const attn_body::AttnTensors AT{(const attn_body::bf16*)(ws + WS_Q), (const attn_body::bf16*)(ws + WS_K), (const attn_body::bf16*)(ws + WS_V), (attn_body::bf16*)(ws + WS_MIX), (const float*)(ws + WS_TAB + TB_CUM)};
          const attn_body::StaticOrder AS(G, bx); attn_body::attn_phase<attn_body::StaticOrder, 64>((char*)lds_raw, AT, AS); }
        for (int u = bx; u < BATCH * 32; u += G) ssm_a_unit(args, u, wave, lane);
    } SYNC(2);
    if (IN(3)) {
        for (int u = bx; u < BATCH * 32; u += G) ssm_b_unit(args, lds, u, wave, lane);
    } SYNC(3);
    if (IN(4)) {
        pg8::Gemm g{(const pg8::bf16_t*)(ws + WS_MIX), (const pg8::bf16_t*)(ws + WS_WOUT), M, D, D}; pg8::StaticOrder S; S.init(M, D, G, bx);
        pg8::EpiX1 E{args.in[0], args.out, (pg8::bf16_t*)(ws + WS_XB), (float*)(ws + WS_TAB + TB_SSQ2), D};
        pg8::gemm_phase<pg8::EpiX1, pg8::StaticOrder, true, true>(lds, g, S, E);
    } SYNC(4);
    if (IN(5)) {
        pg8::Gemm g{(const pg8::bf16_t*)(ws + WS_XB), (const pg8::bf16_t*)(ws + WS_WUP), M, NUP, D}; pg8::StaticOrder S; S.init(M, NUP, G, bx);
        pg8::EpiUpConv E{(const float*)(ws + WS_TAB + TB_SSQ2), args.in[21], args.in[22], (pg8::bf16_t*)(ws + WS_ACT), (float*)(ws + WS_HALO), (LAS float*)(lds + RING_BYTES)};
        pg8::gemm_phase<pg8::EpiUpConv, pg8::StaticOrder, true, true>(lds, g, S, E);
    } SYNC(5);
    if (IN(6)) {
        pg8::Gemm g{(const pg8::bf16_t*)(ws + WS_ACT), (const pg8::bf16_t*)(ws + WS_WDN), M, D, DFF}; pg8::StaticOrder S; S.init(M, D, G, bx);
        { pg8::Unit u0; for (int i = 0; S.next(i, u0); ++i) p_fixup(args, u0.pm, tid); asm volatile("s_waitcnt vmcnt(0)" ::: "memory"); __syncthreads(); }
        pg8::EpiResB E{(const pg8::bf16_t*)(ws + WS_XB), args.out, D};
        pg8::gemm_phase<pg8::EpiResB, pg8::StaticOrder, true, true>(lds, g, S, E);
    }
#undef IN
#undef SYNC
}

constexpr int N_PHASES = 7;
#ifndef MK_MULTI
#define MK_MULTI 0
#endif
extern "C" void kernel_launch(void* const* d_in, const int* in_sizes, int n_in, void* d_out, int out_size, void* d_ws, size_t ws_size, hipStream_t stream) {
    static int grid = 0;
    if (grid == 0) {
        if (n_in != 24 || out_size != M * D || ws_size < WS_END) { fprintf(stderr, "kernel_launch: unexpected sizes n_in %d out %d ws %zu\n", n_in, out_size, ws_size); grid = -1; return; }
        int dev = 0, cus = 0, per_cu = 0;
        hipGetDevice(&dev); hipDeviceGetAttribute(&cus, hipDeviceAttributeMultiprocessorCount, dev);
        hipFuncSetAttribute((const void*)fwd_kernel, hipFuncAttributeMaxDynamicSharedMemorySize, LDS_BYTES);
        hipOccupancyMaxActiveBlocksPerMultiprocessor(&per_cu, (const void*)fwd_kernel, NTHR, LDS_BYTES);
        (void)hipGetLastError();
        if (per_cu < 1) { fprintf(stderr, "kernel_launch: occupancy query says %d blocks per CU\n", per_cu); per_cu = 1; }
        grid = cus * 1;
        fprintf(stderr, "kernel_launch: cus %d per_cu %d grid %d\n", cus, per_cu, grid);
    }
    if (grid < 0) return;
    Args a{};
    for (int i = 0; i < 24; ++i) a.in[i] = (const float*)d_in[i];
    a.out = (float*)d_out; a.ws = (unsigned char*)d_ws;
#if MK_MULTI
    for (int p = 0; p < N_PHASES; ++p) { a.ph_lo = p; a.ph_hi = p + 1; hipLaunchKernelGGL(fwd_kernel, dim3(grid), dim3(NTHR), LDS_BYTES, stream, a); }
#else
    a.ph_lo = 0; a.ph_hi = N_PHASES;
    void* kargs[] = {&a};
    hipError_t e = hipLaunchCooperativeKernel((const void*)fwd_kernel, dim3(grid), dim3(NTHR), kargs, LDS_BYTES, stream);
    if (e != hipSuccess) fprintf(stderr, "cooperative launch failed: %s (grid %d)\n", hipGetErrorString(e), grid);
#endif
}
```

```cpp
#include <hip/hip_runtime.h>
#include <hip/hip_cooperative_groups.h>
#include <cstdio>
#include <cstdint>
namespace cg = cooperative_groups;
namespace pg8 {
#define PG8_LAS __attribute__((address_space(3)))
typedef unsigned short bf16_t;
typedef short bf16x8 __attribute__((ext_vector_type(8)));
typedef float f32x4 __attribute__((ext_vector_type(4)));
typedef unsigned u32x4 __attribute__((ext_vector_type(4)));
constexpr int BM = 256, BK = 64, HALF = 128, HTB = HALF * BK * 2  , STAGE_BYTES = 8 * HTB, NXCD = 8, WGM = 8;

__host__ __device__ __forceinline__ int lds_byte(int r, int c) { const int st = (r >> 4) * 2 + (c >> 5), rr = r & 15, cc = c & 31, ob = rr * 64 + cc * 2; return st * 1024 + (ob ^ (((ob >> 9) & 1) << 5)); }
__host__ __device__ __forceinline__ void stage_rc(int b, int& R, int& C) { const int st = b / 1024, sb = b % 1024, swz = sb ^ (((sb >> 9) & 1) << 5); R = (st >> 1) * 16 + swz / 64; C = (st & 1) * 32 + (swz % 64) / 2; }
__host__ __device__ __forceinline__ int perm32(int rho) { const int n = rho >> 4, i = rho & 15; return 8 * (i >> 2) + 4 * n + (i & 3); }

struct Unit { int pm, pn; };
struct Gemm { const bf16_t* A; const bf16_t* Bt; int M, N, K; };

struct StaticOrder {
    int nM, nN, nwg, G, c;
    __host__ __device__ void init(int M, int N, int G_, int c_) { nM = M / BM; nN = N / BM; nwg = nM * nN; G = G_; c = c_; }
    __host__ __device__ bool next(int i, Unit& u) const {
        const long L = (long)i * G + c; if (L >= nwg) return false;
        int wgid = (int)L; { const int q = nwg / NXCD, r = nwg % NXCD, xcd = wgid % NXCD, off = wgid / NXCD; wgid = (xcd < r ? xcd * (q + 1) : r * (q + 1) + (xcd - r) * q) + off; }
        const int nig = WGM * nN, gid = wgid / nig, fm = gid * WGM, gsz = (nM - fm) < WGM ? (nM - fm) : WGM;
        u.pm = fm + ((wgid % nig) % gsz); u.pn = (wgid % nig) / gsz; return true;
    }
    __device__ __forceinline__ void a_ready(const Unit&) const {}
    __device__ __forceinline__ void done(const Unit&) const {}
};

__device__ __forceinline__ unsigned cvt_pk_bf16(float lo, float hi) { unsigned r; asm volatile("v_cvt_pk_bf16_f32 %0, %1, %2" : "=v"(r) : "v"(lo), "v"(hi)); return r; }
typedef float f32x2 __attribute__((ext_vector_type(2)));
__device__ __forceinline__ f32x2 gelu_pk(f32x2 v) {
    const f32x2 av = __builtin_elementwise_abs(v), d = av * 0.2316418882f + 1.0f;
    f32x2 t; t.x = __builtin_amdgcn_rcpf(d.x); t.y = __builtin_amdgcn_rcpf(d.y);
    f32x2 q = t * 0.5307027145f + (-0.7265760135f); q = q * t + 0.7107068705f; q = q * t + (-0.142248368f); q = q * t + 0.127414796f; q = q * t;
    const f32x2 s = (v * v) * (-0.72134752044f);
    f32x2 e; e.x = __builtin_amdgcn_exp2f(s.x); e.y = __builtin_amdgcn_exp2f(s.y);
    const f32x2 m = v * (q * e), r = v - m;
    f32x2 o; o.x = v.x < 0.f ? m.x : r.x; o.y = v.y < 0.f ? m.y : r.y; return o;
}

template <int ACT  > struct EpiBf16 {
    static constexpr bool PERM = true, AFTER_DRAIN = false; static_assert(ACT == 0 || ACT == 1, "EpiBf16: ACT is 0 (none) or 1 (gelu_pk)");
    bf16_t* O; int ldc; const float* bias; int split_cols; size_t split_stride; float scale0;
    __device__ __forceinline__ void operator()(const f32x4 (&acc)[2][2][4][2], const Unit& u, int wr, int wc, int fr, int fq) const {
        const int row0 = u.pm * BM + wr * 64 + fr; int colt = u.pn * BM; bf16_t* base = O;
        float sc = 1.f; if (split_cols) { const int t = colt / split_cols; base += (size_t)t * split_stride; colt -= t * split_cols; if (t == 0) sc = scale0; }
        const int col0 = colt + wc * 32 + 8 * fq, bcol0 = u.pn * BM + wc * 32 + 8 * fq;
        f32x4 bv[2][2];
#pragma unroll
        for (int bj = 0; bj < 2; ++bj)
#pragma unroll
            for (int n = 0; n < 2; ++n) bv[bj][n] = bias ? *(const f32x4*)(bias + bcol0 + bj * HALF + 4 * n) : (f32x4){0.f, 0.f, 0.f, 0.f};
#pragma unroll
        for (int ai = 0; ai < 2; ++ai)
#pragma unroll
            for (int m = 0; m < 4; ++m) { bf16_t* rowp = base + (size_t)(row0 + ai * HALF + m * 16) * ldc + col0;
#pragma unroll
                for (int bj = 0; bj < 2; ++bj) { f32x4 v0 = acc[ai][bj][m][0] + bv[bj][0], v1 = acc[ai][bj][m][1] + bv[bj][1];
                    if (ACT == 1) { f32x2 a = gelu_pk((f32x2){v0[0], v0[1]}), b = gelu_pk((f32x2){v0[2], v0[3]}), c = gelu_pk((f32x2){v1[0], v1[1]}), d = gelu_pk((f32x2){v1[2], v1[3]});
                        v0 = (f32x4){a.x, a.y, b.x, b.y}; v1 = (f32x4){c.x, c.y, d.x, d.y}; }
                    v0 = v0 * sc; v1 = v1 * sc; u32x4 w; w.x = cvt_pk_bf16(v0[0], v0[1]); w.y = cvt_pk_bf16(v0[2], v0[3]); w.z = cvt_pk_bf16(v1[0], v1[1]); w.w = cvt_pk_bf16(v1[2], v1[3]);
                    *(u32x4*)(rowp + bj * HALF) = w; } }
    }
};

struct PanelStats {
    unsigned* xbuf;
    unsigned* cnt;
    unsigned* tmo;
    int ntn; float eps;
    unsigned code;
    __device__ __forceinline__ bool run(const f32x4 (&v)[2][2][4][2], const Unit& u, int wr, int wc, int fr, int fq, PG8_LAS unsigned char* lds, int wid, int lane) const {
        typedef float f32x2v __attribute__((ext_vector_type(2)));
        PG8_LAS f32x2v* P = (PG8_LAS f32x2v*)lds;
        PG8_LAS f32x2v* S = (PG8_LAS f32x2v*)(lds + 8192);
        PG8_LAS unsigned* flag = (PG8_LAS unsigned*)(lds + 8192 + 2048);
#pragma unroll
        for (int ai = 0; ai < 2; ++ai)
#pragma unroll
            for (int m = 0; m < 4; ++m) {
                float s = 0.f;
#pragma unroll
                for (int bj = 0; bj < 2; ++bj)
#pragma unroll
                    for (int n = 0; n < 2; ++n) { const f32x4 x = v[ai][bj][m][n]; s += (x[0] + x[1]) + (x[2] + x[3]); }
                s += __shfl_xor(s, 16); s += __shfl_xor(s, 32);
                const float mw = s * (1.0f / 64.0f); float q = 0.f;
#pragma unroll
                for (int bj = 0; bj < 2; ++bj)
#pragma unroll
                    for (int n = 0; n < 2; ++n) { const f32x4 d = v[ai][bj][m][n] - mw; q += (d[0] * d[0] + d[1] * d[1]) + (d[2] * d[2] + d[3] * d[3]); }
                q += __shfl_xor(q, 16); q += __shfl_xor(q, 32);
                if (fq == 0) P[(ai * HALF + wr * 64 + m * 16 + fr) * 4 + wc] = (f32x2v){mw, q};
            }
        asm volatile("s_waitcnt lgkmcnt(0)" ::: "memory"); __builtin_amdgcn_s_barrier(); asm volatile("" ::: "memory");
#if defined(BROKEN_EXCHANGE_NO_WAIT)
#warning BROKEN CONTROL BUILD: the row-statistics exchange does not wait; results are wrong by design
        if (blockIdx.x >= 64) { const long long t0_ = clock64(); while (clock64() - t0_ < 60000) __builtin_amdgcn_s_sleep(8); }
#endif
        const int row = wid * 32 + (lane & 31);
        if (lane < 32) {
            const f32x2v a = P[row * 4 + 0], b = P[row * 4 + 1], c = P[row * 4 + 2], d = P[row * 4 + 3];
            const float mt = (a.x + b.x + c.x + d.x) * 0.25f;
            const float da = a.x - mt, db = b.x - mt, dc = c.x - mt, dd = d.x - mt;
            const float m2 = (a.y + b.y) + (c.y + d.y) + 64.0f * ((da * da + db * db) + (dc * dc + dd * dd));
            unsigned long long* slot = (unsigned long long*)xbuf + ((size_t)(u.pm * BM + row) * 4 + u.pn);
            __hip_atomic_store(slot, ((unsigned long long)__float_as_uint(m2) << 32) | __float_as_uint(mt), __ATOMIC_RELAXED, __HIP_MEMORY_SCOPE_AGENT);
        }
        asm volatile("s_waitcnt vmcnt(0)" ::: "memory");
        if (lane == 0) __hip_atomic_fetch_add(cnt + 64 * u.pm, 1u, __ATOMIC_RELAXED, __HIP_MEMORY_SCOPE_AGENT);
        if (wid == 0) {
            bool dead = false; const unsigned long long t0 = __builtin_amdgcn_s_memrealtime(); const unsigned want = 8u * (unsigned)ntn;
            for (;;) {
#if defined(BROKEN_EXCHANGE_NO_WAIT)
                break;
#endif
                if ((unsigned)__builtin_amdgcn_readfirstlane(__hip_atomic_load(cnt + 64 * u.pm, __ATOMIC_RELAXED, __HIP_MEMORY_SCOPE_AGENT)) >= want) break;
                if (__builtin_amdgcn_s_memrealtime() - t0 > 2000000ull) {
                    if (lane == 0) { unsigned expect = 0u; __hip_atomic_compare_exchange_strong(tmo + 1, &expect, code | (unsigned)(u.pm & 0xff), __ATOMIC_RELAXED, __ATOMIC_RELAXED, __HIP_MEMORY_SCOPE_AGENT);
                                     __hip_atomic_store(tmo, 1u, __ATOMIC_RELAXED, __HIP_MEMORY_SCOPE_AGENT); }
                    dead = true; break; }
                __builtin_amdgcn_s_sleep(2);
            }
            __builtin_amdgcn_fence(__ATOMIC_ACQUIRE, "agent");
            if (lane == 0) flag[0] = dead ? 1u : 0u;
        }
        asm volatile("s_waitcnt vmcnt(0) lgkmcnt(0)" ::: "memory"); __builtin_amdgcn_s_barrier(); asm volatile("" ::: "memory");
        const bool bad = flag[0] != 0u;
        if (lane < 32) {
            const unsigned long long* slot = (const unsigned long long*)xbuf + (size_t)(u.pm * BM + row) * 4; float mt[4], m2[4]; float ms = 0.f;
#pragma unroll
            for (int t = 0; t < 4; ++t) { if (t < ntn) { const unsigned long long w = __hip_atomic_load(slot + t, __ATOMIC_RELAXED, __HIP_MEMORY_SCOPE_AGENT); mt[t] = __uint_as_float((unsigned)w); m2[t] = __uint_as_float((unsigned)(w >> 32)); } else { mt[t] = 0.f; m2[t] = 0.f; } ms += mt[t]; }
            const float mean = ms / (float)ntn; float q = 0.f;
#pragma unroll
            for (int t = 0; t < 4; ++t) if (t < ntn) { const float dm = mt[t] - mean; q += m2[t] + 256.0f * dm * dm; }
            S[row] = (f32x2v){mean, 1.0f / sqrtf(q / (256.0f * (float)ntn) + eps)};
        }
        asm volatile("s_waitcnt lgkmcnt(0)" ::: "memory"); __builtin_amdgcn_s_barrier(); asm volatile("" ::: "memory");
        return bad;
    }
};
struct EpiLnRes {
    static constexpr bool PERM = false, AFTER_DRAIN = true;
    const float* base; float* out; int ldc; const float* bias; PanelStats st; unsigned poison;
    __device__ __forceinline__ void fused(f32x4 (&acc)[2][2][4][2], const Unit& u, int wr, int wc, int fr, int fq, PG8_LAS unsigned char* lds, int wid, int lane) const {
        typedef float f32x2v __attribute__((ext_vector_type(2)));
        const PG8_LAS f32x2v* S = (const PG8_LAS f32x2v*)(lds + 8192);
        const int col0 = u.pn * BM + wc * 32 + 4 * fq;
#pragma unroll
        for (int bj = 0; bj < 2; ++bj)
#pragma unroll
            for (int n = 0; n < 2; ++n) { const f32x4 bv = bias ? *(const f32x4*)(bias + col0 + bj * HALF + n * 16) : (f32x4){0.f, 0.f, 0.f, 0.f};
#pragma unroll
                for (int ai = 0; ai < 2; ++ai)
#pragma unroll
                    for (int m = 0; m < 4; ++m) acc[ai][bj][m][n] += bv; }
        f32x4 pre[4][2][2];
#pragma unroll
        for (int m = 0; m < 4; ++m) { const size_t off = (size_t)(u.pm * BM + wr * 64 + m * 16 + fr) * ldc + col0;
#pragma unroll
            for (int bj = 0; bj < 2; ++bj)
#pragma unroll
                for (int n = 0; n < 2; ++n) pre[m][bj][n] = *(const f32x4*)(base + off + bj * HALF + n * 16); }
        const bool bad = st.run(acc, u, wr, wc, fr, fq, lds, wid, lane) || poison != 0u;
        const float qnan = __builtin_nanf("");
#pragma unroll
        for (int ai = 0; ai < 2; ++ai)
#pragma unroll
            for (int m = 0; m < 4; ++m) { const int r = ai * HALF + wr * 64 + m * 16 + fr; const f32x2v sr = S[r]; const size_t off = (size_t)(u.pm * BM + r) * ldc + col0;
#pragma unroll
                for (int bj = 0; bj < 2; ++bj)
#pragma unroll
                    for (int n = 0; n < 2; ++n) { const f32x4 bs = ai == 0 ? pre[m][bj][n] : *(const f32x4*)(base + off + bj * HALF + n * 16); f32x4 o = bs + (acc[ai][bj][m][n] - sr.x) * sr.y;
                        if (bad) o = (f32x4){qnan, qnan, qnan, qnan}; *(f32x4*)(out + off + bj * HALF + n * 16) = o; }
                if (m & 1) asm volatile("" ::: "memory"); }
    }
};
struct EpiLnResLn {
    static constexpr bool PERM = false, AFTER_DRAIN = true;
    const float* base; float* out; bf16_t* xn; int ldc; const float* bias; PanelStats st1, st2; unsigned poison;
    __device__ __forceinline__ void fused(f32x4 (&acc)[2][2][4][2], const Unit& u, int wr, int wc, int fr, int fq, PG8_LAS unsigned char* lds, int wid, int lane) const {
        typedef float f32x2v __attribute__((ext_vector_type(2))); typedef unsigned u32x2v __attribute__((ext_vector_type(2)));
        const PG8_LAS f32x2v* S = (const PG8_LAS f32x2v*)(lds + 8192);
        const int col0 = u.pn * BM + wc * 32 + 4 * fq;
#pragma unroll
        for (int bj = 0; bj < 2; ++bj)
#pragma unroll
            for (int n = 0; n < 2; ++n) { const f32x4 bv = bias ? *(const f32x4*)(bias + col0 + bj * HALF + n * 16) : (f32x4){0.f, 0.f, 0.f, 0.f};
#pragma unroll
                for (int ai = 0; ai < 2; ++ai)
#pragma unroll
                    for (int m = 0; m < 4; ++m) acc[ai][bj][m][n] += bv; }
        bool bad = st1.run(acc, u, wr, wc, fr, fq, lds, wid, lane) || poison != 0u;
        const float qnan = __builtin_nanf("");
#pragma unroll
        for (int ai = 0; ai < 2; ++ai)
#pragma unroll
            for (int m = 0; m < 4; ++m) { const int r = ai * HALF + wr * 64 + m * 16 + fr; const f32x2v sr = S[r]; const size_t off = (size_t)(u.pm * BM + r) * ldc + col0;
#pragma unroll
                for (int bj = 0; bj < 2; ++bj)
#pragma unroll
                    for (int n = 0; n < 2; ++n) { const f32x4 bs = *(const f32x4*)(base + off + bj * HALF + n * 16); acc[ai][bj][m][n] = bs + (acc[ai][bj][m][n] - sr.x) * sr.y; }
                asm volatile("" : "+v"(acc[ai][0][m][0]), "+v"(acc[ai][0][m][1]), "+v"(acc[ai][1][m][0]), "+v"(acc[ai][1][m][1]));
                if (m & 1) asm volatile("" ::: "memory"); }
        const bool bad1 = bad;
        bad = st2.run(acc, u, wr, wc, fr, fq, lds, wid, lane) || bad;
#pragma unroll
        for (int ai = 0; ai < 2; ++ai)
#pragma unroll
            for (int m = 0; m < 4; ++m) { const int r = ai * HALF + wr * 64 + m * 16 + fr; const f32x2v sr = S[r]; const size_t off = (size_t)(u.pm * BM + r) * ldc + col0;
#pragma unroll
                for (int bj = 0; bj < 2; ++bj)
#pragma unroll
                    for (int n = 0; n < 2; ++n) { const f32x4 x1 = acc[ai][bj][m][n]; *(f32x4*)(out + off + bj * HALF + n * 16) = bad1 ? (f32x4){qnan, qnan, qnan, qnan} : x1;
                        const f32x4 o = (x1 - sr.x) * sr.y; u32x2v w; w.x = cvt_pk_bf16(o[0], o[1]); w.y = cvt_pk_bf16(o[2], o[3]);
                        if (bad) { w.x = 0x7fc07fc0u; w.y = 0x7fc07fc0u; } *(u32x2v*)(xn + off + bj * HALF + n * 16) = w; }
                asm volatile("" ::: "memory"); }
    }
};

template <class Epi, class Sched, bool ALIGN_EPI = false, bool SP2 = false>
__device__ __forceinline__ void gemm_phase(PG8_LAS unsigned char* lds, const Gemm g, const Sched& S, const Epi& E) {
    int tid_ = threadIdx.x; asm volatile("" : "+v"(tid_));
    const int tid = tid_, wid = __builtin_amdgcn_readfirstlane(tid >> 6), lane = tid & 63, wr = wid >> 2, wc = wid & 3, fr = lane & 15, fq = lane >> 4;
    const int K = g.K, nt = K / BK;
    unsigned voffA[2], voffB[2];
#pragma unroll
    for (int i = 0; i < 2; ++i) { int R, C; stage_rc(tid * 16 + i * 8192, R, C); const int Rb = Epi::PERM ? ((R & ~31) + perm32(R & 31)) : R;
        voffA[i] = (unsigned)(R * K + C) * 2u; voffB[i] = (unsigned)(Rb * K + C) * 2u; }
    const size_t kstep = (size_t)(BK * 2);
    const size_t hstep = (size_t)HALF * K * 2;
    const size_t tstep = 2 * hstep;
    const unsigned ldsw = (unsigned)wid * 1024u;
    const int aoff = lds_byte(wr * 64 + fr, fq * 8), boff = lds_byte(wc * 32 + fr, fq * 8);
#define PG8_SA(b, h) (((b) * 2 + (h)) * HTB)
#define PG8_SB(b, h) ((4 + (b) * 2 + (h)) * HTB)
#define PG8_STAGE(bufoff, gbase, voff) do { _Pragma("unroll") for (int _i = 0; _i < 2; ++_i) \
        __builtin_amdgcn_global_load_lds((const unsigned*)((const char*)(gbase) + (voff)[_i]), (PG8_LAS unsigned*)(lds + (bufoff) + ldsw + _i * 8192), 16, 0, 0); } while (0)
#define PG8_LDA(dst, b, h) do { _Pragma("unroll") for (int m = 0; m < 4; ++m) _Pragma("unroll") for (int k = 0; k < 2; ++k) dst[m][k] = *(const PG8_LAS bf16x8*)(lds + PG8_SA(b, h) + aoff + m * 2048 + k * 1024); } while (0)
#define PG8_LDB(dst, b, h) do { _Pragma("unroll") for (int n = 0; n < 2; ++n) _Pragma("unroll") for (int k = 0; k < 2; ++k) dst[n][k] = *(const PG8_LAS bf16x8*)(lds + PG8_SB(b, h) + boff + n * 2048 + k * 1024); } while (0)
#define PG8_MMA(ai, bj, At, Bt) do { __builtin_amdgcn_s_setprio(1); _Pragma("unroll") for (int m = 0; m < 4; ++m) _Pragma("unroll") for (int n = 0; n < 2; ++n) _Pragma("unroll") for (int k = 0; k < 2; ++k) \
        acc[ai][bj][m][n] = __builtin_amdgcn_mfma_f32_16x16x32_bf16(Bt[n][k], At[m][k], acc[ai][bj][m][n], 0, 0, 0); __builtin_amdgcn_s_setprio(0); } while (0)
#define PG8_WAIT_V(n) asm volatile("s_waitcnt vmcnt(" #n ")" ::: "memory")
#define PG8_WAIT_L(n) asm volatile("s_waitcnt lgkmcnt(" #n ")" ::: "memory")
#define PG8_BAR __builtin_amdgcn_s_barrier()
#define PG8_SCHED __builtin_amdgcn_sched_barrier(0)
    Unit cur, nxt; int ui = 0;
    if (!S.next(0, cur)) return;
    f32x4 acc[2][2][4][2];
#pragma unroll
    for (int a = 0; a < 2; ++a)
#pragma unroll
        for (int b = 0; b < 2; ++b)
#pragma unroll
            for (int m = 0; m < 4; ++m)
#pragma unroll
                for (int n = 0; n < 2; ++n) acc[a][b][m][n] = (f32x4){0.f, 0.f, 0.f, 0.f};
    bf16x8 At[4][2], B0[2][2], B1[2][2];
    const char* cA = (const char*)g.A + (size_t)cur.pm * tstep; const char* cB = (const char*)g.Bt + (size_t)cur.pn * tstep;
    S.a_ready(cur);
    if constexpr (SP2) {
        PG8_STAGE(PG8_SB(0, 0), cB, voffB); PG8_STAGE(PG8_SB(0, 1), cB + hstep, voffB); PG8_STAGE(PG8_SA(0, 0), cA, voffA); PG8_STAGE(PG8_SA(0, 1), cA + hstep, voffA);
        if (wr == 1) PG8_BAR;
        PG8_WAIT_V(2); PG8_BAR;
        PG8_STAGE(PG8_SB(1, 0), cB + kstep, voffB); PG8_STAGE(PG8_SA(1, 0), cA + kstep, voffA); PG8_STAGE(PG8_SB(1, 1), cB + hstep + kstep, voffB);
        PG8_WAIT_V(6); PG8_BAR;
    } else {
        PG8_STAGE(PG8_SB(0, 0), cB, voffB); PG8_STAGE(PG8_SA(0, 0), cA, voffA); PG8_STAGE(PG8_SB(0, 1), cB + hstep, voffB); PG8_STAGE(PG8_SA(0, 1), cA + hstep, voffA);
        if (wr == 1) PG8_BAR;
        PG8_WAIT_V(4); PG8_BAR;
        PG8_STAGE(PG8_SB(1, 0), cB + kstep, voffB); PG8_STAGE(PG8_SA(1, 0), cA + kstep, voffA); PG8_STAGE(PG8_SB(1, 1), cB + hstep + kstep, voffB);
        PG8_WAIT_V(6); PG8_BAR;
    }
    for (;;) {
        const bool has_next = S.next(ui + 1, nxt);
        const char* nA = has_next ? (const char*)g.A + (size_t)nxt.pm * tstep : cA; const char* nB = has_next ? (const char*)g.Bt + (size_t)nxt.pn * tstep : cB;
        for (int t = 0; t < nt; t += 2) {
            const bool last = (t == nt - 2);
            const char* a1 = cA + (size_t)(t + 1) * kstep;
            const char* a2 = last ? nA : cA + (size_t)(t + 2) * kstep; const char* b2 = last ? nB : cB + (size_t)(t + 2) * kstep;
            const char* a3 = a2 + kstep; const char* b3 = b2 + kstep;
            if (last && has_next) S.a_ready(nxt);
            if constexpr (SP2) {
            PG8_LDB(B0, 0, 0); PG8_LDB(B1, 0, 1); PG8_SCHED; PG8_LDA(At, 0, 0); PG8_STAGE(PG8_SA(1, 1), a1 + hstep, voffA);
            PG8_WAIT_V(8); PG8_WAIT_L(0); PG8_BAR; PG8_MMA(0, 0, At, B0); PG8_MMA(0, 1, At, B1); PG8_BAR; PG8_SCHED;
            PG8_LDA(At, 0, 1); PG8_STAGE(PG8_SB(0, 0), b2, voffB); PG8_STAGE(PG8_SB(0, 1), b2 + hstep, voffB); PG8_STAGE(PG8_SA(0, 0), a2, voffA);
            PG8_WAIT_V(8); PG8_WAIT_L(0); PG8_BAR; PG8_MMA(1, 0, At, B0); PG8_MMA(1, 1, At, B1); PG8_BAR; PG8_SCHED;
            PG8_LDB(B0, 1, 0); PG8_LDB(B1, 1, 1); PG8_SCHED; PG8_LDA(At, 1, 0); PG8_STAGE(PG8_SA(0, 1), a2 + hstep, voffA);
            PG8_WAIT_V(8); PG8_WAIT_L(0); PG8_BAR; PG8_MMA(0, 0, At, B0); PG8_MMA(0, 1, At, B1); PG8_BAR; PG8_SCHED;
            PG8_LDA(At, 1, 1); PG8_STAGE(PG8_SB(1, 0), b3, voffB); PG8_STAGE(PG8_SB(1, 1), b3 + hstep, voffB); PG8_STAGE(PG8_SA(1, 0), a3, voffA);
            PG8_WAIT_V(8); PG8_WAIT_L(0); PG8_BAR; PG8_MMA(1, 0, At, B0); PG8_MMA(1, 1, At, B1); PG8_BAR; PG8_SCHED;
            } else {
            PG8_LDB(B0, 0, 0); PG8_SCHED; PG8_LDA(At, 0, 0); PG8_STAGE(PG8_SA(1, 1), a1 + hstep, voffA);
            PG8_WAIT_L(8); PG8_BAR; PG8_WAIT_L(0); PG8_MMA(0, 0, At, B0); PG8_BAR; PG8_SCHED;
            PG8_LDB(B1, 0, 1); PG8_STAGE(PG8_SB(0, 0), b2, voffB);
            PG8_BAR; PG8_WAIT_L(0); PG8_MMA(0, 1, At, B1); PG8_BAR;
            PG8_LDA(At, 0, 1); PG8_STAGE(PG8_SA(0, 0), a2, voffA);
            PG8_BAR; PG8_WAIT_L(0); PG8_MMA(1, 0, At, B0); PG8_BAR; PG8_SCHED;
            PG8_STAGE(PG8_SB(0, 1), b2 + hstep, voffB);
            PG8_WAIT_V(6); PG8_BAR; PG8_MMA(1, 1, At, B1); PG8_BAR;
            PG8_LDB(B0, 1, 0); PG8_SCHED; PG8_LDA(At, 1, 0); PG8_STAGE(PG8_SA(0, 1), a2 + hstep, voffA);
            PG8_WAIT_L(8); PG8_BAR; PG8_WAIT_L(0); PG8_MMA(0, 0, At, B0); PG8_BAR; PG8_SCHED;
            PG8_LDB(B1, 1, 1); PG8_STAGE(PG8_SB(1, 0), b3, voffB);
            PG8_BAR; PG8_WAIT_L(0); PG8_MMA(0, 1, At, B1); PG8_BAR;
            PG8_LDA(At, 1, 1); PG8_STAGE(PG8_SA(1, 0), a3, voffA);
            PG8_BAR; PG8_WAIT_L(0); PG8_MMA(1, 0, At, B0); PG8_BAR; PG8_SCHED;
            PG8_STAGE(PG8_SB(1, 1), b3 + hstep, voffB);
            PG8_WAIT_V(6); PG8_BAR; PG8_MMA(1, 1, At, B1); PG8_BAR;
            }
        }
        if constexpr (ALIGN_EPI) { if (wr == 0) PG8_BAR; }
        if constexpr (!Epi::AFTER_DRAIN) { E(acc, cur, wr, wc, fr, fq); S.done(cur); }
        if (!has_next) break;
#pragma unroll
        for (int a = 0; a < 2; ++a)
#pragma unroll
            for (int b = 0; b < 2; ++b)
#pragma unroll
                for (int m = 0; m < 4; ++m)
#pragma unroll
                    for (int n = 0; n < 2; ++n) acc[a][b][m][n] = (f32x4){0.f, 0.f, 0.f, 0.f};
        cur = nxt; cA = nA; cB = nB; ++ui;
        if constexpr (ALIGN_EPI) { if (wr == 1) PG8_BAR; }
    }
    PG8_WAIT_V(0);
    if constexpr (!ALIGN_EPI) { if (wr == 0) PG8_BAR; }
    PG8_BAR;
    if constexpr (Epi::AFTER_DRAIN) { E.fused(acc, cur, wr, wc, fr, fq, lds, wid, lane); S.done(cur); }
#undef PG8_SA
#undef PG8_SB
#undef PG8_STAGE
#undef PG8_LDA
#undef PG8_LDB
#undef PG8_MMA
#undef PG8_WAIT_V
#undef PG8_WAIT_L
#undef PG8_BAR
#undef PG8_SCHED
}
}
#include <hip/hip_bf16.h>
#include <cmath>
namespace attn_body {
using bf16=__hip_bfloat16;
using bf16x8=__attribute__((ext_vector_type(8)))short;
using s16x4=__attribute__((ext_vector_type(4)))short;
using f32x16=__attribute__((ext_vector_type(16)))float;
using u32x4=__attribute__((ext_vector_type(4)))unsigned;
constexpr int BATCH=8,NHEAD=8,SEQ=2048,D=64,DM=NHEAD*D,OP=1024,CLS_OFF=86016;
constexpr int NW=8,QBLK=32,QB=QBLK*NW,KVBLK=64,NQB=SEQ/QB;
constexpr int ATTN_PITCH=DM, ATTN_UNIT_ROWS=QB;
__device__ __forceinline__ int crow(int r,int hi){return (r&3)+8*(r>>2)+4*hi;}
#define SBAR() __builtin_amdgcn_sched_barrier(0)
__device__ __forceinline__ void cmask(f32x16&p0,f32x16&p1,int jb,int qrel,int hi){
  const float NEG=-INFINITY; int kb=64*jb+4*hi;
  #pragma unroll
  for(int r=0;r<16;++r){int kv=kb+(r&3)+8*(r>>2); if(kv>qrel)p0[r]=NEG; if(kv+32>qrel)p1[r]=NEG;}
}

constexpr int NSLOT=3, SLOTB=8192;
constexpr int LDS_K=0, LDS_V=NSLOT*SLOTB, LDS_WS=2*NSLOT*SLOTB, LDS_OST=LDS_WS+NW*64*4, LDS_BYTES=LDS_OST+NW*4096;
constexpr float C2=0.125f*1.4426950408889634f;
__device__ __forceinline__ void glds16(const void*gsrc,unsigned lds_dst){unsigned keep;
  asm volatile("s_mov_b32 %0, m0\n\ts_mov_b32 m0, %2\n\ts_nop 0\n\tglobal_load_lds_dwordx4 %1, off\n\ts_mov_b32 m0, %0":"=&s"(keep):"v"(gsrc),"s"(lds_dst):"memory");}
__device__ __forceinline__ float max3f(float a,float b,float c){float r;asm("v_max3_f32 %0, %1, %2, %3":"=v"(r):"v"(a),"v"(b),"v"(c));return r;}
__device__ __forceinline__ float max2f(float a,float b){float r;asm("v_max_f32_e32 %0, %1, %2":"=v"(r):"v"(a),"v"(b));return r;}
__device__ __forceinline__ float fadd_s(float a,float b){float r;asm("v_add_f32_e32 %0, %1, %2":"=v"(r):"v"(a),"v"(b));return r;}
__device__ __forceinline__ float fsub_s(float a,float b){float r;asm("v_sub_f32_e32 %0, %1, %2":"=v"(r):"v"(a),"v"(b));return r;}
typedef float f32x4_t __attribute__((ext_vector_type(4))); typedef float f32x2_t __attribute__((ext_vector_type(2))); typedef __bf16 bf16x2_t __attribute__((ext_vector_type(2)));
__device__ __forceinline__ unsigned cvtpk_s(float lo,float hi){f32x2_t v={lo,hi};bf16x2_t b=__builtin_convertvector(v,bf16x2_t);return __builtin_bit_cast(unsigned,b);}
#define WAIT_BAR(N) asm volatile("s_waitcnt vmcnt(" #N ") lgkmcnt(0)\n\ts_barrier":::"memory")

__device__ __forceinline__ void qkt(f32x16&p0,f32x16&p1,const char*Kslot,const bf16x8*qr,int r32,int hi){ const f32x16 negm=f32x16{};
  const char*kb=Kslot+hi*1024+r32*16;
  #pragma unroll
  for(int d0=0;d0<4;++d0){
    const bf16x8 b0=*reinterpret_cast<const bf16x8*>(kb+d0*2048);
    const bf16x8 b1=*reinterpret_cast<const bf16x8*>(kb+d0*2048+512);
    if(d0==0){p0=__builtin_amdgcn_mfma_f32_32x32x16_bf16(b0,qr[0],negm,0,0,0);p1=__builtin_amdgcn_mfma_f32_32x32x16_bf16(b1,qr[0],negm,0,0,0);}
    else{p0=__builtin_amdgcn_mfma_f32_32x32x16_bf16(b0,qr[d0],p0,0,0,0);p1=__builtin_amdgcn_mfma_f32_32x32x16_bf16(b1,qr[d0],p1,0,0,0);}}
}
typedef __attribute__((address_space(3))) const char* lds_cptr;
typedef short v4i16_t __attribute__((ext_vector_type(4)));
__device__ __forceinline__ void kload8(bf16x8*kf,lds_cptr kp){
  kf[0]=*(const __attribute__((address_space(3))) bf16x8*)(kp);      kf[1]=*(const __attribute__((address_space(3))) bf16x8*)(kp+512);
  kf[2]=*(const __attribute__((address_space(3))) bf16x8*)(kp+2048); kf[3]=*(const __attribute__((address_space(3))) bf16x8*)(kp+2560);
  kf[4]=*(const __attribute__((address_space(3))) bf16x8*)(kp+4096); kf[5]=*(const __attribute__((address_space(3))) bf16x8*)(kp+4608);
  kf[6]=*(const __attribute__((address_space(3))) bf16x8*)(kp+6144); kf[7]=*(const __attribute__((address_space(3))) bf16x8*)(kp+6656);
}
__device__ __forceinline__ void kload2(bf16x8*kf,lds_cptr kp,int j){ kf[2*j]=*(const __attribute__((address_space(3))) bf16x8*)(kp+j*2048); kf[2*j+1]=*(const __attribute__((address_space(3))) bf16x8*)(kp+j*2048+512); }
__device__ __forceinline__ s16x4 vtr(lds_cptr p){ return __builtin_bit_cast(s16x4,__builtin_amdgcn_ds_read_tr16_b64_v4i16((__attribute__((address_space(3))) v4i16_t*)p)); }
__device__ __forceinline__ float rowmax(const f32x16&p0,const f32x16&p1){
  float a=max3f(p0[0],p0[1],p1[0]),b=max3f(p0[2],p0[3],p1[1]);a=max3f(a,p1[2],p1[3]);
  #pragma unroll
  for(int r=4;r<16;r+=4){a=max3f(a,p0[r],p0[r+1]);b=max3f(b,p0[r+2],p0[r+3]);a=max3f(a,p1[r],p1[r+1]);b=max3f(b,p1[r+2],p1[r+3]);}
  const float m=max2f(a,b);
  auto rr=__builtin_amdgcn_permlane32_swap(__float_as_uint(m),__float_as_uint(m),false,false);
  return max2f(__uint_as_float(rr[0]),__uint_as_float(rr[1]));
}
__device__ __forceinline__ void pv(f32x16*o,int vb,bf16x8 pa0,bf16x8 pa1,bf16x8 pa2,bf16x8 pa3){
  #pragma unroll
  for(int d0=0;d0<2;++d0){s16x4 lo[4],hi[4];
    #pragma unroll
    for(int ks=0;ks<4;++ks){
      asm volatile("ds_read_b64_tr_b16 %0,%1 offset:%c2":"=&v"(lo[ks]):"v"(vb),"i"(d0*4096+ks*1024):"memory");
      asm volatile("ds_read_b64_tr_b16 %0,%1 offset:%c2":"=&v"(hi[ks]):"v"(vb),"i"(d0*4096+ks*1024+512):"memory");}
    asm volatile("s_waitcnt lgkmcnt(0)":::"memory");SBAR();
    #define PK(k) (bf16x8){lo[k][0],lo[k][1],lo[k][2],lo[k][3],hi[k][0],hi[k][1],hi[k][2],hi[k][3]}
    o[d0]=__builtin_amdgcn_mfma_f32_32x32x16_bf16(pa0,PK(0),o[d0],0,0,0);
    o[d0]=__builtin_amdgcn_mfma_f32_32x32x16_bf16(pa1,PK(1),o[d0],0,0,0);
    o[d0]=__builtin_amdgcn_mfma_f32_32x32x16_bf16(pa2,PK(2),o[d0],0,0,0);
    o[d0]=__builtin_amdgcn_mfma_f32_32x32x16_bf16(pa3,PK(3),o[d0],0,0,0);
    #undef PK
  }
}

#ifndef ATTN_STORE16
#define ATTN_STORE16(p,v) (*(u32x4*)(p)=(v))
#endif
template<int THRL> __device__ __forceinline__ void attn_unit(int b,int h,int qb,const bf16*Q,const bf16*__restrict__ K,const bf16*__restrict__ V,bf16*O,const float*__restrict__ CL,char*shm){
  const int tid=threadIdx.x,lane=tid&63,r32=lane&31,hi=lane>>5; const int wid=__builtin_amdgcn_readfirstlane(tid>>6);
  const long rowbase=(long)b*SEQ; const int q0=qb*QB;
  const bf16*Qw=Q+(rowbase+q0+wid*QBLK)*DM+h*D;
  const bf16*Kh=K+rowbase*DM+h*D,*Vh=V+rowbase*DM+h*D;
  const unsigned lds0=(unsigned)(uintptr_t)shm;
  float*wsf=(float*)(shm+LDS_WS)+wid*64;
  const bf16*ksrc=Kh+(long)lane*DM+wid*8;
  const bf16*vsrc=Vh+(long)(16*(wid&3)+(lane>>2))*DM+(wid>>2)*32+(lane&3)*8;
  const unsigned kdst=lds0+LDS_K+wid*1024, vdst=lds0+LDS_V+wid*1024;
  #define DMA_K(t,slot) glds16(ksrc+(long)(t)*KVBLK*DM,(unsigned)__builtin_amdgcn_readfirstlane(kdst+(slot)))
  #define DMA_V(t,slot) glds16(vsrc+(long)(t)*KVBLK*DM,(unsigned)__builtin_amdgcn_readfirstlane(vdst+(slot)))
  const int vb0=(int)(lds0+LDS_V)+((lane>>4)&1)*32+(lane&3)*8+(4*hi+((lane&15)>>2))*64;
  const char*Kbase=shm+LDS_K; bf16x8 kf[8];
  const lds_cptr shm3=(lds_cptr)shm; const lds_cptr kp0=shm3+LDS_K+hi*1024+r32*16; const lds_cptr vp0=shm3+LDS_V+((lane>>4)&1)*32+(lane&3)*8+(4*hi+((lane&15)>>2))*64;
  const int NT=(q0+QB)/KVBLK;
  __attribute__((address_space(3))) float*cls=(__attribute__((address_space(3))) float*)((__attribute__((address_space(3))) char*)shm+CLS_OFF);
  const float*CLh=CL+(long)(b*NHEAD+h)*SEQ;
  const float clq=CLh[q0+wid*QBLK+r32];
  glds16(CLh+wid*256+lane*4,(unsigned)__builtin_amdgcn_readfirstlane(lds0+CLS_OFF+wid*1024));
  #define BIAS(P0,P1,t) do{ const __attribute__((address_space(3))) float*cb_=cls+64*(t)+4*hi; _Pragma("unroll") for(int g_=0;g_<4;++g_){ \
      const f32x4_t b0_=*(const __attribute__((address_space(3))) f32x4_t*)(cb_+8*g_), b1_=*(const __attribute__((address_space(3))) f32x4_t*)(cb_+32+8*g_); \
      _Pragma("unroll") for(int j_=0;j_<4;++j_){ P0[4*g_+j_]+=(nm-b0_[j_]); P1[4*g_+j_]+=(nm-b1_[j_]); } } }while(0)
  DMA_K(0,0);DMA_V(0,0);DMA_K(1,SLOTB);
  bf16x8 qr[4];
  #pragma unroll
  for(int d0=0;d0<4;++d0)qr[d0]=*reinterpret_cast<const bf16x8*>(&Qw[(long)r32*DM+d0*16+hi*8]);
  float l_reg=0.f;f32x16 o[2];o[0]=f32x16{};o[1]=f32x16{};float nm=clq; const f32x16 zero16=f32x16{};
  const int qrel=wid*QBLK+r32;
  #define CMASK(P0,P1,t) do{int jb_=(t)-(NT-4); if(jb_>=0)cmask(P0,P1,jb_,qrel,hi);}while(0)
  bool resc=false;
  #define START(P0,P1) do{ const float rm=rowmax(P0,P1); resc=false; \
    { const float dl=rm; \
      _Pragma("unroll") for(int r=0;r<16;++r){P0[r]=fsub_s(P0[r],dl);P1[r]=fsub_s(P1[r],dl);} \
      nm=fsub_s(nm,dl); } \
    _Pragma("unroll") for(int r=0;r<16;++r)P0[r]=__builtin_amdgcn_exp2f(P0[r]); }while(0)
  #define RESC() do{ if(resc){ asm volatile("s_waitcnt lgkmcnt(0)":::"memory"); \
      _Pragma("unroll") for(int d_=0;d_<2;++d_) _Pragma("unroll") for(int r=0;r<16;++r)o[d_][r]*=wsf[crow(r,hi)]; } }while(0)
  f32x16 pA0,pA1,pB0,pB1;
  int sl_prev=0,sl_cur=0,sl_next=SLOTB;
  #define ROT() do{sl_prev=sl_cur;sl_cur=sl_next;sl_next=(sl_next==(NSLOT-1)*SLOTB)?0:sl_next+SLOTB;}while(0)
  DMA_K(2,2*SLOTB);
  WAIT_BAR(3);
  qkt(pA0,pA1,Kbase,qr,r32,hi);asm volatile("s_nop 15\n\ts_nop 7":"+v"(pA0),"+v"(pA1));BIAS(pA0,pA1,0);CMASK(pA0,pA1,0);
  START(pA0,pA1);
  _Pragma("unroll") for(int r=0;r<16;++r)pA1[r]=__builtin_amdgcn_exp2f(pA1[r]);
  WAIT_BAR(0);
  DMA_K(3,0);DMA_V(1,SLOTB);
  ROT();
  kload8(kf,kp0+sl_cur);
  WAIT_BAR(2);
  s16x4 vlo[8],vhi[8]; u32x4 pw0,pw1,pw2,pw3;
  #define PKW(P,B) cvtpk_s(P[B],P[B+1])
  #define PAF(k) __builtin_bit_cast(bf16x8,pw##k)
  #define VFR(i) (bf16x8){vlo[i][0],vlo[i][1],vlo[i][2],vlo[i][3],vhi[i][0],vhi[i][1],vhi[i][2],vhi[i][3]}
  #define PIN(x) asm volatile("":"+v"(x))
  #define MX3(a,b,c) __builtin_fmaxf(__builtin_fmaxf((a),(b)),(c))
  #define GAPA(MF,A0,A1,A2,A3,W0,W1,PW) do{ MF; sacc+=A0; sacc+=A1; sacc+=A2; sacc+=A3; PIN(sacc); W0; W1; PIN(PW); SBAR(); }while(0)
  #define EX(v) __builtin_amdgcn_exp2f(v)
  #define GAPB(MF,X,B) do{ MF; X[B]=EX(X[B]); X[B+1]=EX(X[B+1]); X[B+2]=EX(X[B+2]); X[B+3]=EX(X[B+3]); PIN(X); SBAR(); }while(0)
  #define VRD(i) do{ vlo[i]=vtr(vp_+(((i)>>2)*4096+((i)&3)*1024)); vhi[i]=vtr(vp_+(((i)>>2)*4096+((i)&3)*1024+512)); }while(0)
  #define KRD(G,j) do{ if(G){ kload2(kf,kp0+sl_next,j); SBAR(); } }while(0)
  #define STEP(C0,C1,P0,P1,t,GK,GV,GL) do{ SBAR(); \
    const lds_cptr vp_=vp0+sl_prev; \
    VRD(0); SBAR(); float sacc=(P0[0]+P0[1]); \
    GAPA(C0=__builtin_amdgcn_mfma_f32_32x32x16_bf16(kf[0],qr[0],zero16,0,0,0), P0[2],P0[3],P0[4],P0[5],     pw0[0]=PKW(P0,0), pw0[1]=PKW(P0,2), pw0); \
    VRD(4); SBAR(); GAPA(C1=__builtin_amdgcn_mfma_f32_32x32x16_bf16(kf[1],qr[0],zero16,0,0,0), P0[6],P0[7],P0[8],P0[9],     pw0[2]=PKW(P0,4), pw0[3]=PKW(P0,6), pw0); \
    VRD(1); SBAR(); GAPA(C0=__builtin_amdgcn_mfma_f32_32x32x16_bf16(kf[2],qr[1],C0,0,0,0),   P0[10],P0[11],P0[12],P0[13], pw1[0]=PKW(P0,8), pw1[1]=PKW(P0,10), pw1); \
    VRD(5); SBAR(); GAPA(C1=__builtin_amdgcn_mfma_f32_32x32x16_bf16(kf[3],qr[1],C1,0,0,0),   P0[14],P0[15],P1[0],P1[1],   pw1[2]=PKW(P0,12),pw1[3]=PKW(P0,14), pw1); \
    VRD(2); SBAR(); GAPA(C0=__builtin_amdgcn_mfma_f32_32x32x16_bf16(kf[4],qr[2],C0,0,0,0),   P1[2],P1[3],P1[4],P1[5],     pw2[0]=PKW(P1,0), pw2[1]=PKW(P1,2), pw2); \
    VRD(6); SBAR(); GAPA(C1=__builtin_amdgcn_mfma_f32_32x32x16_bf16(kf[5],qr[2],C1,0,0,0),   P1[6],P1[7],P1[8],P1[9],     pw2[2]=PKW(P1,4), pw2[3]=PKW(P1,6), pw2); \
    VRD(3); SBAR(); GAPA(C0=__builtin_amdgcn_mfma_f32_32x32x16_bf16(kf[6],qr[3],C0,0,0,0),   P1[10],P1[11],P1[12],P1[13], pw3[0]=PKW(P1,8), pw3[1]=PKW(P1,10), pw3); \
    VRD(7); SBAR(); GAPA(C1=__builtin_amdgcn_mfma_f32_32x32x16_bf16(kf[7],qr[3],C1,0,0,0),   P1[14],P1[15],0.f,0.f,       pw3[2]=PKW(P1,12),pw3[3]=PKW(P1,14), pw3); \
    l_reg+=sacc; \
    if(GK){DMA_K((t)+3,sl_cur);} if(GV){DMA_V((t)+1,sl_next);} \
    BIAS(C0,C1,t); CMASK(C0,C1,t); \
    { float a=MX3(C0[0],C0[1],C1[0]),b=MX3(C0[2],C0[3],C1[1]); a=MX3(a,C1[2],C1[3]); \
      _Pragma("unroll") for(int r=4;r<16;r+=4){a=MX3(a,C0[r],C0[r+1]);b=MX3(b,C0[r+2],C0[r+3]);a=MX3(a,C1[r],C1[r+1]);b=MX3(b,C1[r+2],C1[r+3]);} \
      float rm=__builtin_fmaxf(a,b); { auto rr=__builtin_amdgcn_permlane32_swap(__float_as_uint(rm),__float_as_uint(rm),false,false); rm=__builtin_fmaxf(__uint_as_float(rr[0]),__uint_as_float(rr[1])); } \
      resc=false; \
      if(__builtin_expect(__any(rm>(float)THRL),0)){ const float dl=__builtin_fmaxf(rm,0.f); \
        _Pragma("unroll") for(int r=0;r<16;++r){C0[r]-=dl;C1[r]-=dl;} \
        nm-=dl; \
        const float f=__builtin_amdgcn_exp2f(-dl); l_reg*=f; if(hi==0)wsf[r32]=f; resc=true; } } \
    SBAR(); \
    GAPB(o[0]=__builtin_amdgcn_mfma_f32_32x32x16_bf16(PAF(0),VFR(0),o[0],0,0,0), C0,0); \
    GAPB(o[1]=__builtin_amdgcn_mfma_f32_32x32x16_bf16(PAF(0),VFR(4),o[1],0,0,0), C0,4); \
    KRD(GL,0); GAPB(o[0]=__builtin_amdgcn_mfma_f32_32x32x16_bf16(PAF(1),VFR(1),o[0],0,0,0), C0,8); \
    KRD(GL,1); GAPB(o[1]=__builtin_amdgcn_mfma_f32_32x32x16_bf16(PAF(1),VFR(5),o[1],0,0,0), C0,12); \
    KRD(GL,2); GAPB(o[0]=__builtin_amdgcn_mfma_f32_32x32x16_bf16(PAF(2),VFR(2),o[0],0,0,0), C1,0); \
    KRD(GL,3); GAPB(o[1]=__builtin_amdgcn_mfma_f32_32x32x16_bf16(PAF(2),VFR(6),o[1],0,0,0), C1,4); \
    GAPB(o[0]=__builtin_amdgcn_mfma_f32_32x32x16_bf16(PAF(3),VFR(3),o[0],0,0,0), C1,8); \
    GAPB(o[1]=__builtin_amdgcn_mfma_f32_32x32x16_bf16(PAF(3),VFR(7),o[1],0,0,0), C1,12); \
    }while(0)
  int t=1;
  #undef CMASK
  #define CMASK(P0,P1,t) do{}while(0)
  for(;t+5<NT;t+=2){
    STEP(pB0,pB1,pA0,pA1,t,true,true,true);     WAIT_BAR(2); RESC(); ROT();
    STEP(pA0,pA1,pB0,pB1,t+1,true,true,true);   WAIT_BAR(2); RESC(); ROT();
  }
  #undef CMASK
  #define CMASK(P0,P1,t) do{int jb_=(t)-(NT-4); if(jb_>=0)cmask(P0,P1,jb_,qrel,hi);}while(0)
  #define ENDW(tt) do{ if((tt)+3<NT){WAIT_BAR(2);} else if((tt)+2<NT){WAIT_BAR(1);} else {WAIT_BAR(0);} }while(0)
  for(;t+1<NT;t+=2){
    STEP(pB0,pB1,pA0,pA1,t,(t+3<NT),(t+1<NT),(t+1<NT));       ENDW(t);   RESC(); ROT();
    STEP(pA0,pA1,pB0,pB1,t+1,(t+4<NT),(t+2<NT),(t+2<NT));     ENDW(t+1); RESC(); ROT();
  }
  STEP(pB0,pB1,pA0,pA1,NT-1,false,false,false); RESC();
  { float sacc=pB0[0]+pB0[1]; _Pragma("unroll") for(int r=2;r<16;++r)sacc+=pB0[r]; _Pragma("unroll") for(int r=0;r<16;++r)sacc+=pB1[r]; l_reg+=sacc;
    pw0=(u32x4){PKW(pB0,0),PKW(pB0,2),PKW(pB0,4),PKW(pB0,6)};pw1=(u32x4){PKW(pB0,8),PKW(pB0,10),PKW(pB0,12),PKW(pB0,14)};pw2=(u32x4){PKW(pB1,0),PKW(pB1,2),PKW(pB1,4),PKW(pB1,6)};pw3=(u32x4){PKW(pB1,8),PKW(pB1,10),PKW(pB1,12),PKW(pB1,14)};
    SBAR(); pv(o,vb0+sl_cur,PAF(0),PAF(1),PAF(2),PAF(3)); }
  #undef PKW
  #undef PAF
  #undef VFR
  #undef PIN
  #undef MX3
  #undef GAPA
  #undef GAPB
  #undef EX
  #undef VRD
  #undef KRD
  #undef STEP
  #undef ENDW
  {auto rr=__builtin_amdgcn_permlane32_swap(__float_as_uint(l_reg),__float_as_uint(l_reg),false,false);l_reg=__uint_as_float(rr[0])+__uint_as_float(rr[1]);}
  if(hi==0)wsf[32+r32]=l_reg;asm volatile("s_waitcnt lgkmcnt(0)":::"memory");
  float rli[16];
  #pragma unroll
  for(int r=0;r<16;++r)rli[r]=__builtin_amdgcn_rcpf(wsf[32+crow(r,hi)]);
  bf16*Ow=O+(rowbase+q0+wid*QBLK)*OP+h*D;
  { bf16*stg=(bf16*)(shm+LDS_OST)+wid*2048;
    #pragma unroll
    for(int r=0;r<16;++r){const int orow=crow(r,hi);
      #pragma unroll
      for(int d0=0;d0<2;++d0)stg[orow*64+d0*32+r32]=__float2bfloat16(o[d0][r]*rli[r]);}
    asm volatile("s_waitcnt lgkmcnt(0)":::"memory");
    #pragma unroll
    for(int i=0;i<4;++i){const int row=i*8+(lane>>3),ch=lane&7; const u32x4 v=*(const u32x4*)(stg+row*64+ch*8); ATTN_STORE16(Ow+(long)row*OP+ch*8,v);} }
  asm volatile("s_waitcnt lgkmcnt(0)\n\ts_barrier":::"memory");
  #undef BIAS
  #undef DMA_K
  #undef DMA_V
  #undef CMASK
  #undef START
  #undef RESC
  #undef ROT
}
constexpr int ATTN_LDS_BYTES=LDS_BYTES;
struct AttnTensors { const bf16* Q; const bf16* K; const bf16* V; bf16* O; const float* CL; };
struct AttnUnit { int bh; int qb; };
struct StaticOrder {
  int vcu;
  __device__ __forceinline__ explicit StaticOrder(int grid,int block):vcu((block%8)*(grid/8)+block/8){}
  __device__ __forceinline__ bool next(int i,AttnUnit&u)const{ if(i>=2)return false; const int s=vcu&3; u.bh=vcu>>2; u.qb=(i==0)?7-s:s; return true; }
  __device__ __forceinline__ void a_ready(const AttnUnit&)const{}
  __device__ __forceinline__ void done(const AttnUnit&)const{}
};
template<class Sched,int THRL=8> __device__ __forceinline__ void attn_phase(char*lds,const AttnTensors&T,const Sched&S){
  AttnUnit u;
  for(int i=0;S.next(i,u);++i){ S.a_ready(u); attn_unit<THRL>(u.bh/NHEAD,u.bh%NHEAD,u.qb,T.Q,T.K,T.V,T.O,T.CL,lds); S.done(u); }
}
#undef SBAR
#undef WAIT_BAR
}

#define LAS __attribute__((address_space(3)))
typedef unsigned short bf16;
typedef unsigned v4u __attribute__((ext_vector_type(4)));
typedef unsigned v2u __attribute__((ext_vector_type(2)));
typedef float f32x4 __attribute__((ext_vector_type(4)));
constexpr int NWAVES = 8, NTHR = 512;
constexpr int BATCH = 8, SEQ = 2048, M = BATCH * SEQ, D = 1024, AW = 512, NH = 8, HD = 64, SW = 512, NG = 32, GS = 16, NP = 64, DFF = 2816, NUP = 2 * DFF, INC = 2056;
constexpr float EPS = 1e-6f;
constexpr size_t MiB = 1u << 20;
constexpr size_t WS_WIN = 1 * MiB, WS_WGLU = 5 * MiB, WS_WOUT = 6 * MiB, WS_WUP = 8 * MiB, WS_WDN = 19 * MiB;
constexpr size_t WS_TAB = 25 * MiB;
constexpr size_t TB_LOGF = 0, TB_CUM = 512 * 1024, TB_LB = 1024 * 1024, TB_BB = TB_LB + 16384, TB_BBP = 1536 * 1024, TB_CP = 1792 * 1024;
constexpr size_t WS_SS = 28 * MiB;
constexpr size_t WS_XB = 32 * MiB;
constexpr size_t WS_Q = 64 * MiB, WS_K = 80 * MiB, WS_V = 96 * MiB, WS_U = 112 * MiB, WS_YG = 128 * MiB, WS_MIX = 144 * MiB;
constexpr size_t WS_ACT = 152 * MiB, WS_HALO = 240 * MiB, WS_END = 248 * MiB;
constexpr size_t TB_SSQ2 = 2048 * 1024, TB_RSTD1 = 1408 * 1024;
constexpr int LDS_BYTES = 147456, RING_BYTES = 131072;

__device__ __forceinline__ float bf2f(unsigned v) { return __uint_as_float(v << 16); }
__device__ __forceinline__ unsigned f2bf(float f) { unsigned u = __float_as_uint(f); return (u + 0x7fffu + ((u >> 16) & 1u)) >> 16; }
__device__ __forceinline__ unsigned pk2(float lo, float hi) { return f2bf(lo) | (f2bf(hi) << 16); }
__device__ __forceinline__ float wave_sum(float v) {
#pragma unroll
    for (int o = 1; o < 64; o <<= 1) v += __shfl_xor(v, o);
    return v;
}
__device__ __forceinline__ void unpack8(const v4u w, float* f) {
    f[0] = bf2f(w.x & 0xffffu); f[1] = bf2f(w.x >> 16); f[2] = bf2f(w.y & 0xffffu); f[3] = bf2f(w.y >> 16);
    f[4] = bf2f(w.z & 0xffffu); f[5] = bf2f(w.z >> 16); f[6] = bf2f(w.w & 0xffffu); f[7] = bf2f(w.w >> 16);
}
__device__ __forceinline__ v4u pack8(const float* f) { v4u w; w.x = pk2(f[0], f[1]); w.y = pk2(f[2], f[3]); w.z = pk2(f[4], f[5]); w.w = pk2(f[6], f[7]); return w; }

namespace pg8 {
struct EpiPlain {
    static constexpr bool PERM = true, AFTER_DRAIN = false;
    bf16_t* O; int ldc; int split_cols; size_t split_stride;
    __device__ __forceinline__ void operator()(const f32x4 (&acc)[2][2][4][2], const Unit& u, int wr, int wc, int fr, int fq) const {
        const int row0 = u.pm * BM + wr * 64 + fr; int colt = u.pn * BM; bf16_t* base = O;
        if (split_cols) { const int t = colt / split_cols; base += (size_t)t * split_stride; colt -= t * split_cols; }
        const int col0 = colt + wc * 32 + 8 * fq;
#pragma unroll
        for (int ai = 0; ai < 2; ++ai)
#pragma unroll
            for (int m = 0; m < 4; ++m) { bf16_t* rowp = base + (size_t)(row0 + ai * HALF + m * 16) * ldc + col0;
#pragma unroll
                for (int bj = 0; bj < 2; ++bj) { const f32x4 v0 = acc[ai][bj][m][0], v1 = acc[ai][bj][m][1];
                    u32x4 w; w.x = cvt_pk_bf16(v0[0], v0[1]); w.y = cvt_pk_bf16(v0[2], v0[3]); w.z = cvt_pk_bf16(v1[0], v1[1]); w.w = cvt_pk_bf16(v1[2], v1[3]);
                    *(u32x4*)(rowp + bj * HALF) = w; } }
    }
};
struct EpiGlu {
    static constexpr bool PERM = true, AFTER_DRAIN = false;
    const bf16_t* YG; const float* bias; bf16_t* O; int ldo; int ocol0;
    __device__ __forceinline__ void operator()(const f32x4 (&acc)[2][2][4][2], const Unit& u, int wr, int wc, int fr, int fq) const {
        const int row0 = u.pm * BM + wr * 64 + fr; const int col0 = u.pn * BM + wc * 32 + 8 * fq;
#pragma unroll
        for (int ai = 0; ai < 2; ++ai)
#pragma unroll
            for (int m = 0; m < 4; ++m) { const int row = row0 + ai * HALF + m * 16;
#pragma unroll
                for (int bj = 0; bj < 2; ++bj) { const int col = col0 + bj * HALF;
                    const f32x4 b0 = *(const f32x4*)(bias + col), b1 = *(const f32x4*)(bias + col + 4);
                    const f32x4 v0 = acc[ai][bj][m][0] + b0, v1 = acc[ai][bj][m][1] + b1;
                    const u32x4 yw = *(const u32x4*)(YG + (size_t)row * 512 + col);
                    float y[8]; y[0] = __uint_as_float(yw.x << 16); y[1] = __uint_as_float(yw.x & 0xffff0000u); y[2] = __uint_as_float(yw.y << 16); y[3] = __uint_as_float(yw.y & 0xffff0000u);
                    y[4] = __uint_as_float(yw.z << 16); y[5] = __uint_as_float(yw.z & 0xffff0000u); y[6] = __uint_as_float(yw.w << 16); y[7] = __uint_as_float(yw.w & 0xffff0000u);
                    float o[8];
#pragma unroll
                    for (int i = 0; i < 4; ++i) { o[i] = y[i] / (1.f + __expf(-v0[i])); o[4 + i] = y[4 + i] / (1.f + __expf(-v1[i])); }
                    u32x4 w; w.x = cvt_pk_bf16(o[0], o[1]); w.y = cvt_pk_bf16(o[2], o[3]); w.z = cvt_pk_bf16(o[4], o[5]); w.w = cvt_pk_bf16(o[6], o[7]);
                    *(u32x4*)(O + (size_t)row * ldo + ocol0 + col) = w; } }
    }
};
struct EpiRes {
    static constexpr bool PERM = true, AFTER_DRAIN = false;
    const float* base; float* out; int ldc;
    __device__ __forceinline__ void operator()(const f32x4 (&acc)[2][2][4][2], const Unit& u, int wr, int wc, int fr, int fq) const {
        const int row0 = u.pm * BM + wr * 64 + fr; const int col0 = u.pn * BM + wc * 32 + 8 * fq;
#pragma unroll
        for (int ai = 0; ai < 2; ++ai)
#pragma unroll
            for (int m = 0; m < 4; ++m) { const size_t off = (size_t)(row0 + ai * HALF + m * 16) * ldc + col0;
#pragma unroll
                for (int bj = 0; bj < 2; ++bj) {
                    const f32x4 x0 = *(const f32x4*)(base + off + bj * HALF), x1 = *(const f32x4*)(base + off + bj * HALF + 4);
                    *(f32x4*)(out + off + bj * HALF) = x0 + acc[ai][bj][m][0]; *(f32x4*)(out + off + bj * HALF + 4) = x1 + acc[ai][bj][m][1]; } }
    }
};

struct EpiResB {
    static constexpr bool PERM = true, AFTER_DRAIN = false;
    const bf16_t* XB; float* out; int ldc;
    __device__ __forceinline__ void operator()(const f32x4 (&acc)[2][2][4][2], const Unit& u, int wr, int wc, int fr, int fq) const {
        const int row0 = u.pm * BM + wr * 64 + fr; const int col0 = u.pn * BM + wc * 32 + 8 * fq;
        u32x4 wres[2][4][2];
#pragma unroll
        for (int ai = 0; ai < 2; ++ai)
#pragma unroll
            for (int m = 0; m < 4; ++m)
#pragma unroll
                for (int bj = 0; bj < 2; ++bj) wres[ai][m][bj] = *(const u32x4*)(XB + (size_t)(row0 + ai * HALF + m * 16) * ldc + col0 + bj * HALF);
#pragma unroll
        for (int ai = 0; ai < 2; ++ai)
#pragma unroll
            for (int m = 0; m < 4; ++m) { const size_t off = (size_t)(row0 + ai * HALF + m * 16) * ldc + col0;
#pragma unroll
                for (int bj = 0; bj < 2; ++bj) { const u32x4 w = wres[ai][m][bj];
                    const f32x4 x0 = (f32x4){__uint_as_float(w.x << 16), __uint_as_float(w.x & 0xffff0000u), __uint_as_float(w.y << 16), __uint_as_float(w.y & 0xffff0000u)};
                    const f32x4 x1 = (f32x4){__uint_as_float(w.z << 16), __uint_as_float(w.z & 0xffff0000u), __uint_as_float(w.w << 16), __uint_as_float(w.w & 0xffff0000u)};
                    *(f32x4*)(out + off + bj * HALF) = x0 + acc[ai][bj][m][0]; *(f32x4*)(out + off + bj * HALF + 4) = x1 + acc[ai][bj][m][1]; } }
    }
};
struct EpiX1 {
    static constexpr bool PERM = true, AFTER_DRAIN = false;
    const float* base; float* out; bf16_t* XB; float* SSQ; int ldc;
    __device__ __forceinline__ void operator()(const f32x4 (&acc)[2][2][4][2], const Unit& u, int wr, int wc, int fr, int fq) const {
        const int row0 = u.pm * BM + wr * 64 + fr; const int col0 = u.pn * BM + wc * 32 + 8 * fq;
        u32x4 xres[2][4][2];
#pragma unroll
        for (int ai = 0; ai < 2; ++ai)
#pragma unroll
            for (int m = 0; m < 4; ++m)
#pragma unroll
                for (int bj = 0; bj < 2; ++bj) xres[ai][m][bj] = *(const u32x4*)(XB + (size_t)(row0 + ai * HALF + m * 16) * ldc + col0 + bj * HALF);
#pragma unroll
        for (int ai = 0; ai < 2; ++ai)
#pragma unroll
            for (int m = 0; m < 4; ++m) { const int row = row0 + ai * HALF + m * 16; const size_t off = (size_t)row * ldc + col0; float q = 0.f;
#pragma unroll
                for (int bj = 0; bj < 2; ++bj) { const u32x4 xw = xres[ai][m][bj];
                    const f32x4 x0 = (f32x4){__uint_as_float(xw.x << 16), __uint_as_float(xw.x & 0xffff0000u), __uint_as_float(xw.y << 16), __uint_as_float(xw.y & 0xffff0000u)} + acc[ai][bj][m][0];
                    const f32x4 x1 = (f32x4){__uint_as_float(xw.z << 16), __uint_as_float(xw.z & 0xffff0000u), __uint_as_float(xw.w << 16), __uint_as_float(xw.w & 0xffff0000u)} + acc[ai][bj][m][1];
                    q += (x0[0] * x0[0] + x0[1] * x0[1]) + (x0[2] * x0[2] + x0[3] * x0[3]) + (x1[0] * x1[0] + x1[1] * x1[1]) + (x1[2] * x1[2] + x1[3] * x1[3]);
                    u32x4 w; w.x = cvt_pk_bf16(x0[0], x0[1]); w.y = cvt_pk_bf16(x0[2], x0[3]); w.z = cvt_pk_bf16(x1[0], x1[1]); w.w = cvt_pk_bf16(x1[2], x1[3]);
                    *(u32x4*)(XB + off + bj * HALF) = w; }
                q += __shfl_xor(q, 16); q += __shfl_xor(q, 32);
                if (fq == 0) SSQ[(size_t)row * 16 + u.pn * 4 + wc] = q; }
    }
};
__device__ __forceinline__ float row_up1(float prev, float cur) { float t; asm volatile("s_nop 1\n\tv_mov_b32_dpp %0, %1 row_ror:1 row_mask:0xf bank_mask:0xf\n\tv_mov_b32_dpp %0, %2 row_shr:1 row_mask:0xf bank_mask:0xf" : "=&v"(t) : "v"(prev), "v"(cur)); return t; }
__device__ __forceinline__ float row_up2(float prev, float cur) { float t; asm volatile("s_nop 1\n\tv_mov_b32_dpp %0, %1 row_ror:2 row_mask:0xf bank_mask:0xf\n\tv_mov_b32_dpp %0, %2 row_shr:2 row_mask:0xf bank_mask:0xf" : "=&v"(t) : "v"(prev), "v"(cur)); return t; }

struct EpiIn {
    static constexpr bool PERM = true, AFTER_DRAIN = false;
    const float* rstd1; const float* gq; const float* gk; bf16_t* O; size_t stride; float c2;
    __device__ __forceinline__ void operator()(const f32x4 (&acc)[2][2][4][2], const Unit& u, int wr, int wc, int fr, int fq) const {
        const int row0 = u.pm * BM + wr * 64 + fr; const int t = u.pn >> 1; bf16_t* base = O + (size_t)t * stride + ((u.pn & 1) * 4 + wc) * 64 + 8 * fq;
        f32x4 gv[2][2];
        if (t < 2) { const float* gp = t ? gk : gq; const float sc = t ? 1.f : c2;
#pragma unroll
            for (int bj = 0; bj < 2; ++bj)
#pragma unroll
                for (int n = 0; n < 2; ++n) gv[bj][n] = *(const f32x4*)(gp + 32 * bj + 8 * fq + 4 * n) * sc; }
        float rsA[2][4];
#pragma unroll
        for (int ai = 0; ai < 2; ++ai)
#pragma unroll
            for (int m = 0; m < 4; ++m) rsA[ai][m] = rstd1[row0 + ai * HALF + m * 16];
#pragma unroll
        for (int ai = 0; ai < 2; ++ai)
#pragma unroll
            for (int m = 0; m < 4; ++m) { const int row = row0 + ai * HALF + m * 16; float rs = rsA[ai][m];
                f32x4 v[2][2];
#pragma unroll
                for (int bj = 0; bj < 2; ++bj)
#pragma unroll
                    for (int n = 0; n < 2; ++n) v[bj][n] = acc[ai][bj][m][n] * rs;
                if (t < 2) { float q = 0.f;
#pragma unroll
                    for (int bj = 0; bj < 2; ++bj)
#pragma unroll
                        for (int n = 0; n < 2; ++n) q += (v[bj][n][0] * v[bj][n][0] + v[bj][n][1] * v[bj][n][1]) + (v[bj][n][2] * v[bj][n][2] + v[bj][n][3] * v[bj][n][3]);
                    q += __shfl_xor(q, 16); q += __shfl_xor(q, 32);
                    const float hr = __builtin_amdgcn_rsqf(q * (1.f / 64.f) + 1e-6f);
#pragma unroll
                    for (int bj = 0; bj < 2; ++bj)
#pragma unroll
                        for (int n = 0; n < 2; ++n) v[bj][n] = v[bj][n] * gv[bj][n] * hr; }
#pragma unroll
                for (int bj = 0; bj < 2; ++bj) { u32x4 w; w.x = cvt_pk_bf16(v[bj][0][0], v[bj][0][1]); w.y = cvt_pk_bf16(v[bj][0][2], v[bj][0][3]); w.z = cvt_pk_bf16(v[bj][1][0], v[bj][1][1]); w.w = cvt_pk_bf16(v[bj][1][2], v[bj][1][3]);
                    *(u32x4*)(base + (size_t)row * 512 + 32 * bj) = w; } }
    }
};
struct EpiUpConv {
    static constexpr bool PERM = true, AFTER_DRAIN = false;
    const float* SSQ; const float* cw; const float* cb; bf16_t* ACT; float* HALO; __attribute__((address_space(3))) float* XCH;
    __device__ __forceinline__ void operator()(f32x4 (&acc)[2][2][4][2], const Unit& u, int wr, int wc, int fr, int fq) const {
        const int row0 = u.pm * BM + wr * 64 + fr; const int tcol = wc * 32 + 8 * fq;
        const int ac0 = u.pn * HALF + tcol;
        f32x4 prm[2][8];
#define LOAD_PRM(n) do { prm[n][0] = *(const f32x4*)(cb + ac0 + 4 * (n)); prm[n][1] = *(const f32x4*)(cb + 2816 + ac0 + 4 * (n)); \
            _Pragma("unroll") for (int j = 0; j < 3; ++j) { prm[n][2 + 2 * j] = *(const f32x4*)(cw + j * 5632 + ac0 + 4 * (n)); prm[n][3 + 2 * j] = *(const f32x4*)(cw + j * 5632 + 2816 + ac0 + 4 * (n)); } } while (0)
        LOAD_PRM(0);
#pragma unroll
        for (int ai = 0; ai < 2; ++ai)
#pragma unroll
            for (int m = 0; m < 4; ++m) { const f32x4 a0 = *(const f32x4*)(SSQ + (size_t)(row0 + ai * HALF + m * 16) * 16 + 4 * fq);
                float tot = (a0[0] + a0[1]) + (a0[2] + a0[3]); tot += __shfl_xor(tot, 16); tot += __shfl_xor(tot, 32);
                const float rstd = __builtin_amdgcn_rsqf(tot * (1.f / 1024.f) + 1e-6f);
#pragma unroll
                for (int bj = 0; bj < 2; ++bj) { acc[ai][bj][m][0] *= rstd; acc[ai][bj][m][1] *= rstd; }
                __builtin_amdgcn_sched_barrier(0); }
        if (fr >= 14) {
#pragma unroll
            for (int ai = 0; ai < 2; ++ai)
#pragma unroll
                for (int bj = 0; bj < 2; ++bj)
#pragma unroll
                    for (int n = 0; n < 2; ++n) { XCH[((ai * 2 + wr) * 2 + (fr - 14)) * 256 + bj * HALF + tcol + 4 * n + 0] = acc[ai][bj][3][n][0]; XCH[((ai * 2 + wr) * 2 + (fr - 14)) * 256 + bj * HALF + tcol + 4 * n + 1] = acc[ai][bj][3][n][1];
                        XCH[((ai * 2 + wr) * 2 + (fr - 14)) * 256 + bj * HALF + tcol + 4 * n + 2] = acc[ai][bj][3][n][2]; XCH[((ai * 2 + wr) * 2 + (fr - 14)) * 256 + bj * HALF + tcol + 4 * n + 3] = acc[ai][bj][3][n][3]; }
            if (wr == 1) {
#pragma unroll
                for (int bj = 0; bj < 2; ++bj)
#pragma unroll
                    for (int n = 0; n < 2; ++n) *(f32x4*)(HALO + ((size_t)u.pm * 4 + (fr - 14)) * 5632 + u.pn * BM + bj * HALF + tcol + 4 * n) = acc[1][bj][3][n];
            }
        }
        if (fr < 2 && wr == 0) {
#pragma unroll
            for (int bj = 0; bj < 2; ++bj)
#pragma unroll
                for (int n = 0; n < 2; ++n) *(f32x4*)(HALO + ((size_t)u.pm * 4 + 2 + fr) * 5632 + u.pn * BM + bj * HALF + tcol + 4 * n) = acc[0][bj][0][n];
        }
        asm volatile("s_waitcnt lgkmcnt(0)" ::: "memory"); __builtin_amdgcn_s_barrier(); asm volatile("" ::: "memory");
        LOAD_PRM(1);
#undef LOAD_PRM
#pragma unroll
        for (int n = 0; n < 2; ++n) {
            const f32x4 cbg = prm[n][0], cbv = prm[n][1], w0g = prm[n][2], w0v = prm[n][3], w1g = prm[n][4], w1v = prm[n][5], w2g = prm[n][6], w2v = prm[n][7];
#pragma unroll
            for (int ai = 0; ai < 2; ++ai)
#pragma unroll
                for (int m = 3; m >= 0; --m) {
                    f32x4 pg, pv;
                    if (m > 0) { pg = acc[ai][0][m - 1][n]; pv = acc[ai][1][m - 1][n]; }
                    else { const int blk = (wr == 1) ? ai * 2 : 1; const bool have = (wr == 1) || (ai == 1);
                        pg = (f32x4){0.f, 0.f, 0.f, 0.f}; pv = pg;
                        if (have && fr >= 14) { pg = *(const __attribute__((address_space(3))) f32x4*)(XCH + (blk * 2 + (fr - 14)) * 256 + tcol + 4 * n); pv = *(const __attribute__((address_space(3))) f32x4*)(XCH + (blk * 2 + (fr - 14)) * 256 + HALF + tcol + 4 * n); } }
                    const f32x4 cg = acc[ai][0][m][n], cv = acc[ai][1][m][n]; f32x4 o;
#pragma unroll
                    for (int i = 0; i < 4; ++i) {
                        const float g1 = row_up1(pg[i], cg[i]), g2 = row_up2(pg[i], cg[i]), v1 = row_up1(pv[i], cv[i]), v2 = row_up2(pv[i], cv[i]);
                        const float hg = cbg[i] + w0g[i] * g2 + w1g[i] * g1 + w2g[i] * cg[i], hv = cbv[i] + w0v[i] * v2 + w1v[i] * v1 + w2v[i] * cv[i];
                        float oi = hg * __builtin_amdgcn_rcpf(1.f + __expf(-hg)) * hv; asm volatile("" : "+v"(oi)); o[i] = oi; }
                    acc[ai][0][m][n] = o; __builtin_amdgcn_sched_barrier(0); }
        }
#pragma unroll
        for (int ai = 0; ai < 2; ++ai)
#pragma unroll
            for (int m = 0; m < 4; ++m) { const f32x4 v0 = acc[ai][0][m][0], v1 = acc[ai][0][m][1];
                u32x4 w; w.x = cvt_pk_bf16(v0[0], v0[1]); w.y = cvt_pk_bf16(v0[2], v0[3]); w.z = cvt_pk_bf16(v1[0], v1[1]); w.w = cvt_pk_bf16(v1[2], v1[3]);
                *(u32x4*)(ACT + (size_t)(row0 + ai * HALF + m * 16) * 2816 + ac0) = w; }
    }
};
}

struct Args { const float* in[24]; float* out; unsigned char* ws; int ph_lo, ph_hi; };

__device__ __forceinline__ float log_sigmoid(float z) { return fminf(z, 0.f) - log1pf(expf(-fabsf(z))); }
typedef short s16x8p __attribute__((ext_vector_type(8)));
constexpr int WF_LO_OFF = 32768;
__device__ __forceinline__ void p0_prologue(const Args& a, LAS unsigned char* lds, int vcu, int gw, int NGW, int tid, int wave, int lane) {
    unsigned char* ws = a.ws;
    {
        const float* x = a.in[0]; const float* gm = a.in[1]; const float* win = a.in[2]; const float* bfv = a.in[3];
        float* logf = (float*)(ws + WS_TAB + TB_LOGF); float* rstd1 = (float*)(ws + WS_TAB + TB_RSTD1); bf16* XB = (bf16*)(ws + WS_XB);
        for (int i = tid; i < 32768; i += NTHR) ((LAS unsigned*)lds)[i >> 1 << 1 | (i & 1)] = 0u;
        __syncthreads();
        for (int k = tid; k < D; k += NTHR) { const float g = gm[k]; const f32x4 w0 = *(const f32x4*)(win + (size_t)k * INC + 1536), w1 = *(const f32x4*)(win + (size_t)k * INC + 1540);
            const float w[8] = {w0[0] * g, w0[1] * g, w0[2] * g, w0[3] * g, w1[0] * g, w1[1] * g, w1[2] * g, w1[3] * g};
            const int ks = k >> 5, q = (k >> 3) & 3, i = k & 7;
#pragma unroll
            for (int h = 0; h < 8; ++h) { const unsigned hb = f2bf(w[h]); const float lo = w[h] - bf2f(hb); const int off = ((ks * 4 + q) * 16 + h) * 16 + i * 2;
                *(LAS bf16*)(lds + off) = (bf16)hb; *(LAS bf16*)(lds + WF_LO_OFF + off) = (bf16)f2bf(lo); } }
        __syncthreads();
        const int m = lane & 15, q = lane >> 4, half = wave & 1;
        LAS float* XR = (LAS float*)(lds + 65536);
        for (int blk = vcu * 4 + (wave >> 1); blk < M / 16; blk += (NGW / 8) * 4) {
            const size_t row = (size_t)blk * 16 + m; const float* xr = x + row * D + 512 * half + 8 * q;
            f32x4 acc = (f32x4){0.f, 0.f, 0.f, 0.f}; float ssq = 0.f;
#pragma unroll
            for (int ks = 0; ks < 16; ++ks) {
                const f32x4 x0 = __builtin_nontemporal_load((const f32x4*)(xr + 32 * ks)), x1 = __builtin_nontemporal_load((const f32x4*)(xr + 32 * ks + 4));
                const float xv[8] = {x0[0], x0[1], x0[2], x0[3], x1[0], x1[1], x1[2], x1[3]};
                unsigned hb[8]; float lo[8];
#pragma unroll
                for (int i = 0; i < 8; ++i) { hb[i] = f2bf(xv[i]); lo[i] = xv[i] - bf2f(hb[i]); ssq += xv[i] * xv[i]; }
                v4u hw; hw.x = hb[0] | (hb[1] << 16); hw.y = hb[2] | (hb[3] << 16); hw.z = hb[4] | (hb[5] << 16); hw.w = hb[6] | (hb[7] << 16);
                const v4u lw = pack8(lo);
                *(v4u*)(XB + row * D + 512 * half + 32 * ks + 8 * q) = hw;
                const int kst = 16 * half + ks;
                const s16x8p bh = *(const LAS s16x8p*)(lds + ((kst * 4 + q) * 16 + m) * 16), bl = *(const LAS s16x8p*)(lds + WF_LO_OFF + ((kst * 4 + q) * 16 + m) * 16);
                const s16x8p ah = __builtin_bit_cast(s16x8p, hw), al = __builtin_bit_cast(s16x8p, lw);
                acc = __builtin_amdgcn_mfma_f32_16x16x32_bf16(ah, bh, acc, 0, 0, 0);
                acc = __builtin_amdgcn_mfma_f32_16x16x32_bf16(ah, bl, acc, 0, 0, 0);
                acc = __builtin_amdgcn_mfma_f32_16x16x32_bf16(al, bh, acc, 0, 0, 0);
            }
            ssq += __shfl_xor(ssq, 16); ssq += __shfl_xor(ssq, 32);
            __syncthreads();
            if (half) { LAS float* p = XR + ((wave >> 1) * 64 + lane) * 5; p[0] = acc[0]; p[1] = acc[1]; p[2] = acc[2]; p[3] = acc[3]; p[4] = ssq; }
            __syncthreads();
            if (!half) { const LAS float* p = XR + ((wave >> 1) * 64 + lane) * 5; acc[0] += p[0]; acc[1] += p[1]; acc[2] += p[2]; acc[3] += p[3]; ssq += p[4];
                const float rstd = 1.f / sqrtf(ssq * (1.f / D) + EPS);
                if (q == 0) rstd1[row] = rstd;
#pragma unroll
                for (int j = 0; j < 4; ++j) { const float rt = __shfl(rstd, 4 * q + j); if (m < 8) logf[((size_t)blk * 16 + 4 * q + j) * 8 + m] = log_sigmoid(acc[j] * rt + bfv[m]); } }
        }
        __syncthreads();
    }
    {
        constexpr int I_IN = 32 * 32, I_GLU = 8 * 16, I_OUT = 16 * 32, I_UP = 88 * 32, I_DN = 16 * 88, NITEMS = I_IN + I_GLU + I_OUT + I_UP + I_DN;
        struct WItem { const float* src; const float* g; bf16* dst; int ldn; int frag; };
        auto decode = [&](int it, WItem& w) {
            int r = it;
            if (r < I_IN) { const int nb = r / 32, kb = r % 32, dn = 64 * nb + lane, tl = dn >> 8, c = dn & 255;
                int sn = tl * 256 + 64 * ((c >> 5) & 3) + 32 * (c >> 7) + (c & 31); if (sn >= 1536) sn += 8;
                w.src = a.in[2] + (size_t)(32 * kb) * INC + sn; w.ldn = INC; w.g = a.in[1] + 32 * kb; w.dst = (bf16*)(ws + WS_WIN) + (size_t)dn * D + 32 * kb; w.frag = 0; return; } r -= I_IN;
            if (r < I_GLU) { const int nb = r / 16, kb = r % 16, dn = 64 * nb + lane;
                w.src = a.in[14] + (size_t)(32 * kb) * SW + dn; w.ldn = SW; w.g = nullptr; w.dst = (bf16*)(ws + WS_WGLU) + ((size_t)(kb * 32 + (dn >> 4)) * 64 + (dn & 15)) * 8; w.frag = 1; return; } r -= I_GLU;
            if (r < I_OUT) { const int nb = r / 32, kb = r % 32, dn = 64 * nb + lane, k0 = 32 * kb;
                w.src = a.in[18] + (size_t)k0 * D + dn; w.ldn = D; w.g = (k0 < AW) ? a.in[16] + k0 : a.in[17] + (k0 - AW); w.dst = (bf16*)(ws + WS_WOUT) + (size_t)dn * D + k0; w.frag = 0; return; } r -= I_OUT;
            if (r < I_UP) { const int nb = r / 32, kb = r % 32, dn = 64 * nb + lane, tl = dn >> 8, cc = dn & 255, sn = cc < 128 ? 128 * tl + cc : DFF + 128 * tl + cc - 128;
                w.src = a.in[20] + (size_t)(32 * kb) * NUP + sn; w.ldn = NUP; w.g = a.in[19] + 32 * kb; w.dst = (bf16*)(ws + WS_WUP) + (size_t)dn * D + 32 * kb; w.frag = 0; return; } r -= I_UP;
            { const int nb = r / 88, kb = r % 88, dn = 64 * nb + lane;
                w.src = a.in[23] + (size_t)(32 * kb) * D + dn; w.ldn = D; w.g = nullptr; w.dst = (bf16*)(ws + WS_WDN) + (size_t)dn * DFF + 32 * kb; w.frag = 0; }
        };
        for (int it = gw; it < NITEMS; it += 2 * NGW) {
            const bool two = it + NGW < NITEMS;
            WItem w0, w1; decode(it, w0); decode(two ? it + NGW : it, w1);
            float v0[32], v1[32];
#pragma unroll
            for (int i = 0; i < 32; ++i) v0[i] = __builtin_nontemporal_load(w0.src + (size_t)i * w0.ldn);
            if (two) {
#pragma unroll
                for (int i = 0; i < 32; ++i) v1[i] = __builtin_nontemporal_load(w1.src + (size_t)i * w1.ldn); }
            if (w0.g) {
#pragma unroll
                for (int i = 0; i < 32; ++i) v0[i] *= w0.g[i]; }
            if (two && w1.g) {
#pragma unroll
                for (int i = 0; i < 32; ++i) v1[i] *= w1.g[i]; }
#pragma unroll
            for (int j = 0; j < 4; ++j) *(v4u*)(w0.dst + (w0.frag ? j * 128 : 8 * j)) = pack8(v0 + 8 * j);
            if (two) {
#pragma unroll
                for (int j = 0; j < 4; ++j) *(v4u*)(w1.dst + (w1.frag ? j * 128 : 8 * j)) = pack8(v1 + 8 * j); }
        }
    }
    {
        const float* lre = a.in[6]; const float* lim = a.in[7]; const float* lst = a.in[8]; const float* bre = a.in[9]; const float* bim = a.in[10]; const float* cre = a.in[11]; const float* cim = a.in[12];
        float* LB = (float*)(ws + WS_TAB + TB_LB); bf16* BBP = (bf16*)(ws + WS_TAB + TB_BBP); unsigned* CP = (unsigned*)(ws + WS_TAB + TB_CP);
        for (int j = gw * 64 + lane; j < NG * NP * GS; j += NGW * 64) {
            const int i = j >> 4, h = j & 15, g = i / NP, p = i % NP, n = p & 31, slot = p >> 5;
            const float lr = lre[i], li = lim[i], lsv = lst[g], br = bre[j], bi = bim[j], cr = cre[(size_t)(g * GS + h) * NP + p], ci = cim[(size_t)(g * GS + h) * NP + p];
            const float step = expf(lsv), er = expf(lr * step), ar = er * cosf(li * step), ai = er * sinf(li * step);
            const float nr = ar - 1.f, ni = ai, den = lr * lr + li * li;
            const float fr = (nr * lr + ni * li) / den, fi = (ni * lr - nr * li) / den;
            if (h == 0) { LB[2 * i] = ar; LB[2 * i + 1] = ai; }
            BBP[((size_t)(g * 4 + slot) * 32 + n) * 16 + h] = (bf16)f2bf(fr * br - fi * bi); BBP[((size_t)(g * 4 + 2 + slot) * 32 + n) * 16 + h] = (bf16)f2bf(fr * bi + fi * br);
            CP[(size_t)(g * GS + h) * 64 + p] = pk2(cr, -ci);
        }
    }
}

__device__ __forceinline__ void cumsum_bh(const Args& a, int bh, int lane) {
    const float* logf = (const float*)(a.ws + WS_TAB + TB_LOGF); float* cum = (float*)(a.ws + WS_TAB + TB_CUM);
    const int b = bh / NH, h = bh % NH; float loc[32]; float t = 0.f;
#pragma unroll
    for (int i = 0; i < 32; ++i) { t += logf[((size_t)b * SEQ + 32 * lane + i) * 8 + h]; loc[i] = t; }
    float incl = t;
#pragma unroll
    for (int o = 1; o < 64; o <<= 1) { const float nn = __shfl_up(incl, o); if (lane >= o) incl += nn; }
    const float excl = incl - t;
#pragma unroll
    for (int i = 0; i < 32; ++i) cum[(size_t)bh * SEQ + 32 * lane + i] = (loc[i] + excl) * 1.4426950408889634f;
}

__device__ __forceinline__ float gelu_tanh(float x) { const float u = 0.7978845608028654f * (x + 0.044715f * x * x * x); const float e = __expf(2.f * u); return x * (1.f - __builtin_amdgcn_rcpf(e + 1.f)); }
typedef short s16x8 __attribute__((ext_vector_type(8)));
typedef float v2f __attribute__((ext_vector_type(2)));
typedef float f32x16v __attribute__((ext_vector_type(16)));
#define CFMA(xr, xi, lr, li, br, bi) do { const float nr_ = fmaf(lr, xr, fmaf(-(li), xi, br)), ni_ = fmaf(lr, xi, fmaf(li, xr, bi)); xr = nr_; xi = ni_; } while (0)
#define CSQR(r, i) do { const float nr_ = r * r - i * i, ni_ = 2.f * r * i; r = nr_; i = ni_; } while (0)
__device__ __forceinline__ void ssm_a_unit(const Args& a, int unit, int wave, int lane) {
    unsigned char* ws = a.ws;
    const int b = unit >> 5, c = unit & 31; const size_t t0 = (size_t)b * SEQ + 64 * c;
    const int n = lane & 31, hi = lane >> 5, sig = 16 * ((n >> 2) & 1) + 4 * (n >> 3) + (n & 3);
    const bf16* U = (const bf16*)(ws + WS_U); const float* LB = (const float*)(ws + WS_TAB + TB_LB); const bf16* BBP = (const bf16*)(ws + WS_TAB + TB_BBP); float* SS = (float*)(ws + WS_SS);
    const f32x16v zero = f32x16v{};
#pragma unroll 1
    for (int gi = 0; gi < 4; ++gi) {
        const int g = wave * 4 + gi;
        float lr[2], li[2], l16r[2], l16i[2];
#pragma unroll
        for (int sl = 0; sl < 2; ++sl) { lr[sl] = LB[2 * (g * NP + n + 32 * sl)]; li[sl] = LB[2 * (g * NP + n + 32 * sl) + 1]; l16r[sl] = lr[sl]; l16i[sl] = li[sl];
#pragma unroll
            for (int q = 0; q < 4; ++q) CSQR(l16r[sl], l16i[sl]); }
        s16x8 bfr[4];
#pragma unroll
        for (int nb = 0; nb < 4; ++nb) bfr[nb] = *(const s16x8*)(BBP + ((size_t)(g * 4 + nb) * 32 + n) * 16 + 8 * hi);
        float tr[2] = {0.f, 0.f}, ti[2] = {0.f, 0.f};
#pragma unroll
        for (int sb = 0; sb < 2; ++sb) {
            const s16x8 afr = *(const s16x8*)(U + (t0 + 32 * sb + sig) * SW + 16 * g + 8 * hi);
            f32x16v d[4];
#pragma unroll
            for (int nb = 0; nb < 4; ++nb) d[nb] = __builtin_amdgcn_mfma_f32_32x32x16_bf16(afr, bfr[nb], zero, 0, 0, 0);
#pragma unroll
            for (int sl = 0; sl < 2; ++sl) { float sr = 0.f, si = 0.f;
#pragma unroll
                for (int r = 0; r < 16; ++r) CFMA(sr, si, lr[sl], li[sl], d[sl][r], d[2 + sl][r]);
                if (sb == 0) { float qr = l16r[sl], qi = l16i[sl]; CSQR(qr, qi); tr[sl] = qr * sr - qi * si; ti[sl] = qr * si + qi * sr; }
                else { tr[sl] += sr; ti[sl] += si; } }
        }
#pragma unroll
        for (int sl = 0; sl < 2; ++sl) {
            float vr = tr[sl], vi = ti[sl];
            if (hi == 0) { const float nr = l16r[sl] * vr - l16i[sl] * vi, ni = l16r[sl] * vi + l16i[sl] * vr; vr = nr; vi = ni; }
            vr += __shfl_xor(vr, 32); vi += __shfl_xor(vi, 32);
            if (hi == 0) { float* o = SS + ((((size_t)b * 32 + c) * NG + g) * NP + n + 32 * sl) * 2; o[0] = vr; o[1] = vi; }
        }
    }
}
constexpr int XT_PITCH = 68, XT_BYTES = 32 * XT_PITCH * 4, YT_OFF = 8 * XT_BYTES, YT_PITCH = 1040, RED_OFF = YT_OFF + 64 * YT_PITCH;
static_assert(RED_OFF + 2048 <= LDS_BYTES, "ssm LDS");
__device__ __forceinline__ void ssm_b_unit(const Args& a, LAS unsigned char* lds, int unit, int wave, int lane) {
    unsigned char* ws = a.ws;
    const int b = unit >> 5, c = unit & 31; const size_t t0 = (size_t)b * SEQ + 64 * c;
    const int n = lane & 31, hi = lane >> 5, fr = lane & 15, fq = lane >> 4, sig = 16 * ((n >> 2) & 1) + 4 * (n >> 3) + (n & 3);
    const bf16* U = (const bf16*)(ws + WS_U); const float* LB = (const float*)(ws + WS_TAB + TB_LB); const bf16* BBP = (const bf16*)(ws + WS_TAB + TB_BBP);
    const bf16* CP = (const bf16*)(ws + WS_TAB + TB_CP); const float* SS = (const float*)(ws + WS_SS); const float* dsk = a.in[13];
    LAS unsigned* XT = (LAS unsigned*)(lds + wave * XT_BYTES);
    LAS unsigned char* YT = lds + YT_OFF; LAS float* RED = (LAS float*)(lds + RED_OFF);
    const f32x16v zero = f32x16v{};
    float xcrA[4][2], xciA[4][2];
    {
        float l128r[4][2], l128i[4][2], wr_[4][2], wi_[4][2];
#pragma unroll
        for (int gi = 0; gi < 4; ++gi)
#pragma unroll
            for (int sl = 0; sl < 2; ++sl) { const int g = wave * 4 + gi; const v2f lb = *(const v2f*)(LB + 2 * (g * NP + n + 32 * sl));
                float r = lb.x, i = lb.y;
#pragma unroll
                for (int q = 0; q < 4; ++q) CSQR(r, i);
                CSQR(r, i); CSQR(r, i);
                wr_[gi][sl] = hi ? r : 1.f; wi_[gi][sl] = hi ? i : 0.f; CSQR(r, i); l128r[gi][sl] = r; l128i[gi][sl] = i; xcrA[gi][sl] = 0.f; xciA[gi][sl] = 0.f; }
        const float* sp0 = SS + ((((size_t)b * 32) * NG + wave * 4) * NP + n) * 2;
#pragma unroll 2
        for (int k = hi; k < c; k += 2) {
#pragma unroll
            for (int gi = 0; gi < 4; ++gi)
#pragma unroll
                for (int sl = 0; sl < 2; ++sl) { const v2f sv = *(const v2f*)(sp0 + (size_t)(c - 1 - k) * NG * NP * 2 + (gi * NP + 32 * sl) * 2);
                    xcrA[gi][sl] += wr_[gi][sl] * sv.x - wi_[gi][sl] * sv.y; xciA[gi][sl] += wr_[gi][sl] * sv.y + wi_[gi][sl] * sv.x;
                    const float nwr = wr_[gi][sl] * l128r[gi][sl] - wi_[gi][sl] * l128i[gi][sl], nwi = wr_[gi][sl] * l128i[gi][sl] + wi_[gi][sl] * l128r[gi][sl]; wr_[gi][sl] = nwr; wi_[gi][sl] = nwi; } }
#pragma unroll
        for (int gi = 0; gi < 4; ++gi)
#pragma unroll
            for (int sl = 0; sl < 2; ++sl) { xcrA[gi][sl] += __shfl_xor(xcrA[gi][sl], 32); xciA[gi][sl] += __shfl_xor(xciA[gi][sl], 32); }
    }
#pragma unroll 1
    for (int gp = 0; gp < 2; ++gp)
#pragma unroll
    for (int gi2 = 0; gi2 < 2; ++gi2) {
        const int gi = 2 * gp + gi2, g = wave * 4 + gi;
        float lr[2], li[2], l16r[2], l16i[2], xcr[2], xci[2];
#pragma unroll
        for (int sl = 0; sl < 2; ++sl) { const v2f lb = *(const v2f*)(LB + 2 * (g * NP + n + 32 * sl)); lr[sl] = lb.x; li[sl] = lb.y; l16r[sl] = lb.x; l16i[sl] = lb.y;
#pragma unroll
            for (int q = 0; q < 4; ++q) CSQR(l16r[sl], l16i[sl]);
            xcr[sl] = gp ? xcrA[2 + gi2][sl] : xcrA[gi2][sl]; xci[sl] = gp ? xciA[2 + gi2][sl] : xciA[gi2][sl]; }
        s16x8 bfr[4], cfr[4];
#pragma unroll
        for (int nb = 0; nb < 4; ++nb) bfr[nb] = *(const s16x8*)(BBP + ((size_t)(g * 4 + nb) * 32 + n) * 16 + 8 * hi);
#pragma unroll
        for (int kk = 0; kk < 4; ++kk) cfr[kk] = *(const s16x8*)(CP + (size_t)(g * GS + fr) * 128 + 32 * kk + 8 * fq);
        const f32x4 dk = *(const f32x4*)(dsk + g * GS + 4 * fq);
#pragma unroll
        for (int sb = 0; sb < 2; ++sb) {
            const s16x8 afr = *(const s16x8*)(U + (t0 + 32 * sb + sig) * SW + 16 * g + 8 * hi);
            f32x16v d[4];
#pragma unroll
            for (int nb = 0; nb < 4; ++nb) d[nb] = __builtin_amdgcn_mfma_f32_32x32x16_bf16(afr, bfr[nb], zero, 0, 0, 0);
#pragma unroll
            for (int sl = 0; sl < 2; ++sl) {
                float sr = 0.f, si = 0.f;
#pragma unroll
                for (int r = 0; r < 16; ++r) CFMA(sr, si, lr[sl], li[sl], d[sl][r], d[2 + sl][r]);
                const float orr = __shfl_xor(sr, 32), oii = __shfl_xor(si, 32);
                const float ser = hi ? orr : sr, sei = hi ? oii : si, sor = hi ? sr : orr, soi = hi ? si : oii;
                float xnr = xcr[sl], xni = xci[sl]; CFMA(xnr, xni, l16r[sl], l16i[sl], ser, sei);
                float xr = hi ? xnr : xcr[sl], xi = hi ? xni : xci[sl];
                float x2r = xnr, x2i = xni; CFMA(x2r, x2i, l16r[sl], l16i[sl], sor, soi); xcr[sl] = x2r; xci[sl] = x2i;
#pragma unroll
                for (int r = 0; r < 16; ++r) { CFMA(xr, xi, lr[sl], li[sl], d[sl][r], d[2 + sl][r]); XT[(16 * hi + r) * XT_PITCH + n + 32 * sl] = pg8::cvt_pk_bf16(xr, xi); }
            }
#pragma unroll
            for (int mb = 0; mb < 2; ++mb) {
                f32x4 acc = (f32x4){0.f, 0.f, 0.f, 0.f};
#pragma unroll
                for (int kk = 0; kk < 4; ++kk) { const s16x8 xf = *(const LAS s16x8*)(XT + (16 * mb + fr) * XT_PITCH + 16 * kk + 4 * fq); acc = __builtin_amdgcn_mfma_f32_16x16x32_bf16(cfr[kk], xf, acc, 0, 0, 0); }
                const int s = 32 * sb + 16 * mb + fr;
                const v2u uw = *(const v2u*)(U + (t0 + s) * SW + 16 * g + 4 * fq);
                const float y0 = gelu_tanh(acc[0] + dk[0] * bf2f(uw.x & 0xffffu)), y1 = gelu_tanh(acc[1] + dk[1] * bf2f(uw.x >> 16)), y2 = gelu_tanh(acc[2] + dk[2] * bf2f(uw.y & 0xffffu)), y3 = gelu_tanh(acc[3] + dk[3] * bf2f(uw.y >> 16));
                v2u yw; yw.x = pg8::cvt_pk_bf16(y0, y1); yw.y = pg8::cvt_pk_bf16(y2, y3);
                *(LAS v2u*)(YT + s * YT_PITCH + (16 * g + 4 * fq) * 2) = yw;
            }
        }
    }
    __syncthreads();
    const bf16* WG = (const bf16*)(ws + WS_WGLU); const float* bg = a.in[15]; bf16* MIX = (bf16*)(ws + WS_MIX);
    f32x4 acc[4][4];
#pragma unroll
    for (int mb = 0; mb < 4; ++mb)
#pragma unroll
        for (int nb = 0; nb < 4; ++nb) acc[mb][nb] = (f32x4){0.f, 0.f, 0.f, 0.f};
    s16x8 wq[4][4];
    const bf16* wpf = WG + ((size_t)(4 * wave) * 64 + lane) * 8;
#pragma unroll
    for (int st = 0; st < 3; ++st) {
#pragma unroll
        for (int nb = 0; nb < 4; ++nb) wq[st][nb] = *(const s16x8*)(wpf + nb * 512);
        wpf += 32 * 512; }
#pragma unroll 1
    for (int kk4 = 0; kk4 < 16; kk4 += 4) {
        asm volatile("" : "+v"(wpf));
#pragma unroll
        for (int j = 0; j < 4; ++j) {
            const int kk = kk4 + j;
            s16x8 wf[4], yf[4];
#pragma unroll
            for (int nb = 0; nb < 4; ++nb) wf[nb] = wq[j][nb];
            if (kk + 3 < 16) {
#pragma unroll
                for (int nb = 0; nb < 4; ++nb) wq[(j + 3) & 3][nb] = *(const s16x8*)(wpf + nb * 512);
                wpf += 32 * 512; }
#pragma unroll
            for (int mb = 0; mb < 4; ++mb) yf[mb] = *(const LAS s16x8*)(YT + (16 * mb + fr) * YT_PITCH + (32 * kk + 8 * fq) * 2);
#pragma unroll
            for (int mb = 0; mb < 4; ++mb)
#pragma unroll
                for (int nb = 0; nb < 4; ++nb) acc[mb][nb] = __builtin_amdgcn_mfma_f32_16x16x32_bf16(wf[nb], yf[mb], acc[mb][nb], 0, 0, 0);
        }
    }
#pragma unroll
    for (int mb = 0; mb < 4; ++mb) { float q = 0.f;
#pragma unroll
        for (int nb = 0; nb < 4; ++nb) { const int n0 = 64 * wave + 16 * nb + 4 * fq; const f32x4 bv = *(const f32x4*)(bg + n0);
            const v2u yw = *(const LAS v2u*)(YT + (16 * mb + fr) * YT_PITCH + n0 * 2);
            const float y[4] = {bf2f(yw.x & 0xffffu), bf2f(yw.x >> 16), bf2f(yw.y & 0xffffu), bf2f(yw.y >> 16)};
#pragma unroll
            for (int j = 0; j < 4; ++j) { const float o = y[j] * __builtin_amdgcn_rcpf(1.f + __expf(-(acc[mb][nb][j] + bv[j]))); acc[mb][nb][j] = o; q += o * o; } }
        q += __shfl_xor(q, 16); q += __shfl_xor(q, 32);
        if (fq == 0) RED[wave * 64 + 16 * mb + fr] = q; }
    __syncthreads();
#pragma unroll
    for (int mb = 0; mb < 4; ++mb) { const int s = 16 * mb + fr; float tot = 0.f;
#pragma unroll
        for (int w = 0; w < 8; ++w) tot += RED[w * 64 + s];
        const float rstd = 1.f / sqrtf(tot * (1.f / SW) + EPS);
#pragma unroll
        for (int nb = 0; nb < 4; ++nb) { v2u ow; ow.x = pg8::cvt_pk_bf16(acc[mb][nb][0] * rstd, acc[mb][nb][1] * rstd); ow.y = pg8::cvt_pk_bf16(acc[mb][nb][2] * rstd, acc[mb][nb][3] * rstd);
            *(v2u*)(MIX + (t0 + s) * D + AW + 64 * wave + 16 * nb + 4 * fq) = ow; } }
    { v4u w[8];
#pragma unroll
      for (int r = 0; r < 8; ++r) w[r] = *(const v4u*)(MIX + (t0 + wave * 8 + r) * D + 8 * lane);
#pragma unroll
      for (int r = 0; r < 8; ++r) { float f[8]; unpack8(w[r], f); float q = 0.f;
#pragma unroll
          for (int i = 0; i < 8; ++i) q += f[i] * f[i];
          const float rstd = 1.f / sqrtf(wave_sum(q) * (1.f / AW) + EPS);
#pragma unroll
          for (int i = 0; i < 8; ++i) f[i] *= rstd;
          *(v4u*)(MIX + (t0 + wave * 8 + r) * D + 8 * lane) = pack8(f); } }
    __syncthreads();
}

__device__ __forceinline__ void p_fixup(const Args& a, int pm, int tid) {
    const float* HALO = (const float*)(a.ws + WS_HALO); bf16* ACT = (bf16*)(a.ws + WS_ACT); const float* cw = a.in[21]; const float* cb = a.in[22];
    if ((pm & 7) == 0) return;
    const float* hp = HALO + (size_t)(pm - 1) * 4 * 5632; const float* hc = HALO + (size_t)pm * 4 * 5632;
    v2u res[3];
#pragma unroll
    for (int k = 0; k < 3; ++k) {
        const int it = tid + k * NTHR, itc = it < 2 * (DFF / 4) ? it : 0, r = itc / (DFF / 4), ac = (itc % (DFF / 4)) * 4, cg = (ac >> 7) * 256 + (ac & 127), cv = cg + 128;
        const f32x4 g0 = *(const f32x4*)((r ? hp + 5632 : hp) + cg), g1 = *(const f32x4*)((r ? hc + 2 * 5632 : hp + 5632) + cg), g2 = *(const f32x4*)((r ? hc + 3 * 5632 : hc + 2 * 5632) + cg);
        const f32x4 v0 = *(const f32x4*)((r ? hp + 5632 : hp) + cv), v1 = *(const f32x4*)((r ? hc + 2 * 5632 : hp + 5632) + cv), v2 = *(const f32x4*)((r ? hc + 3 * 5632 : hc + 2 * 5632) + cv);
        const f32x4 hg = *(const f32x4*)(cb + ac) + *(const f32x4*)(cw + ac) * g0 + *(const f32x4*)(cw + NUP + ac) * g1 + *(const f32x4*)(cw + 2 * NUP + ac) * g2;
        const f32x4 hv = *(const f32x4*)(cb + DFF + ac) + *(const f32x4*)(cw + DFF + ac) * v0 + *(const f32x4*)(cw + NUP + DFF + ac) * v1 + *(const f32x4*)(cw + 2 * NUP + DFF + ac) * v2;
        float o[4];
#pragma unroll
        for (int i = 0; i < 4; ++i) o[i] = hg[i] * __builtin_amdgcn_rcpf(1.f + __expf(-hg[i])) * hv[i];
        res[k].x = pk2(o[0], o[1]); res[k].y = pk2(o[2], o[3]);
    }
#pragma unroll
    for (int k = 0; k < 3; ++k) { const int it = tid + k * NTHR; if (it < 2 * (DFF / 4)) { const int r = it / (DFF / 4), ac = (it % (DFF / 4)) * 4; *(v2u*)(ACT + (size_t)(pm * 256 + r) * DFF + ac) = res[k]; } }
}

#define XB_TMO      128
#define XB_XCNT(j)  (256  + 64 * (j))
#define XB_XSUB(j)  (1280 + 64 * (j))
#define XB_XGEN(j)  (2304 + 64 * (j))
#define XB_TOP      3328
#define XB_TOPGEN   3392
#define XCD_BAR_WORDS 3456
#define XB_SPIN_CAP (1u << 18)

__device__ __forceinline__ unsigned xb_ld(unsigned* p)              { return __hip_atomic_load(p, __ATOMIC_RELAXED, __HIP_MEMORY_SCOPE_AGENT); }
__device__ __forceinline__ unsigned xb_add(unsigned* p, unsigned v) { return __hip_atomic_fetch_add(p, v, __ATOMIC_RELAXED, __HIP_MEMORY_SCOPE_AGENT); }
__device__ __forceinline__ unsigned xb_xcc_id() { return (unsigned)__builtin_amdgcn_s_getreg((3 << 11) | 20) & 0xFu; }
#define XB_SPIN(cond, bar) do { unsigned _sp = 0; while (cond) { __builtin_amdgcn_s_sleep(1); \
    if ((++_sp & 255u) == 0u) { if (xb_ld(&(bar)[XB_TMO])) break; if (_sp > XB_SPIN_CAP) { atomicAdd(&(bar)[XB_TMO], 1u); break; } } } } while (0)

struct XcdBarrier {
    unsigned* bar; unsigned x;
    volatile LAS unsigned* st;
};

__device__ __forceinline__ XcdBarrier xcd_barrier_post(unsigned* bar, volatile LAS unsigned* st) {
    XcdBarrier b; b.bar = bar; b.x = xb_xcc_id(); b.st = st;
    if (threadIdx.x == 0) (void)xb_add(&bar[XB_XCNT(b.x)], 1u);
    return b;
}
__device__ __forceinline__ void xcd_barrier_complete(unsigned* bar, unsigned x, unsigned& nloc, unsigned& nx) {
    const unsigned G = gridDim.x * gridDim.y * gridDim.z;
    unsigned sum, cnt, mine, sp = 0u;
    for (;;) {
        sum = 0u; cnt = 0u; mine = 0u;
#pragma unroll
        for (unsigned j = 0; j < 16; ++j) { const unsigned c = xb_ld(&bar[XB_XCNT(j)]); sum += c; cnt += (c > 0u) ? 1u : 0u; mine = (j == x) ? c : mine; }
        if (sum == G) break;
        __builtin_amdgcn_s_sleep(1);
        if ((++sp & 255u) == 0u) { if (xb_ld(&bar[XB_TMO])) break; if (sp > XB_SPIN_CAP) { atomicAdd(&bar[XB_TMO], 1u); break; } }
    }
    nloc = mine > 0u ? mine : 1u; nx = cnt > 0u ? cnt : 1u;
}

__device__ __forceinline__ void xcd_barrier(const XcdBarrier& b) {
    asm volatile("s_waitcnt vmcnt(0)" ::: "memory");
    __syncthreads();
    if (threadIdx.x == 0) {
        unsigned* bar = b.bar;
        __builtin_amdgcn_s_waitcnt(0);
        unsigned nloc = b.st[0], nx = b.st[1];
        if (nloc == 0u) { xcd_barrier_complete(bar, b.x, nloc, nx); b.st[0] = nloc; b.st[1] = nx; }
        const unsigned old = xb_add(&bar[XB_XSUB(b.x)], 1u);
        const unsigned gen = old / nloc;
        if (old + 1u == (gen + 1u) * nloc) {
            __builtin_amdgcn_fence(__ATOMIC_RELEASE, "agent");
            asm volatile("s_waitcnt vmcnt(0)" ::: "memory");
            const unsigned og = xb_add(&bar[XB_TOP], 1u);
            const unsigned tg = og / nx;
            if (og + 1u == (tg + 1u) * nx) xb_add(&bar[XB_TOPGEN], 1u);
            else XB_SPIN(xb_ld(&bar[XB_TOPGEN]) == tg, bar);
            __builtin_amdgcn_fence(__ATOMIC_ACQUIRE, "agent");
            xb_add(&bar[XB_XGEN(b.x)], 1u);
            asm volatile("s_waitcnt vmcnt(0)" ::: "memory");
        } else {
            XB_SPIN(xb_ld(&bar[XB_XGEN(b.x)]) == gen, bar);
            __builtin_amdgcn_fence(__ATOMIC_ACQUIRE, "agent");
            asm volatile("s_waitcnt vmcnt(0)" ::: "memory");
        }
    }
    __syncthreads();
}

__global__ void __launch_bounds__(NTHR, 2) fwd_kernel(Args args) {
    extern __shared__ __attribute__((aligned(16))) unsigned char lds_raw[];
    LAS unsigned char* lds = (LAS unsigned char*)lds_raw;
    cg::grid_group grid = cg::this_grid();
    int tid = threadIdx.x, lane = tid & 63; const int wave = __builtin_amdgcn_readfirstlane(tid >> 6);
    const int G = gridDim.x, bx = blockIdx.x, vcu = (G % 8 == 0) ? (bx % 8) * (G / 8) + bx / 8 : bx;
    const int gw = vcu * NWAVES + wave, NGW = G * NWAVES, NT = G * NTHR; int gtid = vcu * NTHR + tid;
    unsigned char* ws = args.ws;
    const int lo = args.ph_lo, hi = args.ph_hi;
    volatile LAS unsigned* MISC = (volatile LAS unsigned*)(lds + LDS_BYTES - 128);
    if (tid < 32) MISC[tid] = 0u;
    __syncthreads();
    XcdBarrier bar; bar.bar = (unsigned*)ws + 4096; bar.x = 0; bar.st = nullptr;
    if (hi - lo > 1) {
        if (bx == 0) for (int i = tid; i < XCD_BAR_WORDS; i += NTHR) ((unsigned*)ws)[4096 + i] = 0u;
        grid.sync();
        bar = xcd_barrier_post((unsigned*)ws + 4096, MISC + 8); }
#define IN(k) (lo <= (k) && (k) < hi)
#define REFRESH() do { int t_ = threadIdx.x; asm volatile("" : "+v"(t_)); tid = t_; lane = tid & 63; gtid = vcu * NTHR + tid; } while (0)
#define SYNC(k) do { if (IN(k) && IN((k) + 1)) xcd_barrier(bar); REFRESH(); } while (0)
    if (IN(0)) { p0_prologue(args, lds, vcu, gw, NGW, tid, wave, lane); } SYNC(0);
    if (IN(1)) {
        if (bx < BATCH * NH && wave == 0) cumsum_bh(args, bx, lane);
        pg8::Gemm g{(const pg8::bf16_t*)(ws + WS_XB), (const pg8::bf16_t*)(ws + WS_WIN), M, 2048, D}; pg8::StaticOrder S; S.init(M, 2048, G, bx);
        pg8::EpiIn E{(const float*)(ws + WS_TAB + TB_RSTD1), args.in[4], args.in[5], (pg8::bf16_t*)(ws + WS_Q), (size_t)M * AW, attn_body::C2};
        pg8::gemm_phase<pg8::EpiIn, pg8::StaticOrder, true, true>(lds, g, S, E);
    } SYNC(1);
    if (IN(2)) {
        { const attn_body::AttnTensors AT{(const attn_body::bf16*)(ws + WS_Q), (const attn_body::bf16*)(ws + WS_K), (const attn_body::bf16*)(ws + WS_V), (attn_body::bf16*)(ws + WS_MIX), (const float*)(ws + WS_TAB + TB_CUM)};
          const attn_body::StaticOrder AS(G, bx); attn_body::attn_phase<attn_body::StaticOrder, 64>((char*)lds_raw, AT, AS); }
        for (int u = bx; u < BATCH * 32; u += G) ssm_a_unit(args, u, wave, lane);
    } SYNC(2);
    if (IN(3)) {
        for (int u = bx; u < BATCH * 32; u += G) ssm_b_unit(args, lds, u, wave, lane);
    } SYNC(3);
    if (IN(4)) {
        pg8::Gemm g{(const pg8::bf16_t*)(ws + WS_MIX), (const pg8::bf16_t*)(ws + WS_WOUT), M, D, D}; pg8::StaticOrder S; S.init(M, D, G, bx);
        pg8::EpiX1 E{args.in[0], args.out, (pg8::bf16_t*)(ws + WS_XB), (float*)(ws + WS_TAB + TB_SSQ2), D};
        pg8::gemm_phase<pg8::EpiX1, pg8::StaticOrder, true, true>(lds, g, S, E);
    } SYNC(4);
    if (IN(5)) {
        pg8::Gemm g{(const pg8::bf16_t*)(ws + WS_XB), (const pg8::bf16_t*)(ws + WS_WUP), M, NUP, D}; pg8::StaticOrder S; S.init(M, NUP, G, bx);
        pg8::EpiUpConv E{(const float*)(ws + WS_TAB + TB_SSQ2), args.in[21], args.in[22], (pg8::bf16_t*)(ws + WS_ACT), (float*)(ws + WS_HALO), (LAS float*)(lds + RING_BYTES)};
        pg8::gemm_phase<pg8::EpiUpConv, pg8::StaticOrder, true, true>(lds, g, S, E);
    } SYNC(5);
    if (IN(6)) {
        pg8::Gemm g{(const pg8::bf16_t*)(ws + WS_ACT), (const pg8::bf16_t*)(ws + WS_WDN), M, D, DFF}; pg8::StaticOrder S; S.init(M, D, G, bx);
        { pg8::Unit u0; for (int i = 0; S.next(i, u0); ++i) p_fixup(args, u0.pm, tid); asm volatile("s_waitcnt vmcnt(0)" ::: "memory"); __syncthreads(); }
        pg8::EpiResB E{(const pg8::bf16_t*)(ws + WS_XB), args.out, D};
        pg8::gemm_phase<pg8::EpiResB, pg8::StaticOrder, true, true>(lds, g, S, E);
    }
#undef IN
#undef SYNC
}

constexpr int N_PHASES = 7;
#ifndef MK_MULTI
#define MK_MULTI 0
#endif
extern "C" void kernel_launch(void* const* d_in, const int* in_sizes, int n_in, void* d_out, int out_size, void* d_ws, size_t ws_size, hipStream_t stream) {
    static int grid = 0;
    if (grid == 0) {
        if (n_in != 24 || out_size != M * D || ws_size < WS_END) { fprintf(stderr, "kernel_launch: unexpected sizes n_in %d out %d ws %zu\n", n_in, out_size, ws_size); grid = -1; return; }
        int dev = 0, cus = 0, per_cu = 0;
        hipGetDevice(&dev); hipDeviceGetAttribute(&cus, hipDeviceAttributeMultiprocessorCount, dev);
        hipFuncSetAttribute((const void*)fwd_kernel, hipFuncAttributeMaxDynamicSharedMemorySize, LDS_BYTES);
        hipOccupancyMaxActiveBlocksPerMultiprocessor(&per_cu, (const void*)fwd_kernel, NTHR, LDS_BYTES);
        (void)hipGetLastError();
        if (per_cu < 1) { fprintf(stderr, "kernel_launch: occupancy query says %d blocks per CU\n", per_cu); per_cu = 1; }
        grid = cus * 1;
        fprintf(stderr, "kernel_launch: cus %d per_cu %d grid %d\n", cus, per_cu, grid);
    }
    if (grid < 0) return;
    Args a{};
    for (int i = 0; i < 24; ++i) a.in[i] = (const float*)d_in[i];
    a.out = (float*)d_out; a.ws = (unsigned char*)d_ws;
#if MK_MULTI
    for (int p = 0; p < N_PHASES; ++p) { a.ph_lo = p; a.ph_hi = p + 1; hipLaunchKernelGGL(fwd_kernel, dim3(grid), dim3(NTHR), LDS_BYTES, stream, a); }
#else
    a.ph_lo = 0; a.ph_hi = N_PHASES;
    void* kargs[] = {&a};
    hipError_t e = hipLaunchCooperativeKernel((const void*)fwd_kernel, dim3(grid), dim3(NTHR), kargs, LDS_BYTES, stream);
    if (e != hipSuccess) fprintf(stderr, "cooperative launch failed: %s (grid %d)\n", hipGetErrorString(e), grid);
#endif
}
```
